# Optimizing an MI355X kernel written in HIP

```python
import math
import jax, jax.numpy as jnp
from jax import lax
import numpy as np

D_MODEL = 1024
BATCH = 4
SEQ = 8192
DEPTH = 1

GDN_HEAD_K = 128
GDN_HEAD_V = 128
GDN_HEADS = D_MODEL // GDN_HEAD_V
GDN_CONV = 4
GDN_CHUNK = 64
GDN_QK_DIM = GDN_HEADS * GDN_HEAD_K
GDN_V_DIM = GDN_HEADS * GDN_HEAD_V
GDN_CONV_DIM = 2 * GDN_QK_DIM + GDN_V_DIM

ATT_HEAD_DIM = 128
ATT_HEADS = D_MODEL // ATT_HEAD_DIM
ATT_KV_HEADS = 2
ATT_Q_DIM = ATT_HEADS * ATT_HEAD_DIM
ATT_KV_DIM = ATT_KV_HEADS * ATT_HEAD_DIM
IDX_HEADS = 8
IDX_DIM = 64
TOPK_MAX = 256
Q_BLOCK = 128

ROPE_THETA = 500000.0
ROPE_FRACTION = 4
D_FF = 4 * D_MODEL
EPS = 1e-6

IN_SPLITS = (GDN_CONV_DIM, GDN_V_DIM, GDN_HEADS, GDN_HEADS,
             ATT_Q_DIM, ATT_KV_DIM, ATT_KV_DIM,
             IDX_HEADS * IDX_DIM, IDX_DIM, IDX_HEADS,
             D_MODEL, D_MODEL)
IN_PROJ_DIM = (GDN_CONV_DIM + GDN_V_DIM + 2 * GDN_HEADS + ATT_Q_DIM + 2 * ATT_KV_DIM
               + IDX_HEADS * IDX_DIM + IDX_DIM + IDX_HEADS + 2 * D_MODEL)

kernel_name = "hybrid_gdn_dsa_gated_merge"


def rms_norm(x, g):
    xf = x.astype(jnp.float32)
    y = xf * lax.rsqrt(jnp.mean(xf * xf, axis=-1, keepdims=True) + EPS)
    return (y * g.astype(jnp.float32)).astype(x.dtype)


def l2_normalize(x):
    xf = x.astype(jnp.float32)
    return xf * lax.rsqrt(jnp.sum(xf * xf, axis=-1, keepdims=True) + EPS)


def rope_tables(seq, rot_dim):
    inv_freq = ROPE_THETA ** (-jnp.arange(0, rot_dim, 2, dtype=jnp.float32) / rot_dim)
    ang = jnp.arange(seq, dtype=jnp.float32)[:, None] * inv_freq[None, :]
    return jnp.cos(ang), jnp.sin(ang)


def apply_partial_rope(t, cos, sin):
    half = cos.shape[-1]
    shape = (t.shape[1],) + (1,) * (t.ndim - 3) + (half,)
    c, s = cos.reshape(shape), sin.reshape(shape)
    tf = t.astype(jnp.float32)
    x1, x2 = tf[..., :half], tf[..., half:2 * half]
    out = jnp.concatenate([x1 * c - x2 * s, x2 * c + x1 * s, tf[..., 2 * half:]], axis=-1)
    return out.astype(t.dtype)


def causal_short_conv(u, w):
    k = w.shape[0]
    s = u.shape[1]
    up = jnp.pad(u, ((0, 0), (k - 1, 0), (0, 0)))
    y = up[:, 0:s] * w[0]
    for j in range(1, k):
        y = y + up[:, j:j + s] * w[j]
    return y


def gated_delta_rule_chunked(q, k, v, g, beta):
    B, S, H, dk = q.shape
    dv = v.shape[-1]
    C = GDN_CHUNK
    N = S // C
    f32 = jnp.float32

    def chunks(t):
        t = jnp.swapaxes(t.astype(f32), 1, 2)
        return t.reshape((B, H, N, C) + t.shape[3:])

    q, k, v, g, beta = chunks(q), chunks(k), chunks(v), chunks(g), chunks(beta)
    g_cum = jnp.cumsum(g, axis=-1)
    pos = jnp.arange(C)
    incl = pos[:, None] >= pos[None, :]
    strict = pos[:, None] > pos[None, :]
    diff = g_cum[..., :, None] - g_cum[..., None, :]
    decay = jnp.where(incl, jnp.exp(jnp.where(incl, diff, 0.0)), 0.0)
    k_beta = k * beta[..., None]
    a_mat = jnp.where(strict, jnp.einsum('bhnid,bhnjd->bhnij', k_beta, k) * decay, 0.0)
    lhs = a_mat + jnp.eye(C, dtype=f32)
    rhs = jnp.concatenate([v * beta[..., None], k_beta * jnp.exp(g_cum)[..., None]], axis=-1)
    sol = lax.linalg.triangular_solve(lhs, rhs, left_side=True, lower=True, unit_diagonal=True)
    u, w = sol[..., :dv], sol[..., dv:]
    qk = jnp.where(incl, jnp.einsum('bhnid,bhnjd->bhnij', q, k) * decay, 0.0)
    q_dec = q * jnp.exp(g_cum)[..., None]
    g_last = g_cum[..., -1]
    k_dec = k * jnp.exp(g_last[..., None] - g_cum)[..., None]

    def step(state, xs):
        u_n, w_n, qk_n, q_n, k_n, gl_n = xs
        v_new = u_n - jnp.einsum('bhcd,bhde->bhce', w_n, state)
        o_n = (jnp.einsum('bhcd,bhde->bhce', q_n, state)
               + jnp.einsum('bhij,bhje->bhie', qk_n, v_new))
        state = state * jnp.exp(gl_n)[..., None, None] + jnp.einsum('bhcd,bhce->bhde', k_n, v_new)
        return state, o_n

    xs = tuple(jnp.moveaxis(t, 2, 0) for t in (u, w, qk, q_dec, k_dec, g_last))
    state0 = jnp.zeros((B, H, dk, dv), f32)
    _, o = lax.scan(step, state0, xs)
    o = jnp.moveaxis(o, 0, 2).reshape(B, H, S, dv)
    return jnp.swapaxes(o, 1, 2)


def dsa_sparse_attention(q, k, v, q_idx, k_idx, w_idx):
    B, S, H, hd = q.shape
    kvh = k.shape[2]
    grp = H // kvh
    n_blk = S // Q_BLOCK
    k_sel = min(TOPK_MAX, S // 4)
    scale = hd ** -0.5
    key_pos = jnp.arange(S, dtype=jnp.int32)
    k_idx_f = k_idx.astype(jnp.float32)

    def to_blocks(t):
        return jnp.moveaxis(t.reshape((B, n_blk, Q_BLOCK) + t.shape[2:]), 1, 0)

    def block(args):
        blk, qb, qib, wb = args
        t = blk * Q_BLOCK + jnp.arange(Q_BLOCK, dtype=jnp.int32)
        logits = jnp.einsum('bqhd,bsd->bqhs', qib.astype(jnp.float32), k_idx_f)
        score = jnp.einsum('bqh,bqhs->bqs', wb.astype(jnp.float32), jax.nn.relu(logits))
        causal = key_pos[None, :] <= t[:, None]
        score = jnp.where(causal[None], score, -jnp.inf)
        _, sel = lax.top_k(score, k_sel)
        valid = sel <= t[None, :, None]
        k_g = jax.vmap(lambda kb, ib: kb[ib])(k, sel)
        v_g = jax.vmap(lambda vb, ib: vb[ib])(v, sel)
        qg = qb.reshape(B, Q_BLOCK, kvh, grp, hd)
        s = jnp.einsum('bqcgd,bqncd->bqcgn', qg, k_g).astype(jnp.float32) * scale
        s = jnp.where(valid[:, :, None, None, :], s, -jnp.inf)
        p = jax.nn.softmax(s, axis=-1).astype(v_g.dtype)
        o = jnp.einsum('bqcgn,bqncd->bqcgd', p, v_g)
        return o.reshape(B, Q_BLOCK, H * hd)

    o = lax.map(block, (jnp.arange(n_blk, dtype=jnp.int32), to_blocks(q),
                        to_blocks(q_idx), to_blocks(w_idx)))
    return jnp.moveaxis(o, 0, 1).reshape(B, S, H * hd)


def hybrid_layer(x, norm_mix_g, w_in, conv_w, a_log, dt_bias, gdn_norm_g,
                 q_norm_g, k_norm_g, w_out, norm_mlp_g, w_mlp_up, w_mlp_down):
    B, S, _ = x.shape
    h = rms_norm(x, norm_mix_g)
    proj = h @ w_in
    points = np.cumsum(np.array(IN_SPLITS))[:-1].tolist()
    (g_qkv, g_z, g_a, g_b, a_q, a_k, a_v,
     i_q, i_k, i_w, gate_a, gate_b) = jnp.split(proj, points, axis=-1)

    qkv = jax.nn.silu(causal_short_conv(g_qkv, conv_w))
    gq, gk, gv = jnp.split(qkv, [GDN_QK_DIM, 2 * GDN_QK_DIM], axis=-1)
    gq = l2_normalize(gq.reshape(B, S, GDN_HEADS, GDN_HEAD_K)) * (GDN_HEAD_K ** -0.5)
    gk = l2_normalize(gk.reshape(B, S, GDN_HEADS, GDN_HEAD_K))
    gv = gv.reshape(B, S, GDN_HEADS, GDN_HEAD_V)
    beta = jax.nn.sigmoid(g_b.astype(jnp.float32))
    g = -jnp.exp(a_log.astype(jnp.float32)) * jax.nn.softplus(
        g_a.astype(jnp.float32) + dt_bias.astype(jnp.float32))
    o_gdn = gated_delta_rule_chunked(gq, gk, gv, g, beta)
    z = jax.nn.silu(g_z.reshape(B, S, GDN_HEADS, GDN_HEAD_V).astype(jnp.float32))
    o_gdn = (rms_norm(o_gdn, gdn_norm_g) * z).reshape(B, S, GDN_V_DIM).astype(x.dtype)

    cos, sin = rope_tables(S, ATT_HEAD_DIM // ROPE_FRACTION)
    a_q = apply_partial_rope(rms_norm(a_q.reshape(B, S, ATT_HEADS, ATT_HEAD_DIM), q_norm_g), cos, sin)
    a_k = apply_partial_rope(rms_norm(a_k.reshape(B, S, ATT_KV_HEADS, ATT_HEAD_DIM), k_norm_g), cos, sin)
    a_v = a_v.reshape(B, S, ATT_KV_HEADS, ATT_HEAD_DIM)
    cos_i, sin_i = rope_tables(S, IDX_DIM // ROPE_FRACTION)
    i_q = apply_partial_rope(i_q.reshape(B, S, IDX_HEADS, IDX_DIM), cos_i, sin_i)
    i_k = apply_partial_rope(i_k, cos_i, sin_i)
    i_w = i_w * (IDX_HEADS ** -0.5 * IDX_DIM ** -0.5)
    o_att = dsa_sparse_attention(a_q, a_k, a_v, i_q, i_k, i_w).astype(x.dtype)

    merged = jax.nn.sigmoid(gate_a) * o_gdn + jax.nn.sigmoid(gate_b) * o_att
    x = x + merged @ w_out

    h2 = rms_norm(x, norm_mlp_g)
    x = x + jnp.square(jax.nn.relu(h2 @ w_mlp_up)) @ w_mlp_down
    return x


def setup_inputs(seed: int = 0) -> dict:
    key = jax.random.key(seed)
    ks = jax.random.split(key, 14)
    f32 = jnp.float32

    def gain(k, n):
        return 1.0 + 0.02 * jax.random.normal(k, (DEPTH, n), f32)

    x = jax.random.normal(ks[0], (BATCH, SEQ, D_MODEL), f32)
    norm_mix_g = gain(ks[1], D_MODEL)
    w_in = jax.random.normal(ks[2], (DEPTH, D_MODEL, IN_PROJ_DIM), f32) * D_MODEL ** -0.5
    conv_w = jax.random.normal(ks[3], (DEPTH, GDN_CONV, GDN_CONV_DIM), f32) * GDN_CONV ** -0.5
    a_log = jnp.log(jax.random.uniform(ks[4], (DEPTH, GDN_HEADS), f32, 1.0, 16.0))
    dt = jnp.exp(jax.random.uniform(ks[5], (DEPTH, GDN_HEADS), f32, math.log(1e-3), math.log(1e-1)))
    dt_bias = dt + jnp.log(-jnp.expm1(-dt))
    gdn_norm_g = gain(ks[6], GDN_HEAD_V)
    q_norm_g = gain(ks[7], ATT_HEAD_DIM)
    k_norm_g = gain(ks[8], ATT_HEAD_DIM)
    w_out = jax.random.normal(ks[9], (DEPTH, D_MODEL, D_MODEL), f32) * D_MODEL ** -0.5
    norm_mlp_g = gain(ks[10], D_MODEL)
    w_mlp_up = jax.random.normal(ks[11], (DEPTH, D_MODEL, D_FF), f32) * D_MODEL ** -0.5
    w_mlp_down = jax.random.normal(ks[12], (DEPTH, D_FF, D_MODEL), f32) * D_FF ** -0.5
    return {"x": x, "norm_mix_g": norm_mix_g, "w_in": w_in, "conv_w": conv_w,
            "a_log": a_log, "dt_bias": dt_bias, "gdn_norm_g": gdn_norm_g,
            "q_norm_g": q_norm_g, "k_norm_g": k_norm_g, "w_out": w_out,
            "norm_mlp_g": norm_mlp_g, "w_mlp_up": w_mlp_up, "w_mlp_down": w_mlp_down}


def reference(x, norm_mix_g, w_in, conv_w, a_log, dt_bias, gdn_norm_g, q_norm_g, k_norm_g,
              w_out, norm_mlp_g, w_mlp_up, w_mlp_down):
    for layer in range(DEPTH):
        x = hybrid_layer(x, norm_mix_g[layer], w_in[layer], conv_w[layer], a_log[layer],
                         dt_bias[layer], gdn_norm_g[layer], q_norm_g[layer], k_norm_g[layer],
                         w_out[layer], norm_mlp_g[layer], w_mlp_up[layer], w_mlp_down[layer])
    return x
```

```cpp
#include <hip/hip_runtime.h>
#include <hip/hip_cooperative_groups.h>
#include <cstdio>
#include <cstdint>
namespace pg8 {
#define PG8_LAS __attribute__((address_space(3)))
typedef unsigned short bf16_t;
typedef short bf16x8 __attribute__((ext_vector_type(8)));
typedef float f32x4 __attribute__((ext_vector_type(4)));
typedef unsigned u32x4 __attribute__((ext_vector_type(4)));
constexpr int BM = 256, BK = 64, HALF = 128, HTB = HALF * BK * 2  , STAGE_BYTES = 8 * HTB, NXCD = 8, WGM = 8;

__host__ __device__ __forceinline__ int lds_byte(int r, int c) { const int st = (r >> 4) * 2 + (c >> 5), rr = r & 15, cc = c & 31, ob = rr * 64 + cc * 2; return st * 1024 + (ob ^ (((ob >> 9) & 1) << 5)); }
__host__ __device__ __forceinline__ void stage_rc(int b, int& R, int& C) { const int st = b / 1024, sb = b % 1024, swz = sb ^ (((sb >> 9) & 1) << 5); R = (st >> 1) * 16 + swz / 64; C = (st & 1) * 32 + (swz % 64) / 2; }
__host__ __device__ __forceinline__ int perm32(int rho) { const int n = rho >> 4, i = rho & 15; return 8 * (i >> 2) + 4 * n + (i & 3); }

struct Unit { int pm, pn; };
struct Gemm { const bf16_t* A; const bf16_t* Bt; int M, N, K; };

struct StaticOrder {
    int nM, nN, nwg, G, c;
    __host__ __device__ void init(int M, int N, int G_, int c_) { nM = M / BM; nN = N / BM; nwg = nM * nN; G = G_; c = c_; }
    __host__ __device__ bool next(int i, Unit& u) const {
        const long L = (long)i * G + c; if (L >= nwg) return false;
        int wgid = (int)L; { const int q = nwg / NXCD, r = nwg % NXCD, xcd = wgid % NXCD, off = wgid / NXCD; wgid = (xcd < r ? xcd * (q + 1) : r * (q + 1) + (xcd - r) * q) + off; }
        const int nig = WGM * nN, gid = wgid / nig, fm = gid * WGM, gsz = (nM - fm) < WGM ? (nM - fm) : WGM;
        u.pm = fm + ((wgid % nig) % gsz); u.pn = (wgid % nig) / gsz; return true;
    }
    __device__ __forceinline__ void a_ready(const Unit&) const {}
    __device__ __forceinline__ void done(const Unit&) const {}
};

__device__ __forceinline__ unsigned cvt_pk_bf16(float lo, float hi) { unsigned r; asm volatile("v_cvt_pk_bf16_f32 %0, %1, %2" : "=v"(r) : "v"(lo), "v"(hi)); return r; }
typedef unsigned u32x2 __attribute__((ext_vector_type(2)));
__device__ __forceinline__ float bf_lo(unsigned w) { return __builtin_bit_cast(float, w << 16); }
__device__ __forceinline__ float bf_hi(unsigned w) { return __builtin_bit_cast(float, w & 0xffff0000u); }
__device__ __forceinline__ float sigmoidf_(float x) { return 1.0f / (1.0f + __expf(-x)); }

struct EpiInProj {
    static constexpr bool PERM = true, AFTER_DRAIN = false;
    bf16_t *QKV, *Z, *AQ, *AKV, *IQ, *IK, *HALO; float* SM;
    __device__ __forceinline__ void operator()(const f32x4 (&acc)[2][2][4][2], const Unit& u, int wr, int wc, int fr, int fq) const {
        const int pn = u.pn; const int row0 = u.pm * BM + wr * 64 + fr;
        if (pn < 24) {
            bf16_t* base; int ldc, colt;
            if (pn < 12) { base = QKV; ldc = 3072; colt = pn * 256; }
            else if (pn < 16) { base = Z; ldc = 1024; colt = (pn - 12) * 256; }
            else if (pn < 20) { base = AQ; ldc = 1024; colt = (pn - 16) * 256; }
            else if (pn < 22) { base = AKV; ldc = 512; colt = (pn - 20) * 256; }
            else { base = IQ; ldc = 512; colt = (pn - 22) * 256; }
            const int col0 = colt + wc * 32 + 8 * fq;
#pragma unroll
            for (int ai = 0; ai < 2; ++ai)
#pragma unroll
                for (int m = 0; m < 4; ++m) { const int row = row0 + ai * HALF + m * 16; bf16_t* rowp = base + (size_t)row * ldc + col0;
#pragma unroll
                    for (int bj = 0; bj < 2; ++bj) { const f32x4 v0 = acc[ai][bj][m][0], v1 = acc[ai][bj][m][1];
                        u32x4 w; w.x = cvt_pk_bf16(v0[0], v0[1]); w.y = cvt_pk_bf16(v0[2], v0[3]); w.z = cvt_pk_bf16(v1[0], v1[1]); w.w = cvt_pk_bf16(v1[2], v1[3]);
                        *(u32x4*)(rowp + bj * HALF) = w;
                        if (pn < 12 && m == 3 && fr >= 13) *(u32x4*)(HALO + ((size_t)(row >> 6) * 3 + (fr - 13)) * 3072 + col0 + bj * HALF) = w; } }
        } else {
#pragma unroll
            for (int ai = 0; ai < 2; ++ai)
#pragma unroll
                for (int m = 0; m < 4; ++m) { const int row = row0 + ai * HALF + m * 16; const f32x4 v0 = acc[ai][0][m][0], v1 = acc[ai][0][m][1];
                    if (wc < 2) { u32x4 w; w.x = cvt_pk_bf16(v0[0], v0[1]); w.y = cvt_pk_bf16(v0[2], v0[3]); w.z = cvt_pk_bf16(v1[0], v1[1]); w.w = cvt_pk_bf16(v1[2], v1[3]);
                        *(u32x4*)(IK + (size_t)row * 64 + wc * 32 + 8 * fq) = w; }
                    else if (wc == 2 && fq < 3) { float* p = SM + (size_t)row * 32 + 8 * fq; *(f32x4*)p = v0; *(f32x4*)(p + 4) = v1; } }
        }
    }
};
struct EpiGate {
    static constexpr bool PERM = true, AFTER_DRAIN = false;
    const bf16_t* OG; int ldog; const bf16_t* OA; int ldoa; bf16_t* MG;
    __device__ __forceinline__ void operator()(const f32x4 (&acc)[2][2][4][2], const Unit& u, int wr, int wc, int fr, int fq) const {
        const int row0 = u.pm * BM + wr * 64 + fr; const int ch0 = u.pn * 128 + wc * 32 + 8 * fq;
#pragma unroll
        for (int ai = 0; ai < 2; ++ai)
#pragma unroll
            for (int m = 0; m < 4; ++m) { const int row = row0 + ai * HALF + m * 16;
                const u32x4 og = *(const u32x4*)(OG + (size_t)row * ldog + ch0); const u32x4 oa = *(const u32x4*)(OA + (size_t)row * ldoa + ch0);
                const f32x4 a0 = acc[ai][0][m][0], a1 = acc[ai][0][m][1], b0 = acc[ai][1][m][0], b1 = acc[ai][1][m][1];
                float r[8];
                r[0] = sigmoidf_(a0[0]) * bf_lo(og.x) + sigmoidf_(b0[0]) * bf_lo(oa.x); r[1] = sigmoidf_(a0[1]) * bf_hi(og.x) + sigmoidf_(b0[1]) * bf_hi(oa.x);
                r[2] = sigmoidf_(a0[2]) * bf_lo(og.y) + sigmoidf_(b0[2]) * bf_lo(oa.y); r[3] = sigmoidf_(a0[3]) * bf_hi(og.y) + sigmoidf_(b0[3]) * bf_hi(oa.y);
                r[4] = sigmoidf_(a1[0]) * bf_lo(og.z) + sigmoidf_(b1[0]) * bf_lo(oa.z); r[5] = sigmoidf_(a1[1]) * bf_hi(og.z) + sigmoidf_(b1[1]) * bf_hi(oa.z);
                r[6] = sigmoidf_(a1[2]) * bf_lo(og.w) + sigmoidf_(b1[2]) * bf_lo(oa.w); r[7] = sigmoidf_(a1[3]) * bf_hi(og.w) + sigmoidf_(b1[3]) * bf_hi(oa.w);
                u32x4 w; w.x = cvt_pk_bf16(r[0], r[1]); w.y = cvt_pk_bf16(r[2], r[3]); w.z = cvt_pk_bf16(r[4], r[5]); w.w = cvt_pk_bf16(r[6], r[7]);
                *(u32x4*)(MG + (size_t)row * 1024 + ch0) = w; }
    }
};
struct EpiResF32 {
    static constexpr bool PERM = false, AFTER_DRAIN = false;
    const float* base; float* out;
    __device__ __forceinline__ void operator()(const f32x4 (&acc)[2][2][4][2], const Unit& u, int wr, int wc, int fr, int fq) const {
        const int col0 = u.pn * BM + wc * 32 + 4 * fq;
#pragma unroll
        for (int ai = 0; ai < 2; ++ai)
#pragma unroll
            for (int m = 0; m < 4; ++m) { const size_t off = (size_t)(u.pm * BM + ai * HALF + wr * 64 + m * 16 + fr) * 1024 + col0;
#pragma unroll
                for (int bj = 0; bj < 2; ++bj)
#pragma unroll
                    for (int n = 0; n < 2; ++n) { const f32x4 bs = *(const f32x4*)(base + off + bj * HALF + n * 16); *(f32x4*)(out + off + bj * HALF + n * 16) = bs + acc[ai][bj][m][n]; } }
    }
};
struct EpiRelu2 {
    static constexpr bool PERM = true, AFTER_DRAIN = false;
    bf16_t* O; int ldc;
    __device__ __forceinline__ void operator()(const f32x4 (&acc)[2][2][4][2], const Unit& u, int wr, int wc, int fr, int fq) const {
        const int row0 = u.pm * BM + wr * 64 + fr; const int col0 = u.pn * BM + wc * 32 + 8 * fq;
#pragma unroll
        for (int ai = 0; ai < 2; ++ai)
#pragma unroll
            for (int m = 0; m < 4; ++m) { bf16_t* rowp = O + (size_t)(row0 + ai * HALF + m * 16) * ldc + col0;
#pragma unroll
                for (int bj = 0; bj < 2; ++bj) { f32x4 v0 = acc[ai][bj][m][0], v1 = acc[ai][bj][m][1];
#pragma unroll
                    for (int i = 0; i < 4; ++i) { const float a = fmaxf(v0[i], 0.f), b = fmaxf(v1[i], 0.f); v0[i] = a * a; v1[i] = b * b; }
                    u32x4 w; w.x = cvt_pk_bf16(v0[0], v0[1]); w.y = cvt_pk_bf16(v0[2], v0[3]); w.z = cvt_pk_bf16(v1[0], v1[1]); w.w = cvt_pk_bf16(v1[2], v1[3]);
                    *(u32x4*)(rowp + bj * HALF) = w; } }
    }
};
template <class Epi, class Sched, bool ALIGN_EPI = false, bool SP2 = false>
__device__ __forceinline__ void gemm_phase(PG8_LAS unsigned char* lds, const Gemm g, const Sched& S, const Epi& E) {
    const int tid = threadIdx.x, wid = __builtin_amdgcn_readfirstlane(tid >> 6), lane = tid & 63, wr = wid >> 2, wc = wid & 3, fr = lane & 15, fq = lane >> 4;
    const int K = g.K, nt = K / BK;
    unsigned voffA[2], voffB[2];
#pragma unroll
    for (int i = 0; i < 2; ++i) { int R, C; stage_rc(tid * 16 + i * 8192, R, C); const int Rb = Epi::PERM ? ((R & ~31) + perm32(R & 31)) : R;
        voffA[i] = (unsigned)(R * K + C) * 2u; voffB[i] = (unsigned)(Rb * K + C) * 2u; }
    const size_t kstep = (size_t)(BK * 2);
    const size_t hstep = (size_t)HALF * K * 2;
    const size_t tstep = 2 * hstep;
    const unsigned ldsw = (unsigned)wid * 1024u;
    const int aoff = lds_byte(wr * 64 + fr, fq * 8), boff = lds_byte(wc * 32 + fr, fq * 8);
#define PG8_SA(b, h) (((b) * 2 + (h)) * HTB)
#define PG8_SB(b, h) ((4 + (b) * 2 + (h)) * HTB)
#define PG8_STAGE(bufoff, gbase, voff) do { _Pragma("unroll") for (int _i = 0; _i < 2; ++_i) \
        __builtin_amdgcn_global_load_lds((const unsigned*)((const char*)(gbase) + (voff)[_i]), (PG8_LAS unsigned*)(lds + (bufoff) + ldsw + _i * 8192), 16, 0, 0); } while (0)
#define PG8_LDA(dst, b, h) do { _Pragma("unroll") for (int m = 0; m < 4; ++m) _Pragma("unroll") for (int k = 0; k < 2; ++k) dst[m][k] = *(const PG8_LAS bf16x8*)(lds + PG8_SA(b, h) + aoff + m * 2048 + k * 1024); } while (0)
#define PG8_LDB(dst, b, h) do { _Pragma("unroll") for (int n = 0; n < 2; ++n) _Pragma("unroll") for (int k = 0; k < 2; ++k) dst[n][k] = *(const PG8_LAS bf16x8*)(lds + PG8_SB(b, h) + boff + n * 2048 + k * 1024); } while (0)
#define PG8_MMA(ai, bj, At, Bt) do { __builtin_amdgcn_s_setprio(1); _Pragma("unroll") for (int m = 0; m < 4; ++m) _Pragma("unroll") for (int n = 0; n < 2; ++n) _Pragma("unroll") for (int k = 0; k < 2; ++k) \
        acc[ai][bj][m][n] = __builtin_amdgcn_mfma_f32_16x16x32_bf16(Bt[n][k], At[m][k], acc[ai][bj][m][n], 0, 0, 0); __builtin_amdgcn_s_setprio(0); } while (0)
#define PG8_WAIT_V(n) asm volatile("s_waitcnt vmcnt(" #n ")" ::: "memory")
#define PG8_WAIT_L(n) asm volatile("s_waitcnt lgkmcnt(" #n ")" ::: "memory")
#define PG8_BAR __builtin_amdgcn_s_barrier()
#define PG8_SCHED __builtin_amdgcn_sched_barrier(0)
    Unit cur, nxt; int ui = 0;
    if (!S.next(0, cur)) return;
    f32x4 acc[2][2][4][2];
#pragma unroll
    for (int a = 0; a < 2; ++a)
#pragma unroll
        for (int b = 0; b < 2; ++b)
#pragma unroll
            for (int m = 0; m < 4; ++m)
#pragma unroll
                for (int n = 0; n < 2; ++n) acc[a][b][m][n] = (f32x4){0.f, 0.f, 0.f, 0.f};
    bf16x8 At[4][2], B0[2][2], B1[2][2];
    const char* cA = (const char*)g.A + (size_t)cur.pm * tstep; const char* cB = (const char*)g.Bt + (size_t)cur.pn * tstep;
    S.a_ready(cur);
    if constexpr (SP2) {
        PG8_STAGE(PG8_SB(0, 0), cB, voffB); PG8_STAGE(PG8_SB(0, 1), cB + hstep, voffB); PG8_STAGE(PG8_SA(0, 0), cA, voffA); PG8_STAGE(PG8_SA(0, 1), cA + hstep, voffA);
        if (wr == 1) PG8_BAR;
        PG8_WAIT_V(2); PG8_BAR;
        PG8_STAGE(PG8_SB(1, 0), cB + kstep, voffB); PG8_STAGE(PG8_SA(1, 0), cA + kstep, voffA); PG8_STAGE(PG8_SB(1, 1), cB + hstep + kstep, voffB);
        PG8_WAIT_V(6); PG8_BAR;
    } else {
        PG8_STAGE(PG8_SB(0, 0), cB, voffB); PG8_STAGE(PG8_SA(0, 0), cA, voffA); PG8_STAGE(PG8_SB(0, 1), cB + hstep, voffB); PG8_STAGE(PG8_SA(0, 1), cA + hstep, voffA);
        if (wr == 1) PG8_BAR;
        PG8_WAIT_V(4); PG8_BAR;
        PG8_STAGE(PG8_SB(1, 0), cB + kstep, voffB); PG8_STAGE(PG8_SA(1, 0), cA + kstep, voffA); PG8_STAGE(PG8_SB(1, 1), cB + hstep + kstep, voffB);
        PG8_WAIT_V(6); PG8_BAR;
    }
    for (;;) {
        const bool has_next = S.next(ui + 1, nxt);
        const char* nA = has_next ? (const char*)g.A + (size_t)nxt.pm * tstep : cA; const char* nB = has_next ? (const char*)g.Bt + (size_t)nxt.pn * tstep : cB;
        for (int t = 0; t < nt; t += 2) {
            const bool last = (t == nt - 2);
            const char* a1 = cA + (size_t)(t + 1) * kstep;
            const char* a2 = last ? nA : cA + (size_t)(t + 2) * kstep; const char* b2 = last ? nB : cB + (size_t)(t + 2) * kstep;
            const char* a3 = a2 + kstep; const char* b3 = b2 + kstep;
            if (last && has_next) S.a_ready(nxt);
            if constexpr (SP2) {
            PG8_LDB(B0, 0, 0); PG8_LDB(B1, 0, 1); PG8_SCHED; PG8_LDA(At, 0, 0); PG8_STAGE(PG8_SA(1, 1), a1 + hstep, voffA);
            PG8_WAIT_V(8); PG8_WAIT_L(0); PG8_BAR; PG8_MMA(0, 0, At, B0); PG8_MMA(0, 1, At, B1); PG8_BAR; PG8_SCHED;
            PG8_LDA(At, 0, 1); PG8_STAGE(PG8_SB(0, 0), b2, voffB); PG8_STAGE(PG8_SB(0, 1), b2 + hstep, voffB); PG8_STAGE(PG8_SA(0, 0), a2, voffA);
            PG8_WAIT_V(8); PG8_WAIT_L(0); PG8_BAR; PG8_MMA(1, 0, At, B0); PG8_MMA(1, 1, At, B1); PG8_BAR; PG8_SCHED;
            PG8_LDB(B0, 1, 0); PG8_LDB(B1, 1, 1); PG8_SCHED; PG8_LDA(At, 1, 0); PG8_STAGE(PG8_SA(0, 1), a2 + hstep, voffA);
            PG8_WAIT_V(8); PG8_WAIT_L(0); PG8_BAR; PG8_MMA(0, 0, At, B0); PG8_MMA(0, 1, At, B1); PG8_BAR; PG8_SCHED;
            PG8_LDA(At, 1, 1); PG8_STAGE(PG8_SB(1, 0), b3, voffB); PG8_STAGE(PG8_SB(1, 1), b3 + hstep, voffB); PG8_STAGE(PG8_SA(1, 0), a3, voffA);
            PG8_WAIT_V(8); PG8_WAIT_L(0); PG8_BAR; PG8_MMA(1, 0, At, B0); PG8_MMA(1, 1, At, B1); PG8_BAR; PG8_SCHED;
            } else {
            PG8_LDB(B0, 0, 0); PG8_SCHED; PG8_LDA(At, 0, 0); PG8_STAGE(PG8_SA(1, 1), a1 + hstep, voffA);
            PG8_WAIT_L(8); PG8_BAR; PG8_WAIT_L(0); PG8_MMA(0, 0, At, B0); PG8_BAR; PG8_SCHED;
            PG8_LDB(B1, 0, 1); PG8_STAGE(PG8_SB(0, 0), b2, voffB);
            PG8_BAR; PG8_WAIT_L(0); PG8_MMA(0, 1, At, B1); PG8_BAR;
            PG8_LDA(At, 0, 1); PG8_STAGE(PG8_SA(0, 0), a2, voffA);
            PG8_BAR; PG8_WAIT_L(0); PG8_MMA(1, 0, At, B0); PG8_BAR; PG8_SCHED;
            PG8_STAGE(PG8_SB(0, 1), b2 + hstep, voffB);
            PG8_WAIT_V(6); PG8_BAR; PG8_MMA(1, 1, At, B1); PG8_BAR;
            PG8_LDB(B0, 1, 0); PG8_SCHED; PG8_LDA(At, 1, 0); PG8_STAGE(PG8_SA(0, 1), a2 + hstep, voffA);
            PG8_WAIT_L(8); PG8_BAR; PG8_WAIT_L(0); PG8_MMA(0, 0, At, B0); PG8_BAR; PG8_SCHED;
            PG8_LDB(B1, 1, 1); PG8_STAGE(PG8_SB(1, 0), b3, voffB);
            PG8_BAR; PG8_WAIT_L(0); PG8_MMA(0, 1, At, B1); PG8_BAR;
            PG8_LDA(At, 1, 1); PG8_STAGE(PG8_SA(1, 0), a3, voffA);
            PG8_BAR; PG8_WAIT_L(0); PG8_MMA(1, 0, At, B0); PG8_BAR; PG8_SCHED;
            PG8_STAGE(PG8_SB(1, 1), b3 + hstep, voffB);
            PG8_WAIT_V(6); PG8_BAR; PG8_MMA(1, 1, At, B1); PG8_BAR;
            }
        }
        if constexpr (ALIGN_EPI) { if (wr == 0) PG8_BAR; }
        if constexpr (!Epi::AFTER_DRAIN) { E(acc, cur, wr, wc, fr, fq); S.done(cur); }
        if (!has_next) break;
#pragma unroll
        for (int a = 0; a < 2; ++a)
#pragma unroll
            for (int b = 0; b < 2; ++b)
#pragma unroll
                for (int m = 0; m < 4; ++m)
#pragma unroll
                    for (int n = 0; n < 2; ++n) acc[a][b][m][n] = (f32x4){0.f, 0.f, 0.f, 0.f};
        cur = nxt; cA = nA; cB = nB; ++ui;
        if constexpr (ALIGN_EPI) { if (wr == 1) PG8_BAR; }
    }
    PG8_WAIT_V(0);
    if constexpr (!ALIGN_EPI) { if (wr == 0) PG8_BAR; }
    PG8_BAR;
    if constexpr (Epi::AFTER_DRAIN) { E.fused(acc, cur, wr, wc, fr, fq, lds, wid, lane); S.done(cur); }
#undef PG8_SA
#undef PG8_SB
#undef PG8_STAGE
#undef PG8_LDA
#undef PG8_LDB
#undef PG8_MMA
#undef PG8_WAIT_V
#undef PG8_WAIT_L
#undef PG8_BAR
#undef PG8_SCHED
}
}

#ifndef PG8_SP2
#define PG8_SP2 true
#endif
#ifndef PG8_ALIGN
#define PG8_ALIGN true
#endif
constexpr int NB = 4, SEQ = 8192, DM = 1024, MROWS = NB * SEQ, DFF = 4096;
constexpr int NWAVES = 8;
constexpr float EPSN = 1e-6f;
constexpr int N_IN1 = 6400;
constexpr int N_INT = 8448;
constexpr size_t MiB = 1u << 20;
constexpr size_t WS_CTL = 0, CTL_ZERO_BYTES = 1 * MiB;
constexpr size_t WS_ROPEI = 1 * MiB;
constexpr size_t WS_ROPEA = 1 * MiB + 512 * 1024;
constexpr size_t WS_WINT = 3 * MiB;
constexpr size_t WS_WOT = 20 * MiB, WS_WUT = 22 * MiB, WS_WDT = 30 * MiB;
constexpr size_t WS_QKV = 40 * MiB;
constexpr size_t WS_Z = 232 * MiB;
constexpr size_t WS_AQ = 296 * MiB;
constexpr size_t WS_AKV = 360 * MiB;
constexpr size_t WS_IQ = 392 * MiB;
constexpr size_t WS_IK = 424 * MiB;
constexpr size_t WS_SM = 428 * MiB;
constexpr size_t WS_HALO = 432 * MiB;
constexpr size_t WS_TOPK = 442 * MiB;
constexpr size_t WS_HID = 40 * MiB;
constexpr size_t WS_NEED = 460 * MiB;

constexpr int LDS_BYTES = 147456;

#define GAS __attribute__((address_space(1)))
#define LAS __attribute__((address_space(3)))
typedef unsigned short bf16;
typedef unsigned v4u __attribute__((ext_vector_type(4)));
typedef unsigned v2u __attribute__((ext_vector_type(2)));
typedef float f32x4 __attribute__((ext_vector_type(4)));
#define LDS_WAIT() asm volatile("s_waitcnt lgkmcnt(0)" ::: "memory")
__device__ __forceinline__ unsigned f2bf(float f) { unsigned u = __builtin_bit_cast(unsigned, f); return (u + 0x7fffu + ((u >> 16) & 1u)) >> 16; }
__device__ __forceinline__ unsigned pk2(float lo, float hi) { return f2bf(lo) | (f2bf(hi) << 16); }
__device__ __forceinline__ float bflo(unsigned w) { return __builtin_bit_cast(float, w << 16); }
__device__ __forceinline__ float bfhi(unsigned w) { return __builtin_bit_cast(float, w & 0xffff0000u); }
__device__ __forceinline__ float bf2f(bf16 v) { return __builtin_bit_cast(float, ((unsigned)v) << 16); }
__device__ __forceinline__ float wave_sum(float v) {
#pragma unroll
    for (int o = 1; o < 64; o <<= 1) v += __shfl_xor(v, o);
    return v;
}
__device__ __forceinline__ float siluf_(float x) { return x / (1.0f + __expf(-x)); }
__device__ __forceinline__ float sigm_(float x) { return 1.0f / (1.0f + __expf(-x)); }
__device__ __forceinline__ float softplusf_(float x) { return x > 20.f ? x : log1pf(__expf(x)); }

struct Args {
    const float* x; const float* norm_mix_g; const float* w_in; const float* conv_w; const float* a_log; const float* dt_bias;
    const float* gdn_norm_g; const float* q_norm_g; const float* k_norm_g; const float* w_out; const float* norm_mlp_g; const float* w_up; const float* w_down;
    float* out; unsigned char* ws; int ph_lo, ph_hi;
};

__device__ __forceinline__ int win_src_col(int n) {
    if (n < 4096) return n;
    if (n < 6208) return n + 16;
    if (n < 6216) return 4096 + (n - 6208);
    if (n < 6224) return 4104 + (n - 6216);
    if (n < 6232) return 6224 + (n - 6224);
    if (n < 6400) return -1;
    const int j = (n - 6400) >> 8, i = (n - 6400) & 255;
    return i < 128 ? 6232 + 128 * j + i : 7256 + 128 * j + (i - 128);
}
template <bool PERMUTE>
__device__ __forceinline__ void transpose_item(const float* W, int K, int Nsrc, bf16* WT, int n0, int k0, LAS float* scr, int lane) {
    const int nd = n0 + (lane & 31); const int sc = PERMUTE ? win_src_col(nd) : nd;
#pragma unroll 8
    for (int i = 0; i < 32; ++i) { const int kk = 2 * i + (lane >> 5); scr[kk * 33 + (lane & 31)] = sc >= 0 ? W[(size_t)(k0 + kk) * Nsrc + sc] : 0.f; }
    LDS_WAIT(); asm volatile("" ::: "memory");
    const int c = lane & 7;
#pragma unroll
    for (int j = 0; j < 4; ++j) { const int n = (lane >> 3) + 8 * j; const LAS float* s = scr + (8 * c) * 33 + n;
        v4u o; o.x = pk2(s[0 * 33], s[1 * 33]); o.y = pk2(s[2 * 33], s[3 * 33]); o.z = pk2(s[4 * 33], s[5 * 33]); o.w = pk2(s[6 * 33], s[7 * 33]);
        *(GAS v4u*)(WT + (size_t)(n0 + n) * K + k0 + 8 * c) = o; }
    LDS_WAIT(); asm volatile("" ::: "memory");
}
__device__ __forceinline__ void rms_row_to_bf16(const float* xrow, const float* g, bf16* orow, int lane) {
    const GAS f32x4* xr = (const GAS f32x4*)xrow + lane; const GAS f32x4* gr = (const GAS f32x4*)g + lane;
    f32x4 v[4]; float s = 0.f;
#pragma unroll
    for (int j = 0; j < 4; ++j) { v[j] = xr[64 * j]; s += (v[j].x * v[j].x + v[j].y * v[j].y) + (v[j].z * v[j].z + v[j].w * v[j].w); }
    const float rstd = 1.0f / sqrtf(wave_sum(s) * (1.f / DM) + EPSN);
    GAS unsigned long long* o8 = (GAS unsigned long long*)orow + lane;
#pragma unroll
    for (int j = 0; j < 4; ++j) { const f32x4 gv = gr[64 * j];
        o8[64 * j] = (unsigned long long)pk2(v[j].x * rstd * gv.x, v[j].y * rstd * gv.y) | ((unsigned long long)pk2(v[j].z * rstd * gv.z, v[j].w * rstd * gv.w) << 32); }
}

__device__ __forceinline__ void phase_p0(const Args& a, LAS unsigned char* lds, int gw, int NGW, int wave, int lane) {
    LAS float* scr = (LAS float*)(lds + wave * 16384);
    bf16* WinT = (bf16*)(a.ws + WS_WINT); bf16* WoT = (bf16*)(a.ws + WS_WOT); bf16* WuT = (bf16*)(a.ws + WS_WUT); bf16* WdT = (bf16*)(a.ws + WS_WDT);
    constexpr int I_IN = (N_INT / 32) * (DM / 64), I_O = (DM / 32) * (DM / 64), I_U = (DFF / 32) * (DM / 64), I_D = (DM / 32) * (DFF / 64);
    constexpr int NITEMS = I_IN + I_O + I_U + I_D;
    for (int it = gw; it < NITEMS; it += NGW) {
        int r = it;
        if (r < I_IN) { const int nb = r % (N_INT / 32), kb = r / (N_INT / 32); transpose_item<true>(a.w_in, DM, 8280, WinT, nb * 32, kb * 64, scr, lane); continue; } r -= I_IN;
        if (r < I_O) { const int nb = r % (DM / 32), kb = r / (DM / 32); transpose_item<false>(a.w_out, DM, DM, WoT, nb * 32, kb * 64, scr, lane); continue; } r -= I_O;
        if (r < I_U) { const int nb = r % (DFF / 32), kb = r / (DFF / 32); transpose_item<false>(a.w_up, DM, DFF, WuT, nb * 32, kb * 64, scr, lane); continue; } r -= I_U;
        { const int nb = r % (DM / 32), kb = r / (DM / 32); transpose_item<false>(a.w_down, DFF, DM, WdT, nb * 32, kb * 64, scr, lane); }
    }
    float2* RI = (float2*)(a.ws + WS_ROPEI); float2* RA = (float2*)(a.ws + WS_ROPEA);
    for (int e = gw * 64 + lane; e < SEQ * 24; e += NGW * 64) {
        const int t = e / 24, j = e % 24; float inv, sn, cs;
        if (j < 8) { inv = powf(500000.0f, -(float)(2 * j) / 16.0f); const float ang = (float)t * inv; sincosf(ang, &sn, &cs); RI[t * 8 + j] = make_float2(cs, sn); }
        else { const int jj = j - 8; inv = powf(500000.0f, -(float)(2 * jj) / 32.0f); const float ang = (float)t * inv; sincosf(ang, &sn, &cs); RA[t * 16 + jj] = make_float2(cs, sn); }
    }
    bf16* H = (bf16*)a.out;
    for (int m = gw; m < MROWS; m += NGW) rms_row_to_bf16(a.x + (size_t)m * DM, a.norm_mix_g, H + (size_t)m * DM, lane);
}

__device__ __forceinline__ void phase_p1b(const Args& a, int gw, int NGW, int lane) {
    bf16* AQ = (bf16*)(a.ws + WS_AQ); bf16* AKV = (bf16*)(a.ws + WS_AKV); bf16* IQ = (bf16*)(a.ws + WS_IQ); bf16* IK = (bf16*)(a.ws + WS_IK);
    const float2* RI = (const float2*)(a.ws + WS_ROPEI); const float2* RA = (const float2*)(a.ws + WS_ROPEA);
    for (int m = gw; m < MROWS; m += NGW) {
        const int t = m & (SEQ - 1);
        {
            const int seg = lane & 7; bf16* p = AQ + (size_t)m * 1024 + (lane >> 3) * 128 + seg * 16;
            const v4u w0 = *(const v4u*)p, w1 = *(const v4u*)(p + 8);
            float y[16]; y[0] = bflo(w0.x); y[1] = bfhi(w0.x); y[2] = bflo(w0.y); y[3] = bfhi(w0.y); y[4] = bflo(w0.z); y[5] = bfhi(w0.z); y[6] = bflo(w0.w); y[7] = bfhi(w0.w);
            y[8] = bflo(w1.x); y[9] = bfhi(w1.x); y[10] = bflo(w1.y); y[11] = bfhi(w1.y); y[12] = bflo(w1.z); y[13] = bfhi(w1.z); y[14] = bflo(w1.w); y[15] = bfhi(w1.w);
            float ss = 0.f;
#pragma unroll
            for (int i = 0; i < 16; ++i) ss += y[i] * y[i];
            ss += __shfl_xor(ss, 1); ss += __shfl_xor(ss, 2); ss += __shfl_xor(ss, 4);
            const float rstd = 1.0f / sqrtf(ss * (1.f / 128.f) + EPSN);
#pragma unroll
            for (int i = 0; i < 16; ++i) y[i] = y[i] * rstd * a.q_norm_g[seg * 16 + i];
#pragma unroll
            for (int i = 0; i < 16; ++i) { const float o = __shfl_xor(y[i], 1); const float2 cs = RA[t * 16 + i];
                if (seg == 0) y[i] = y[i] * cs.x - o * cs.y; else if (seg == 1) y[i] = y[i] * cs.x + o * cs.y; }
            v4u o0, o1; o0.x = pk2(y[0], y[1]); o0.y = pk2(y[2], y[3]); o0.z = pk2(y[4], y[5]); o0.w = pk2(y[6], y[7]);
            o1.x = pk2(y[8], y[9]); o1.y = pk2(y[10], y[11]); o1.z = pk2(y[12], y[13]); o1.w = pk2(y[14], y[15]);
            *(v4u*)p = o0; *(v4u*)(p + 8) = o1;
        }
        {
            const int sl = lane & 31; bf16* p = AKV + (size_t)m * 512 + (lane >> 5) * 128 + sl * 4;
            const v2u w = *(const v2u*)p; float y[4] = {bflo(w.x), bfhi(w.x), bflo(w.y), bfhi(w.y)};
            float ss = y[0] * y[0] + y[1] * y[1] + y[2] * y[2] + y[3] * y[3];
            ss += __shfl_xor(ss, 1); ss += __shfl_xor(ss, 2); ss += __shfl_xor(ss, 4); ss += __shfl_xor(ss, 8); ss += __shfl_xor(ss, 16);
            const float rstd = 1.0f / sqrtf(ss * (1.f / 128.f) + EPSN);
#pragma unroll
            for (int i = 0; i < 4; ++i) y[i] = y[i] * rstd * a.k_norm_g[sl * 4 + i];
#pragma unroll
            for (int i = 0; i < 4; ++i) { const float o = __shfl_xor(y[i], 4); const float2 cs = RA[t * 16 + ((sl & 3) * 4 + i)];
                if (sl < 4) y[i] = y[i] * cs.x - o * cs.y; else if (sl < 8) y[i] = y[i] * cs.x + o * cs.y; }
            v2u o; o.x = pk2(y[0], y[1]); o.y = pk2(y[2], y[3]); *(v2u*)p = o;
        }
        {
            const int seg = lane & 7; bf16* p = IQ + (size_t)m * 512 + (lane >> 3) * 64 + seg * 8;
            const v4u w = *(const v4u*)p; float y[8] = {bflo(w.x), bfhi(w.x), bflo(w.y), bfhi(w.y), bflo(w.z), bfhi(w.z), bflo(w.w), bfhi(w.w)};
#pragma unroll
            for (int i = 0; i < 8; ++i) { const float o = __shfl_xor(y[i], 1); const float2 cs = RI[t * 8 + i];
                if (seg == 0) y[i] = y[i] * cs.x - o * cs.y; else if (seg == 1) y[i] = y[i] * cs.x + o * cs.y; }
            v4u o; o.x = pk2(y[0], y[1]); o.y = pk2(y[2], y[3]); o.z = pk2(y[4], y[5]); o.w = pk2(y[6], y[7]); *(v4u*)p = o;
        }
        {
            bf16* p = IK + (size_t)m * 64 + lane; float y = bf2f(*p); const float o = __shfl_xor(y, 8); const float2 cs = RI[t * 8 + (lane & 7)];
            if (lane < 8) y = y * cs.x - o * cs.y; else if (lane < 16) y = y * cs.x + o * cs.y;
            *p = (bf16)f2bf(y);
        }
    }
}
__device__ __forceinline__ void phase_p4b(const Args& a, int gw, int NGW, int lane) {
    bf16* H2 = (bf16*)(a.ws + WS_AQ);
    for (int m = gw; m < MROWS; m += NGW) rms_row_to_bf16(a.out + (size_t)m * DM, a.norm_mlp_g, H2 + (size_t)m * DM, lane);
}

__global__ void __launch_bounds__(256) gdn_naive(const bf16* QKV, const bf16* Z, const float* SM, const float* conv_w, const float* a_log, const float* dt_bias,
                                                  const float* gnorm_g, bf16* OG) {
    const int b = blockIdx.x >> 3, h = blockIdx.x & 7, tid = threadIdx.x, lane = tid & 63, wave = tid >> 6;
    __shared__ float sq[32][128], sk[32][128], sv[32][128], so[32][128];
    __shared__ float sdec[32], sbeta[32];
    __shared__ float redA[2][128], redB[2][128];
    float S[64];
#pragma unroll
    for (int i = 0; i < 64; ++i) S[i] = 0.f;
    const int col = tid & 127, half = tid >> 7;
    const float aexp = __expf(a_log[h]), dtb = dt_bias[h];
    for (int t0 = 0; t0 < SEQ; t0 += 32) {
        for (int e = tid; e < 32 * 384; e += 256) {
            const int tok = e / 384, cch = e % 384, which = cch >> 7, d = cch & 127, ch = which * 1024 + h * 128 + d, t = t0 + tok;
            float y = 0.f;
#pragma unroll
            for (int j = 0; j < 4; ++j) { const int tt = t - 3 + j; if (tt >= 0) y += conv_w[j * 3072 + ch] * bf2f(QKV[((size_t)b * SEQ + tt) * 3072 + ch]); }
            y = siluf_(y);
            if (which == 0) sq[tok][d] = y; else if (which == 1) sk[tok][d] = y; else sv[tok][d] = y;
        }
        __syncthreads();
        for (int vi = wave; vi < 64; vi += 4) { const int tok = vi >> 1; float* p = (vi & 1) ? sk[tok] : sq[tok];
            const float x0 = p[lane], x1 = p[lane + 64]; const float ss = wave_sum(x0 * x0 + x1 * x1);
            float sc = 1.0f / sqrtf(ss + EPSN); if (!(vi & 1)) sc *= 0.08838834764831845f;
            p[lane] = x0 * sc; p[lane + 64] = x1 * sc; }
        if (tid < 32) { const size_t row = (size_t)b * SEQ + t0 + tid; const float ga = SM[row * 32 + h], gb = SM[row * 32 + 8 + h];
            sbeta[tid] = sigm_(gb); sdec[tid] = __expf(-aexp * softplusf_(ga + dtb)); }
        __syncthreads();
        for (int tok = 0; tok < 32; ++tok) {
            const float decay = sdec[tok]; const float* kk = sk[tok] + half * 64; const float* qq = sq[tok] + half * 64;
            float p = 0.f;
#pragma unroll
            for (int i = 0; i < 64; ++i) p += S[i] * kk[i];
            redA[half][col] = p; __syncthreads();
            const float kv = (redA[0][col] + redA[1][col]) * decay;
            const float delta = sbeta[tok] * (sv[tok][col] - kv);
            float po = 0.f;
#pragma unroll
            for (int i = 0; i < 64; ++i) { S[i] = decay * S[i] + kk[i] * delta; po += S[i] * qq[i]; }
            redB[half][col] = po; __syncthreads();
            if (half == 0) so[tok][col] = redB[0][col] + redB[1][col];
        }
        __syncthreads();
        for (int tok = wave; tok < 32; tok += 4) { const size_t row = (size_t)b * SEQ + t0 + tok;
            const float o0 = so[tok][lane], o1 = so[tok][lane + 64]; const float ss = wave_sum(o0 * o0 + o1 * o1);
            const float rstd = 1.0f / sqrtf(ss * (1.f / 128.f) + EPSN);
            const float z0 = bf2f(Z[row * 1024 + h * 128 + lane]), z1 = bf2f(Z[row * 1024 + h * 128 + lane + 64]);
            OG[row * 1024 + h * 128 + lane] = (bf16)f2bf(o0 * rstd * gnorm_g[lane] * siluf_(z0));
            OG[row * 1024 + h * 128 + lane + 64] = (bf16)f2bf(o1 * rstd * gnorm_g[lane + 64] * siluf_(z1)); }
        __syncthreads();
    }
}

__device__ __forceinline__ unsigned f2ord(float f) { if (f == 0.f) f = 0.f; const unsigned u = __builtin_bit_cast(unsigned, f); return (u & 0x80000000u) ? ~u : (u | 0x80000000u); }

__global__ void __launch_bounds__(256) topk_naive(const bf16* IQ, const bf16* IK, const float* SM, unsigned short* TOPK) {
    const int row = blockIdx.x, b = row >> 13, t = row & (SEQ - 1), tid = threadIdx.x;
    __shared__ float sq[512]; __shared__ float sw[8]; __shared__ unsigned skey[SEQ]; __shared__ unsigned hist[256]; __shared__ unsigned smisc[4]; __shared__ unsigned scnt[257];
    unsigned short* outp = TOPK + (size_t)row * 256;
    if (t < 256) { outp[tid] = tid <= t ? (unsigned short)tid : (unsigned short)0xFFFF; return; }
    sq[tid] = bf2f(IQ[(size_t)row * 512 + tid]); sq[tid + 256] = bf2f(IQ[(size_t)row * 512 + tid + 256]);
    if (tid < 8) sw[tid] = SM[(size_t)row * 32 + 16 + tid] * (0.35355339059327373f * 0.125f);
    if (tid == 0) smisc[2] = 0u;
    __syncthreads();
    const int n = t + 1;
    for (int s = tid; s < n; s += 256) {
        const v4u* kp = (const v4u*)(IK + ((size_t)b * SEQ + s) * 64); float k[64];
#pragma unroll
        for (int i = 0; i < 8; ++i) { const v4u w = kp[i]; k[8 * i] = bflo(w.x); k[8 * i + 1] = bfhi(w.x); k[8 * i + 2] = bflo(w.y); k[8 * i + 3] = bfhi(w.y); k[8 * i + 4] = bflo(w.z); k[8 * i + 5] = bfhi(w.z); k[8 * i + 6] = bflo(w.w); k[8 * i + 7] = bfhi(w.w); }
        float sc = 0.f;
#pragma unroll
        for (int hh = 0; hh < 8; ++hh) { float d = 0.f;
#pragma unroll
            for (int i = 0; i < 64; ++i) d += sq[hh * 64 + i] * k[i];
            sc += sw[hh] * fmaxf(d, 0.f); }
        skey[s] = f2ord(sc);
    }
    __syncthreads();
    unsigned prefix = 0u, mask = 0u, need = 256u;
    for (int pass = 0; pass < 4; ++pass) { const int shift = 24 - 8 * pass;
        hist[tid] = 0u; __syncthreads();
        for (int s = tid; s < n; s += 256) { const unsigned k = skey[s]; if ((k & mask) == prefix) atomicAdd(&hist[(k >> shift) & 255u], 1u); }
        __syncthreads();
        if (tid == 0) { unsigned cum = 0u; int d = 255; for (; d > 0; --d) { const unsigned c = hist[d]; if (cum + c >= need) break; cum += c; } smisc[0] = (unsigned)d; smisc[1] = need - cum; }
        __syncthreads();
        prefix |= smisc[0] << shift; mask |= 0xFFu << shift; need = smisc[1];
        __syncthreads();
    }
    const int per = (n + 255) / 256; const int s0 = tid * per, s1 = min(n, s0 + per);
    unsigned ceq = 0u;
    for (int s = s0; s < s1; ++s) { const unsigned k = skey[s]; if (k > prefix) { const unsigned pos = atomicAdd(&smisc[2], 1u); outp[pos] = (unsigned short)s; } else if (k == prefix) ++ceq; }
    scnt[tid] = ceq; __syncthreads();
    if (tid == 0) { unsigned run = 0u; for (int i = 0; i < 256; ++i) { const unsigned c = scnt[i]; scnt[i] = run; run += c; } }
    __syncthreads();
    const unsigned ngt = smisc[2]; unsigned rk = scnt[tid];
    for (int s = s0; s < s1; ++s) { if (skey[s] == prefix) { if (rk < need) outp[ngt + rk] = (unsigned short)s; ++rk; } }
}

__global__ void __launch_bounds__(256) attn_simple(bf16* AQ, const bf16* AKV, const unsigned short* TOPK) {
    const int row = blockIdx.x, b = row >> 13, tid = threadIdx.x, lane = tid & 63, wave = tid >> 6;
    __shared__ float sq[1024]; __shared__ float sp[8][256]; __shared__ int sidx[256]; __shared__ float sred[8][4];
    { const v2u w = *(const v2u*)(AQ + (size_t)row * 1024 + tid * 4); sq[tid * 4] = bflo(w.x); sq[tid * 4 + 1] = bfhi(w.x); sq[tid * 4 + 2] = bflo(w.y); sq[tid * 4 + 3] = bfhi(w.y); }
    const int idx = TOPK[(size_t)row * 256 + tid]; const bool valid = idx != 0xFFFF; sidx[tid] = valid ? idx : -1;
    __syncthreads();
    float lg[8];
    if (valid) { const bf16* kr = AKV + ((size_t)b * SEQ + idx) * 512;
#pragma unroll
        for (int c = 0; c < 2; ++c) { float acc4[4] = {0.f, 0.f, 0.f, 0.f};
            for (int i = 0; i < 16; ++i) { const v4u w = *(const v4u*)(kr + c * 128 + i * 8); const float kf[8] = {bflo(w.x), bfhi(w.x), bflo(w.y), bfhi(w.y), bflo(w.z), bfhi(w.z), bflo(w.w), bfhi(w.w)};
#pragma unroll
                for (int g = 0; g < 4; ++g) { const float* q = sq + (c * 4 + g) * 128 + i * 8;
#pragma unroll
                    for (int j = 0; j < 8; ++j) acc4[g] += q[j] * kf[j]; } }
#pragma unroll
            for (int g = 0; g < 4; ++g) lg[c * 4 + g] = acc4[g] * 0.08838834764831845f; }
    } else {
#pragma unroll
        for (int hh = 0; hh < 8; ++hh) lg[hh] = -INFINITY;
    }
#pragma unroll
    for (int hh = 0; hh < 8; ++hh) { float m = lg[hh];
#pragma unroll
        for (int o = 1; o < 64; o <<= 1) m = fmaxf(m, __shfl_xor(m, o));
        if (lane == 0) sred[hh][wave] = m; }
    __syncthreads();
    float ex[8];
#pragma unroll
    for (int hh = 0; hh < 8; ++hh) { const float m = fmaxf(fmaxf(sred[hh][0], sred[hh][1]), fmaxf(sred[hh][2], sred[hh][3])); ex[hh] = valid ? __expf(lg[hh] - m) : 0.f; }
    __syncthreads();
#pragma unroll
    for (int hh = 0; hh < 8; ++hh) { const float s = wave_sum(ex[hh]); if (lane == 0) sred[hh][wave] = s; }
    __syncthreads();
#pragma unroll
    for (int hh = 0; hh < 8; ++hh) { const float s = (sred[hh][0] + sred[hh][1]) + (sred[hh][2] + sred[hh][3]); sp[hh][tid] = ex[hh] / s; }
    __syncthreads();
    const int hh = tid >> 5, d0 = (tid & 31) * 4, c = hh >> 2; float o4[4] = {0.f, 0.f, 0.f, 0.f};
    for (int nn = 0; nn < 256; ++nn) { const int id = sidx[nn]; if (id < 0) continue; const float p = sp[hh][nn];
        const v2u w = *(const v2u*)(AKV + ((size_t)b * SEQ + id) * 512 + 256 + c * 128 + d0);
        o4[0] += p * bflo(w.x); o4[1] += p * bfhi(w.x); o4[2] += p * bflo(w.y); o4[3] += p * bfhi(w.y); }
    v2u o; o.x = pk2(o4[0], o4[1]); o.y = pk2(o4[2], o4[3]); *(v2u*)(AQ + (size_t)row * 1024 + tid * 4) = o;
}

__global__ void __launch_bounds__(NWAVES * 64, 2) fwd(Args a) {
    extern __shared__ __attribute__((aligned(16))) unsigned char lds_raw[];
    LAS unsigned char* lds = (LAS unsigned char*)lds_raw;
    const int tid = threadIdx.x, lane = tid & 63, wave = __builtin_amdgcn_readfirstlane(tid >> 6);
    const int G = gridDim.x, bx = blockIdx.x; const int vcu = (G % 8 == 0) ? (bx % 8) * (G / 8) + bx / 8 : bx;
    const int gw = vcu * NWAVES + wave, NGW = G * NWAVES;
    unsigned char* ws = a.ws;
    bf16* H = (bf16*)a.out; bf16* OG = (bf16*)a.out + (size_t)MROWS * DM;
    bf16* WinT = (bf16*)(ws + WS_WINT);
    const int lo = a.ph_lo, hi = a.ph_hi;
#define IN(k) (lo <= (k) && (k) < hi)
    {
        if (IN(0)) phase_p0(a, lds, gw, NGW, wave, lane);
        if (IN(1)) {
            pg8::Gemm g{H, WinT, MROWS, N_IN1, DM}; pg8::StaticOrder S; S.init(MROWS, N_IN1, G, bx);
            pg8::EpiInProj E{(bf16*)(ws + WS_QKV), (bf16*)(ws + WS_Z), (bf16*)(ws + WS_AQ), (bf16*)(ws + WS_AKV), (bf16*)(ws + WS_IQ), (bf16*)(ws + WS_IK), (bf16*)(ws + WS_HALO), (float*)(ws + WS_SM)};
            pg8::gemm_phase<pg8::EpiInProj, pg8::StaticOrder, PG8_ALIGN, PG8_SP2>(lds, g, S, E);
        }
        if (IN(2)) phase_p1b(a, gw, NGW, lane);
        if (IN(3)) {
            pg8::Gemm g{H, WinT + (size_t)N_IN1 * DM, MROWS, 2048, DM}; pg8::StaticOrder S; S.init(MROWS, 2048, G, bx);
            pg8::EpiGate E{OG, 1024, (const bf16*)(ws + WS_AQ), 1024, (bf16*)(ws + WS_Z)};
            pg8::gemm_phase<pg8::EpiGate, pg8::StaticOrder, PG8_ALIGN, PG8_SP2>(lds, g, S, E);
        }
        if (IN(4)) {
            pg8::Gemm g{(const bf16*)(ws + WS_Z), (const bf16*)(ws + WS_WOT), MROWS, DM, DM}; pg8::StaticOrder S; S.init(MROWS, DM, G, bx);
            pg8::EpiResF32 E{a.x, a.out};
            pg8::gemm_phase<pg8::EpiResF32, pg8::StaticOrder, PG8_ALIGN, PG8_SP2>(lds, g, S, E);
        }
        if (IN(5)) phase_p4b(a, gw, NGW, lane);
        if (IN(6)) {
            pg8::Gemm g{(const bf16*)(ws + WS_AQ), (const bf16*)(ws + WS_WUT), MROWS, DFF, DM}; pg8::StaticOrder S; S.init(MROWS, DFF, G, bx);
            pg8::EpiRelu2 E{(bf16*)(ws + WS_HID), DFF};
            pg8::gemm_phase<pg8::EpiRelu2, pg8::StaticOrder, PG8_ALIGN, PG8_SP2>(lds, g, S, E);
        }
        if (IN(7)) {
            pg8::Gemm g{(const bf16*)(ws + WS_HID), (const bf16*)(ws + WS_WDT), MROWS, DM, DFF}; pg8::StaticOrder S; S.init(MROWS, DM, G, bx);
            pg8::EpiResF32 E{a.out, a.out};
            pg8::gemm_phase<pg8::EpiResF32, pg8::StaticOrder, PG8_ALIGN, PG8_SP2>(lds, g, S, E);
        }
    }
}

extern "C" void kernel_launch(void* const* d_in, const int* in_sizes, int n_in, void* d_out, int out_size, void* d_ws, size_t ws_size, hipStream_t stream) {
    static int ok = 0;
    if (ok == 0) {
        if (n_in != 13 || in_sizes[0] != MROWS * DM || out_size != MROWS * DM || ws_size < WS_NEED) { fprintf(stderr, "kernel_launch: unexpected shapes/workspace (%d inputs, ws %zu)\n", n_in, ws_size); ok = -1; return; }
        if (hipFuncSetAttribute((const void*)fwd, hipFuncAttributeMaxDynamicSharedMemorySize, LDS_BYTES) != hipSuccess) { fprintf(stderr, "kernel_launch: hipFuncSetAttribute failed\n"); ok = -1; return; }
        ok = 1;
    }
    if (ok < 0) return;
    Args a{};
    a.x = (const float*)d_in[0]; a.norm_mix_g = (const float*)d_in[1]; a.w_in = (const float*)d_in[2]; a.conv_w = (const float*)d_in[3]; a.a_log = (const float*)d_in[4];
    a.dt_bias = (const float*)d_in[5]; a.gdn_norm_g = (const float*)d_in[6]; a.q_norm_g = (const float*)d_in[7]; a.k_norm_g = (const float*)d_in[8]; a.w_out = (const float*)d_in[9];
    a.norm_mlp_g = (const float*)d_in[10]; a.w_up = (const float*)d_in[11]; a.w_down = (const float*)d_in[12];
    a.out = (float*)d_out; a.ws = (unsigned char*)d_ws;
    unsigned char* ws = (unsigned char*)d_ws;
    const int grid = 256;
    auto run = [&](int lo, int hi) { a.ph_lo = lo; a.ph_hi = hi; hipLaunchKernelGGL(fwd, dim3(grid), dim3(NWAVES * 64), LDS_BYTES, stream, a); };
    run(0, 1); run(1, 2); run(2, 3);
    bf16* OG = (bf16*)d_out + (size_t)MROWS * DM;
    hipLaunchKernelGGL(gdn_naive, dim3(32), dim3(256), 0, stream, (const bf16*)(ws + WS_QKV), (const bf16*)(ws + WS_Z), (const float*)(ws + WS_SM), a.conv_w, a.a_log, a.dt_bias, a.gdn_norm_g, OG);
    hipLaunchKernelGGL(topk_naive, dim3(MROWS), dim3(256), 0, stream, (const bf16*)(ws + WS_IQ), (const bf16*)(ws + WS_IK), (const float*)(ws + WS_SM), (unsigned short*)(ws + WS_TOPK));
    hipLaunchKernelGGL(attn_simple, dim3(MROWS), dim3(256), 0, stream, (bf16*)(ws + WS_AQ), (const bf16*)(ws + WS_AKV), (const unsigned short*)(ws + WS_TOPK));
    run(3, 4); run(4, 5); run(5, 6); run(6, 7); run(7, 8);
}
```

```cpp
#include <hip/hip_runtime.h>
#include <hip/hip_cooperative_groups.h>
#include <cstdio>
#include <cstdint>
namespace pg8 {
#define PG8_LAS __attribute__((address_space(3)))
typedef unsigned short bf16_t;
typedef short bf16x8 __attribute__((ext_vector_type(8)));
typedef float f32x4 __attribute__((ext_vector_type(4)));
typedef unsigned u32x4 __attribute__((ext_vector_type(4)));
constexpr int BM = 256, BK = 64, HALF = 128, HTB = HALF * BK * 2  , STAGE_BYTES = 8 * HTB, NXCD = 8, WGM = 8;

__host__ __device__ __forceinline__ int lds_byte(int r, int c) { const int st = (r >> 4) * 2 + (c >> 5), rr = r & 15, cc = c & 31, ob = rr * 64 + cc * 2; return st * 1024 + (ob ^ (((ob >> 9) & 1) << 5)); }
__host__ __device__ __forceinline__ void stage_rc(int b, int& R, int& C) { const int st = b / 1024, sb = b % 1024, swz = sb ^ (((sb >> 9) & 1) << 5); R = (st >> 1) * 16 + swz / 64; C = (st & 1) * 32 + (swz % 64) / 2; }
__host__ __device__ __forceinline__ int perm32(int rho) { const int n = rho >> 4, i = rho & 15; return 8 * (i >> 2) + 4 * n + (i & 3); }

struct Unit { int pm, pn; };
struct Gemm { const bf16_t* A; const bf16_t* Bt; int M, N, K; };

struct StaticOrder {
    int nM, nN, nwg, G, c;
    __host__ __device__ void init(int M, int N, int G_, int c_) { nM = M / BM; nN = N / BM; nwg = nM * nN; G = G_; c = c_; }
    __host__ __device__ bool next(int i, Unit& u) const {
        const long L = (long)i * G + c; if (L >= nwg) return false;
        int wgid = (int)L; { const int q = nwg / NXCD, r = nwg % NXCD, xcd = wgid % NXCD, off = wgid / NXCD; wgid = (xcd < r ? xcd * (q + 1) : r * (q + 1) + (xcd - r) * q) + off; }
        const int nig = WGM * nN, gid = wgid / nig, fm = gid * WGM, gsz = (nM - fm) < WGM ? (nM - fm) : WGM;
        u.pm = fm + ((wgid % nig) % gsz); u.pn = (wgid % nig) / gsz; return true;
    }
    __device__ __forceinline__ void a_ready(const Unit&) const {}
    __device__ __forceinline__ void done(const Unit&) const {}
};

__device__ __forceinline__ unsigned cvt_pk_bf16(float lo, float hi) { unsigned r; asm volatile("v_cvt_pk_bf16_f32 %0, %1, %2" : "=v"(r) : "v"(lo), "v"(hi)); return r; }
typedef unsigned u32x2 __attribute__((ext_vector_type(2)));
__device__ __forceinline__ float bf_lo(unsigned w) { return __builtin_bit_cast(float, w << 16); }
__device__ __forceinline__ float bf_hi(unsigned w) { return __builtin_bit_cast(float, w & 0xffff0000u); }
__device__ __forceinline__ float sigmoidf_(float x) { return 1.0f / (1.0f + __expf(-x)); }

struct EpiInProj {
    static constexpr bool PERM = true, AFTER_DRAIN = false;
    bf16_t *QKV, *Z, *AQ, *AKV, *IQ, *IK, *HALO; float* SM;
    __device__ __forceinline__ void operator()(const f32x4 (&acc)[2][2][4][2], const Unit& u, int wr, int wc, int fr, int fq) const {
        const int pn = u.pn; const int row0 = u.pm * BM + wr * 64 + fr;
        if (pn < 24) {
            bf16_t* base; int ldc, colt;
            if (pn < 12) { base = QKV; ldc = 3072; colt = pn * 256; }
            else if (pn < 16) { base = Z; ldc = 1024; colt = (pn - 12) * 256; }
            else if (pn < 20) { base = AQ; ldc = 1024; colt = (pn - 16) * 256; }
            else if (pn < 22) { base = AKV; ldc = 512; colt = (pn - 20) * 256; }
            else { base = IQ; ldc = 512; colt = (pn - 22) * 256; }
            const int col0 = colt + wc * 32 + 8 * fq;
#pragma unroll
            for (int ai = 0; ai < 2; ++ai)
#pragma unroll
                for (int m = 0; m < 4; ++m) { const int row = row0 + ai * HALF + m * 16; bf16_t* rowp = base + (size_t)row * ldc + col0;
#pragma unroll
                    for (int bj = 0; bj < 2; ++bj) { const f32x4 v0 = acc[ai][bj][m][0], v1 = acc[ai][bj][m][1];
                        u32x4 w; w.x = cvt_pk_bf16(v0[0], v0[1]); w.y = cvt_pk_bf16(v0[2], v0[3]); w.z = cvt_pk_bf16(v1[0], v1[1]); w.w = cvt_pk_bf16(v1[2], v1[3]);
                        *(u32x4*)(rowp + bj * HALF) = w;
                        if (pn < 12 && m == 3 && fr >= 13) *(u32x4*)(HALO + ((size_t)(row >> 6) * 3 + (fr - 13)) * 3072 + col0 + bj * HALF) = w; } }
        } else {
#pragma unroll
            for (int ai = 0; ai < 2; ++ai)
#pragma unroll
                for (int m = 0; m < 4; ++m) { const int row = row0 + ai * HALF + m * 16; const f32x4 v0 = acc[ai][0][m][0], v1 = acc[ai][0][m][1];
                    if (wc < 2) { u32x4 w; w.x = cvt_pk_bf16(v0[0], v0[1]); w.y = cvt_pk_bf16(v0[2], v0[3]); w.z = cvt_pk_bf16(v1[0], v1[1]); w.w = cvt_pk_bf16(v1[2], v1[3]);
                        *(u32x4*)(IK + (size_t)row * 64 + wc * 32 + 8 * fq) = w; }
                    else if (wc == 2 && fq < 3) { float* p = SM + (size_t)row * 32 + 8 * fq; *(f32x4*)p = v0; *(f32x4*)(p + 4) = v1; } }
        }
    }
};
struct EpiGate {
    static constexpr bool PERM = true, AFTER_DRAIN = false;
    const bf16_t* OG; int ldog; const bf16_t* OA; int ldoa; bf16_t* MG;
    __device__ __forceinline__ void operator()(const f32x4 (&acc)[2][2][4][2], const Unit& u, int wr, int wc, int fr, int fq) const {
        const int row0 = u.pm * BM + wr * 64 + fr; const int ch0 = u.pn * 128 + wc * 32 + 8 * fq;
#pragma unroll
        for (int ai = 0; ai < 2; ++ai)
#pragma unroll
            for (int m = 0; m < 4; ++m) { const int row = row0 + ai * HALF + m * 16;
                const u32x4 og = *(const u32x4*)(OG + (size_t)row * ldog + ch0); const u32x4 oa = *(const u32x4*)(OA + (size_t)row * ldoa + ch0);
                const f32x4 a0 = acc[ai][0][m][0], a1 = acc[ai][0][m][1], b0 = acc[ai][1][m][0], b1 = acc[ai][1][m][1];
                float r[8];
                r[0] = sigmoidf_(a0[0]) * bf_lo(og.x) + sigmoidf_(b0[0]) * bf_lo(oa.x); r[1] = sigmoidf_(a0[1]) * bf_hi(og.x) + sigmoidf_(b0[1]) * bf_hi(oa.x);
                r[2] = sigmoidf_(a0[2]) * bf_lo(og.y) + sigmoidf_(b0[2]) * bf_lo(oa.y); r[3] = sigmoidf_(a0[3]) * bf_hi(og.y) + sigmoidf_(b0[3]) * bf_hi(oa.y);
                r[4] = sigmoidf_(a1[0]) * bf_lo(og.z) + sigmoidf_(b1[0]) * bf_lo(oa.z); r[5] = sigmoidf_(a1[1]) * bf_hi(og.z) + sigmoidf_(b1[1]) * bf_hi(oa.z);
                r[6] = sigmoidf_(a1[2]) * bf_lo(og.w) + sigmoidf_(b1[2]) * bf_lo(oa.w); r[7] = sigmoidf_(a1[3]) * bf_hi(og.w) + sigmoidf_(b1[3]) * bf_hi(oa.w);
                u32x4 w; w.x = cvt_pk_bf16(r[0], r[1]); w.y = cvt_pk_bf16(r[2], r[3]); w.z = cvt_pk_bf16(r[4], r[5]); w.w = cvt_pk_bf16(r[6], r[7]);
                *(u32x4*)(MG + (size_t)row * 1024 + ch0) = w; }
    }
};
struct EpiResF32 {
    static constexpr bool PERM = false, AFTER_DRAIN = false;
    const float* base; float* out;
    __device__ __forceinline__ void operator()(const f32x4 (&acc)[2][2][4][2], const Unit& u, int wr, int wc, int fr, int fq) const {
        const int col0 = u.pn * BM + wc * 32 + 4 * fq;
#pragma unroll
        for (int ai = 0; ai < 2; ++ai)
#pragma unroll
            for (int m = 0; m < 4; ++m) { const size_t off = (size_t)(u.pm * BM + ai * HALF + wr * 64 + m * 16 + fr) * 1024 + col0;
#pragma unroll
                for (int bj = 0; bj < 2; ++bj)
#pragma unroll
                    for (int n = 0; n < 2; ++n) { const f32x4 bs = *(const f32x4*)(base + off + bj * HALF + n * 16); *(f32x4*)(out + off + bj * HALF + n * 16) = bs + acc[ai][bj][m][n]; } }
    }
};
struct EpiRelu2 {
    static constexpr bool PERM = true, AFTER_DRAIN = false;
    bf16_t* O; int ldc;
    __device__ __forceinline__ void operator()(const f32x4 (&acc)[2][2][4][2], const Unit& u, int wr, int wc, int fr, int fq) const {
        const int row0 = u.pm * BM + wr * 64 + fr; const int col0 = u.pn * BM + wc * 32 + 8 * fq;
#pragma unroll
        for (int ai = 0; ai < 2; ++ai)
#pragma unroll
            for (int m = 0; m < 4; ++m) { bf16_t* rowp = O + (size_t)(row0 + ai * HALF + m * 16) * ldc + col0;
#pragma unroll
                for (int bj = 0; bj < 2; ++bj) { f32x4 v0 = acc[ai][bj][m][0], v1 = acc[ai][bj][m][1];
#pragma unroll
                    for (int i = 0; i < 4; ++i) { const float a = fmaxf(v0[i], 0.f), b = fmaxf(v1[i], 0.f); v0[i] = a * a; v1[i] = b * b; }
                    u32x4 w; w.x = cvt_pk_bf16(v0[0], v0[1]); w.y = cvt_pk_bf16(v0[2], v0[3]); w.z = cvt_pk_bf16(v1[0], v1[1]); w.w = cvt_pk_bf16(v1[2], v1[3]);
                    *(u32x4*)(rowp + bj * HALF) = w; } }
    }
};
template <class Epi, class Sched, bool ALIGN_EPI = false, bool SP2 = false>
__device__ __forceinline__ void gemm_phase(PG8_LAS unsigned char* lds, const Gemm g, const Sched& S, const Epi& E) {
    const int tid = threadIdx.x, wid = __builtin_amdgcn_readfirstlane(tid >> 6), lane = tid & 63, wr = wid >> 2, wc = wid & 3, fr = lane & 15, fq = lane >> 4;
    const int K = g.K, nt = K / BK;
    unsigned voffA[2], voffB[2];
#pragma unroll
    for (int i = 0; i < 2; ++i) { int R, C; stage_rc(tid * 16 + i * 8192, R, C); const int Rb = Epi::PERM ? ((R & ~31) + perm32(R & 31)) : R;
        voffA[i] = (unsigned)(R * K + C) * 2u; voffB[i] = (unsigned)(Rb * K + C) * 2u; }
    const size_t kstep = (size_t)(BK * 2);
    const size_t hstep = (size_t)HALF * K * 2;
    const size_t tstep = 2 * hstep;
    const unsigned ldsw = (unsigned)wid * 1024u;
    const int aoff = lds_byte(wr * 64 + fr, fq * 8), boff = lds_byte(wc * 32 + fr, fq * 8);
#define PG8_SA(b, h) (((b) * 2 + (h)) * HTB)
#define PG8_SB(b, h) ((4 + (b) * 2 + (h)) * HTB)
#define PG8_STAGE(bufoff, gbase, voff) do { _Pragma("unroll") for (int _i = 0; _i < 2; ++_i) \
        __builtin_amdgcn_global_load_lds((const unsigned*)((const char*)(gbase) + (voff)[_i]), (PG8_LAS unsigned*)(lds + (bufoff) + ldsw + _i * 8192), 16, 0, 0); } while (0)
#define PG8_LDA(dst, b, h) do { _Pragma("unroll") for (int m = 0; m < 4; ++m) _Pragma("unroll") for (int k = 0; k < 2; ++k) dst[m][k] = *(const PG8_LAS bf16x8*)(lds + PG8_SA(b, h) + aoff + m * 2048 + k * 1024); } while (0)
#define PG8_LDB(dst, b, h) do { _Pragma("unroll") for (int n = 0; n < 2; ++n) _Pragma("unroll") for (int k = 0; k < 2; ++k) dst[n][k] = *(const PG8_LAS bf16x8*)(lds + PG8_SB(b, h) + boff + n * 2048 + k * 1024); } while (0)
#define PG8_MMA(ai, bj, At, Bt) do { __builtin_amdgcn_s_setprio(1); _Pragma("unroll") for (int m = 0; m < 4; ++m) _Pragma("unroll") for (int n = 0; n < 2; ++n) _Pragma("unroll") for (int k = 0; k < 2; ++k) \
        acc[ai][bj][m][n] = __builtin_amdgcn_mfma_f32_16x16x32_bf16(Bt[n][k], At[m][k], acc[ai][bj][m][n], 0, 0, 0); __builtin_amdgcn_s_setprio(0); } while (0)
#define PG8_WAIT_V(n) asm volatile("s_waitcnt vmcnt(" #n ")" ::: "memory")
#define PG8_WAIT_L(n) asm volatile("s_waitcnt lgkmcnt(" #n ")" ::: "memory")
#define PG8_BAR __builtin_amdgcn_s_barrier()
#define PG8_SCHED __builtin_amdgcn_sched_barrier(0)
    Unit cur, nxt; int ui = 0;
    if (!S.next(0, cur)) return;
    f32x4 acc[2][2][4][2];
#pragma unroll
    for (int a = 0; a < 2; ++a)
#pragma unroll
        for (int b = 0; b < 2; ++b)
#pragma unroll
            for (int m = 0; m < 4; ++m)
#pragma unroll
                for (int n = 0; n < 2; ++n) acc[a][b][m][n] = (f32x4){0.f, 0.f, 0.f, 0.f};
    bf16x8 At[4][2], B0[2][2], B1[2][2];
    const char* cA = (const char*)g.A + (size_t)cur.pm * tstep; const char* cB = (const char*)g.Bt + (size_t)cur.pn * tstep;
    S.a_ready(cur);
    if constexpr (SP2) {
        PG8_STAGE(PG8_SB(0, 0), cB, voffB); PG8_STAGE(PG8_SB(0, 1), cB + hstep, voffB); PG8_STAGE(PG8_SA(0, 0), cA, voffA); PG8_STAGE(PG8_SA(0, 1), cA + hstep, voffA);
        if (wr == 1) PG8_BAR;
        PG8_WAIT_V(2); PG8_BAR;
        PG8_STAGE(PG8_SB(1, 0), cB + kstep, voffB); PG8_STAGE(PG8_SA(1, 0), cA + kstep, voffA); PG8_STAGE(PG8_SB(1, 1), cB + hstep + kstep, voffB);
        PG8_WAIT_V(6); PG8_BAR;
    } else {
        PG8_STAGE(PG8_SB(0, 0), cB, voffB); PG8_STAGE(PG8_SA(0, 0), cA, voffA); PG8_STAGE(PG8_SB(0, 1), cB + hstep, voffB); PG8_STAGE(PG8_SA(0, 1), cA + hstep, voffA);
        if (wr == 1) PG8_BAR;
        PG8_WAIT_V(4); PG8_BAR;
        PG8_STAGE(PG8_SB(1, 0), cB + kstep, voffB); PG8_STAGE(PG8_SA(1, 0), cA + kstep, voffA); PG8_STAGE(PG8_SB(1, 1), cB + hstep + kstep, voffB);
        PG8_WAIT_V(6); PG8_BAR;
    }
    for (;;) {
        const bool has_next = S.next(ui + 1, nxt);
        const char* nA = has_next ? (const char*)g.A + (size_t)nxt.pm * tstep : cA; const char* nB = has_next ? (const char*)g.Bt + (size_t)nxt.pn * tstep : cB;
        for (int t = 0; t < nt; t += 2) {
            const bool last = (t == nt - 2);
            const char* a1 = cA + (size_t)(t + 1) * kstep;
            const char* a2 = last ? nA : cA + (size_t)(t + 2) * kstep; const char* b2 = last ? nB : cB + (size_t)(t + 2) * kstep;
            const char* a3 = a2 + kstep; const char* b3 = b2 + kstep;
            if (last && has_next) S.a_ready(nxt);
            if constexpr (SP2) {
            PG8_LDB(B0, 0, 0); PG8_LDB(B1, 0, 1); PG8_SCHED; PG8_LDA(At, 0, 0); PG8_STAGE(PG8_SA(1, 1), a1 + hstep, voffA);
            PG8_WAIT_V(8); PG8_WAIT_L(0); PG8_BAR; PG8_MMA(0, 0, At, B0); PG8_MMA(0, 1, At, B1); PG8_BAR; PG8_SCHED;
            PG8_LDA(At, 0, 1); PG8_STAGE(PG8_SB(0, 0), b2, voffB); PG8_STAGE(PG8_SB(0, 1), b2 + hstep, voffB); PG8_STAGE(PG8_SA(0, 0), a2, voffA);
            PG8_WAIT_V(8); PG8_WAIT_L(0); PG8_BAR; PG8_MMA(1, 0, At, B0); PG8_MMA(1, 1, At, B1); PG8_BAR; PG8_SCHED;
            PG8_LDB(B0, 1, 0); PG8_LDB(B1, 1, 1); PG8_SCHED; PG8_LDA(At, 1, 0); PG8_STAGE(PG8_SA(0, 1), a2 + hstep, voffA);
            PG8_WAIT_V(8); PG8_WAIT_L(0); PG8_BAR; PG8_MMA(0, 0, At, B0); PG8_MMA(0, 1, At, B1); PG8_BAR; PG8_SCHED;
            PG8_LDA(At, 1, 1); PG8_STAGE(PG8_SB(1, 0), b3, voffB); PG8_STAGE(PG8_SB(1, 1), b3 + hstep, voffB); PG8_STAGE(PG8_SA(1, 0), a3, voffA);
            PG8_WAIT_V(8); PG8_WAIT_L(0); PG8_BAR; PG8_MMA(1, 0, At, B0); PG8_MMA(1, 1, At, B1); PG8_BAR; PG8_SCHED;
            } else {
            PG8_LDB(B0, 0, 0); PG8_SCHED; PG8_LDA(At, 0, 0); PG8_STAGE(PG8_SA(1, 1), a1 + hstep, voffA);
            PG8_WAIT_L(8); PG8_BAR; PG8_WAIT_L(0); PG8_MMA(0, 0, At, B0); PG8_BAR; PG8_SCHED;
            PG8_LDB(B1, 0, 1); PG8_STAGE(PG8_SB(0, 0), b2, voffB);
            PG8_BAR; PG8_WAIT_L(0); PG8_MMA(0, 1, At, B1); PG8_BAR;
            PG8_LDA(At, 0, 1); PG8_STAGE(PG8_SA(0, 0), a2, voffA);
            PG8_BAR; PG8_WAIT_L(0); PG8_MMA(1, 0, At, B0); PG8_BAR; PG8_SCHED;
            PG8_STAGE(PG8_SB(0, 1), b2 + hstep, voffB);
            PG8_WAIT_V(6); PG8_BAR; PG8_MMA(1, 1, At, B1); PG8_BAR;
            PG8_LDB(B0, 1, 0); PG8_SCHED; PG8_LDA(At, 1, 0); PG8_STAGE(PG8_SA(0, 1), a2 + hstep, voffA);
            PG8_WAIT_L(8); PG8_BAR; PG8_WAIT_L(0); PG8_MMA(0, 0, At, B0); PG8_BAR; PG8_SCHED;
            PG8_LDB(B1, 1, 1); PG8_STAGE(PG8_SB(1, 0), b3, voffB);
            PG8_BAR; PG8_WAIT_L(0); PG8_MMA(0, 1, At, B1); PG8_BAR;
            PG8_LDA(At, 1, 1); PG8_STAGE(PG8_SA(1, 0), a3, voffA);
            PG8_BAR; PG8_WAIT_L(0); PG8_MMA(1, 0, At, B0); PG8_BAR; PG8_SCHED;
            PG8_STAGE(PG8_SB(1, 1), b3 + hstep, voffB);
            PG8_WAIT_V(6); PG8_BAR; PG8_MMA(1, 1, At, B1); PG8_BAR;
            }
        }
        if constexpr (ALIGN_EPI) { if (wr == 0) PG8_BAR; }
        if constexpr (!Epi::AFTER_DRAIN) { E(acc, cur, wr, wc, fr, fq); S.done(cur); }
        if (!has_next) break;
#pragma unroll
        for (int a = 0; a < 2; ++a)
#pragma unroll
            for (int b = 0; b < 2; ++b)
#pragma unroll
                for (int m = 0; m < 4; ++m)
#pragma unroll
                    for (int n = 0; n < 2; ++n) acc[a][b][m][n] = (f32x4){0.f, 0.f, 0.f, 0.f};
        cur = nxt; cA = nA; cB = nB; ++ui;
        if constexpr (ALIGN_EPI) { if (wr == 1) PG8_BAR; }
    }
    PG8_WAIT_V(0);
    if constexpr (!ALIGN_EPI) { if (wr == 0) PG8_BAR; }
    PG8_BAR;
    if constexpr (Epi::AFTER_DRAIN) { E.fused(acc, cur, wr, wc, fr, fq, lds, wid, lane); S.done(cur); }
#undef PG8_SA
#undef PG8_SB
#undef PG8_STAGE
#undef PG8_LDA
#undef PG8_LDB
#undef PG8_MMA
#undef PG8_WAIT_V
#undef PG8_WAIT_L
#undef PG8_BAR
#undef PG8_SCHED
}
}

#ifndef PG8_SP2
#define PG8_SP2 true
#endif
#ifndef PG8_ALIGN
#define PG8_ALIGN true
#endif
constexpr int NB = 4, SEQ = 8192, DM = 1024, MROWS = NB * SEQ, DFF = 4096;
constexpr int NWAVES = 8;
constexpr float EPSN = 1e-6f;
constexpr int N_IN1 = 6400;
constexpr int N_INT = 8448;
constexpr size_t MiB = 1u << 20;
constexpr size_t WS_CTL = 0, CTL_ZERO_BYTES = 1 * MiB;
constexpr size_t WS_ROPEI = 1 * MiB;
constexpr size_t WS_ROPEA = 1 * MiB + 512 * 1024;
constexpr size_t WS_WINT = 3 * MiB;
constexpr size_t WS_WOT = 20 * MiB, WS_WUT = 22 * MiB, WS_WDT = 30 * MiB;
constexpr size_t WS_QKV = 40 * MiB;
constexpr size_t WS_Z = 232 * MiB;
constexpr size_t WS_AQ = 296 * MiB;
constexpr size_t WS_AKV = 360 * MiB;
constexpr size_t WS_IQ = 392 * MiB;
constexpr size_t WS_IK = 424 * MiB;
constexpr size_t WS_SM = 428 * MiB;
constexpr size_t WS_HALO = 432 * MiB;
constexpr size_t WS_TOPK = 442 * MiB;
constexpr size_t WS_HID = 40 * MiB;
constexpr size_t WS_NEED = 460 * MiB;

constexpr int LDS_BYTES = 147456;

#define GAS __attribute__((address_space(1)))
#define LAS __attribute__((address_space(3)))
typedef unsigned short bf16;
typedef unsigned v4u __attribute__((ext_vector_type(4)));
typedef unsigned v2u __attribute__((ext_vector_type(2)));
typedef float f32x4 __attribute__((ext_vector_type(4)));
#define LDS_WAIT() asm volatile("s_waitcnt lgkmcnt(0)" ::: "memory")
__device__ __forceinline__ unsigned f2bf(float f) { unsigned u = __builtin_bit_cast(unsigned, f); return (u + 0x7fffu + ((u >> 16) & 1u)) >> 16; }
__device__ __forceinline__ unsigned pk2(float lo, float hi) { return f2bf(lo) | (f2bf(hi) << 16); }
__device__ __forceinline__ float bflo(unsigned w) { return __builtin_bit_cast(float, w << 16); }
__device__ __forceinline__ float bfhi(unsigned w) { return __builtin_bit_cast(float, w & 0xffff0000u); }
__device__ __forceinline__ float bf2f(bf16 v) { return __builtin_bit_cast(float, ((unsigned)v) << 16); }
__device__ __forceinline__ float wave_sum(float v) {
#pragma unroll
    for (int o = 1; o < 64; o <<= 1) v += __shfl_xor(v, o);
    return v;
}
__device__ __forceinline__ float siluf_(float x) { return x / (1.0f + __expf(-x)); }
__device__ __forceinline__ float sigm_(float x) { return 1.0f / (1.0f + __expf(-x)); }
__device__ __forceinline__ float softplusf_(float x) { return x > 20.f ? x : log1pf(__expf(x)); }

struct Args {
    const float* x; const float* norm_mix_g; const float* w_in; const float* conv_w; const float* a_log; const float* dt_bias;
    const float* gdn_norm_g; const float* q_norm_g; const float* k_norm_g; const float* w_out; const float* norm_mlp_g; const float* w_up; const float* w_down;
    float* out; unsigned char* ws; int ph_lo, ph_hi;
};

__device__ __forceinline__ int win_src_col(int n) {
    if (n < 4096) return n;
    if (n < 6208) return n + 16;
    if (n < 6216) return 4096 + (n - 6208);
    if (n < 6224) return 4104 + (n - 6216);
    if (n < 6232) return 6224 + (n - 6224);
    if (n < 6400) return -1;
    const int j = (n - 6400) >> 8, i = (n - 6400) & 255;
    return i < 128 ? 6232 + 128 * j + i : 7256 + 128 * j + (i - 128);
}
template <bool PERMUTE>
__device__ __forceinline__ void transpose_item(const float* W, int K, int Nsrc, bf16* WT, int n0, int k0, LAS float* scr, int lane) {
    const int nd = n0 + (lane & 31); const int sc = PERMUTE ? win_src_col(nd) : nd;
#pragma unroll 8
    for (int i = 0; i < 32; ++i) { const int kk = 2 * i + (lane >> 5); scr[kk * 33 + (lane & 31)] = sc >= 0 ? W[(size_t)(k0 + kk) * Nsrc + sc] : 0.f; }
    LDS_WAIT(); asm volatile("" ::: "memory");
    const int c = lane & 7;
#pragma unroll
    for (int j = 0; j < 4; ++j) { const int n = (lane >> 3) + 8 * j; const LAS float* s = scr + (8 * c) * 33 + n;
        v4u o; o.x = pk2(s[0 * 33], s[1 * 33]); o.y = pk2(s[2 * 33], s[3 * 33]); o.z = pk2(s[4 * 33], s[5 * 33]); o.w = pk2(s[6 * 33], s[7 * 33]);
        *(GAS v4u*)(WT + (size_t)(n0 + n) * K + k0 + 8 * c) = o; }
    LDS_WAIT(); asm volatile("" ::: "memory");
}
__device__ __forceinline__ void rms_row_to_bf16(const float* xrow, const float* g, bf16* orow, int lane) {
    const GAS f32x4* xr = (const GAS f32x4*)xrow + lane; const GAS f32x4* gr = (const GAS f32x4*)g + lane;
    f32x4 v[4]; float s = 0.f;
#pragma unroll
    for (int j = 0; j < 4; ++j) { v[j] = xr[64 * j]; s += (v[j].x * v[j].x + v[j].y * v[j].y) + (v[j].z * v[j].z + v[j].w * v[j].w); }
    const float rstd = 1.0f / sqrtf(wave_sum(s) * (1.f / DM) + EPSN);
    GAS unsigned long long* o8 = (GAS unsigned long long*)orow + lane;
#pragma unroll
    for (int j = 0; j < 4; ++j) { const f32x4 gv = gr[64 * j];
        o8[64 * j] = (unsigned long long)pk2(v[j].x * rstd * gv.x, v[j].y * rstd * gv.y) | ((unsigned long long)pk2(v[j].z * rstd * gv.z, v[j].w * rstd * gv.w) << 32); }
}

__device__ __forceinline__ void phase_p0(const Args& a, LAS unsigned char* lds, int gw, int NGW, int wave, int lane) {
    LAS float* scr = (LAS float*)(lds + wave * 16384);
    bf16* WinT = (bf16*)(a.ws + WS_WINT); bf16* WoT = (bf16*)(a.ws + WS_WOT); bf16* WuT = (bf16*)(a.ws + WS_WUT); bf16* WdT = (bf16*)(a.ws + WS_WDT);
    constexpr int I_IN = (N_INT / 32) * (DM / 64), I_O = (DM / 32) * (DM / 64), I_U = (DFF / 32) * (DM / 64), I_D = (DM / 32) * (DFF / 64);
    constexpr int NITEMS = I_IN + I_O + I_U + I_D;
    for (int it = gw; it < NITEMS; it += NGW) {
        int r = it;
        if (r < I_IN) { const int nb = r % (N_INT / 32), kb = r / (N_INT / 32); transpose_item<true>(a.w_in, DM, 8280, WinT, nb * 32, kb * 64, scr, lane); continue; } r -= I_IN;
        if (r < I_O) { const int nb = r % (DM / 32), kb = r / (DM / 32); transpose_item<false>(a.w_out, DM, DM, WoT, nb * 32, kb * 64, scr, lane); continue; } r -= I_O;
        if (r < I_U) { const int nb = r % (DFF / 32), kb = r / (DFF / 32); transpose_item<false>(a.w_up, DM, DFF, WuT, nb * 32, kb * 64, scr, lane); continue; } r -= I_U;
        { const int nb = r % (DM / 32), kb = r / (DM / 32); transpose_item<false>(a.w_down, DFF, DM, WdT, nb * 32, kb * 64, scr, lane); }
    }
    float2* RI = (float2*)(a.ws + WS_ROPEI); float2* RA = (float2*)(a.ws + WS_ROPEA);
    for (int e = gw * 64 + lane; e < SEQ * 24; e += NGW * 64) {
        const int t = e / 24, j = e % 24; float inv, sn, cs;
        if (j < 8) { inv = powf(500000.0f, -(float)(2 * j) / 16.0f); const float ang = (float)t * inv; sincosf(ang, &sn, &cs); RI[t * 8 + j] = make_float2(cs, sn); }
        else { const int jj = j - 8; inv = powf(500000.0f, -(float)(2 * jj) / 32.0f); const float ang = (float)t * inv; sincosf(ang, &sn, &cs); RA[t * 16 + jj] = make_float2(cs, sn); }
    }
    bf16* H = (bf16*)a.out;
    for (int m = gw; m < MROWS; m += NGW) rms_row_to_bf16(a.x + (size_t)m * DM, a.norm_mix_g, H + (size_t)m * DM, lane);
}

__device__ __forceinline__ void phase_p1b(const Args& a, int gw, int NGW, int lane) {
    bf16* AQ = (bf16*)(a.ws + WS_AQ); bf16* AKV = (bf16*)(a.ws + WS_AKV); bf16* IQ = (bf16*)(a.ws + WS_IQ); bf16* IK = (bf16*)(a.ws + WS_IK);
    const float2* RI = (const float2*)(a.ws + WS_ROPEI); const float2* RA = (const float2*)(a.ws + WS_ROPEA);
    for (int m = gw; m < MROWS; m += NGW) {
        const int t = m & (SEQ - 1);
        {
            const int seg = lane & 7; bf16* p = AQ + (size_t)m * 1024 + (lane >> 3) * 128 + seg * 16;
            const v4u w0 = *(const v4u*)p, w1 = *(const v4u*)(p + 8);
            float y[16]; y[0] = bflo(w0.x); y[1] = bfhi(w0.x); y[2] = bflo(w0.y); y[3] = bfhi(w0.y); y[4] = bflo(w0.z); y[5] = bfhi(w0.z); y[6] = bflo(w0.w); y[7] = bfhi(w0.w);
            y[8] = bflo(w1.x); y[9] = bfhi(w1.x); y[10] = bflo(w1.y); y[11] = bfhi(w1.y); y[12] = bflo(w1.z); y[13] = bfhi(w1.z); y[14] = bflo(w1.w); y[15] = bfhi(w1.w);
            float ss = 0.f;
#pragma unroll
            for (int i = 0; i < 16; ++i) ss += y[i] * y[i];
            ss += __shfl_xor(ss, 1); ss += __shfl_xor(ss, 2); ss += __shfl_xor(ss, 4);
            const float rstd = 1.0f / sqrtf(ss * (1.f / 128.f) + EPSN);
#pragma unroll
            for (int i = 0; i < 16; ++i) y[i] = y[i] * rstd * a.q_norm_g[seg * 16 + i];
#pragma unroll
            for (int i = 0; i < 16; ++i) { const float o = __shfl_xor(y[i], 1); const float2 cs = RA[t * 16 + i];
                if (seg == 0) y[i] = y[i] * cs.x - o * cs.y; else if (seg == 1) y[i] = y[i] * cs.x + o * cs.y; }
            v4u o0, o1; o0.x = pk2(y[0], y[1]); o0.y = pk2(y[2], y[3]); o0.z = pk2(y[4], y[5]); o0.w = pk2(y[6], y[7]);
            o1.x = pk2(y[8], y[9]); o1.y = pk2(y[10], y[11]); o1.z = pk2(y[12], y[13]); o1.w = pk2(y[14], y[15]);
            *(v4u*)p = o0; *(v4u*)(p + 8) = o1;
        }
        {
            const int sl = lane & 31; bf16* p = AKV + (size_t)m * 512 + (lane >> 5) * 128 + sl * 4;
            const v2u w = *(const v2u*)p; float y[4] = {bflo(w.x), bfhi(w.x), bflo(w.y), bfhi(w.y)};
            float ss = y[0] * y[0] + y[1] * y[1] + y[2] * y[2] + y[3] * y[3];
            ss += __shfl_xor(ss, 1); ss += __shfl_xor(ss, 2); ss += __shfl_xor(ss, 4); ss += __shfl_xor(ss, 8); ss += __shfl_xor(ss, 16);
            const float rstd = 1.0f / sqrtf(ss * (1.f / 128.f) + EPSN);
#pragma unroll
            for (int i = 0; i < 4; ++i) y[i] = y[i] * rstd * a.k_norm_g[sl * 4 + i];
#pragma unroll
            for (int i = 0; i < 4; ++i) { const float o = __shfl_xor(y[i], 4); const float2 cs = RA[t * 16 + ((sl & 3) * 4 + i)];
                if (sl < 4) y[i] = y[i] * cs.x - o * cs.y; else if (sl < 8) y[i] = y[i] * cs.x + o * cs.y; }
            v2u o; o.x = pk2(y[0], y[1]); o.y = pk2(y[2], y[3]); *(v2u*)p = o;
        }
        {
            const int seg = lane & 7; bf16* p = IQ + (size_t)m * 512 + (lane >> 3) * 64 + seg * 8;
            const v4u w = *(const v4u*)p; float y[8] = {bflo(w.x), bfhi(w.x), bflo(w.y), bfhi(w.y), bflo(w.z), bfhi(w.z), bflo(w.w), bfhi(w.w)};
#pragma unroll
            for (int i = 0; i < 8; ++i) { const float o = __shfl_xor(y[i], 1); const float2 cs = RI[t * 8 + i];
                if (seg == 0) y[i] = y[i] * cs.x - o * cs.y; else if (seg == 1) y[i] = y[i] * cs.x + o * cs.y; }
            v4u o; o.x = pk2(y[0], y[1]); o.y = pk2(y[2], y[3]); o.z = pk2(y[4], y[5]); o.w = pk2(y[6], y[7]); *(v4u*)p = o;
        }
        {
            bf16* p = IK + (size_t)m * 64 + lane; float y = bf2f(*p); const float o = __shfl_xor(y, 8); const float2 cs = RI[t * 8 + (lane & 7)];
            if (lane < 8) y = y * cs.x - o * cs.y; else if (lane < 16) y = y * cs.x + o * cs.y;
            *p = (bf16)f2bf(y);
        }
    }
}
__device__ __forceinline__ void phase_p4b(const Args& a, int gw, int NGW, int lane) {
    bf16* H2 = (bf16*)(a.ws + WS_AQ);
    for (int m = gw; m < MROWS; m += NGW) rms_row_to_bf16(a.out + (size_t)m * DM, a.norm_mlp_g, H2 + (size_t)m * DM, lane);
}

__device__ __forceinline__ void gdn_naive_dev(int chain, int tid, LAS unsigned char* lb, const bf16* QKV, const bf16* Z, const float* SM, const float* conv_w, const float* a_log, const float* dt_bias,
                                              const float* gnorm_g, bf16* OG) {
    const int b = chain >> 3, h = chain & 7, lane = tid & 63, wave = tid >> 6;
    typedef float row128[128];
    LAS row128* sq = (LAS row128*)lb; LAS row128* sk = sq + 32; LAS row128* sv = sk + 32; LAS row128* so = sv + 32;
    LAS float* sdec = (LAS float*)(so + 32); LAS float* sbeta = sdec + 32;
    LAS row128* redA = (LAS row128*)(sbeta + 32); LAS row128* redB = redA + 2;
    float S[64];
#pragma unroll
    for (int i = 0; i < 64; ++i) S[i] = 0.f;
    const int col = tid & 127, half = tid >> 7;
    const float aexp = __expf(a_log[h]), dtb = dt_bias[h];
    for (int t0 = 0; t0 < SEQ; t0 += 32) {
        for (int e = tid; e < 32 * 384; e += 256) {
            const int tok = e / 384, cch = e % 384, which = cch >> 7, d = cch & 127, ch = which * 1024 + h * 128 + d, t = t0 + tok;
            float y = 0.f;
#pragma unroll
            for (int j = 0; j < 4; ++j) { const int tt = t - 3 + j; if (tt >= 0) y += conv_w[j * 3072 + ch] * bf2f(QKV[((size_t)b * SEQ + tt) * 3072 + ch]); }
            y = siluf_(y);
            if (which == 0) sq[tok][d] = y; else if (which == 1) sk[tok][d] = y; else sv[tok][d] = y;
        }
        __syncthreads();
        for (int vi = wave; vi < 64; vi += 4) { const int tok = vi >> 1; LAS float* p = (vi & 1) ? sk[tok] : sq[tok];
            const float x0 = p[lane], x1 = p[lane + 64]; const float ss = wave_sum(x0 * x0 + x1 * x1);
            float sc = 1.0f / sqrtf(ss + EPSN); if (!(vi & 1)) sc *= 0.08838834764831845f;
            p[lane] = x0 * sc; p[lane + 64] = x1 * sc; }
        if (tid < 32) { const size_t row = (size_t)b * SEQ + t0 + tid; const float ga = SM[row * 32 + h], gb = SM[row * 32 + 8 + h];
            sbeta[tid] = sigm_(gb); sdec[tid] = __expf(-aexp * softplusf_(ga + dtb)); }
        __syncthreads();
        for (int tok = 0; tok < 32; ++tok) {
            const float decay = sdec[tok]; const LAS float* kk = sk[tok] + half * 64; const LAS float* qq = sq[tok] + half * 64;
            float p = 0.f;
#pragma unroll
            for (int i = 0; i < 64; ++i) p += S[i] * kk[i];
            redA[half][col] = p; __syncthreads();
            const float kv = (redA[0][col] + redA[1][col]) * decay;
            const float delta = sbeta[tok] * (sv[tok][col] - kv);
            float po = 0.f;
#pragma unroll
            for (int i = 0; i < 64; ++i) { S[i] = decay * S[i] + kk[i] * delta; po += S[i] * qq[i]; }
            redB[half][col] = po; __syncthreads();
            if (half == 0) so[tok][col] = redB[0][col] + redB[1][col];
        }
        __syncthreads();
        for (int tok = wave; tok < 32; tok += 4) { const size_t row = (size_t)b * SEQ + t0 + tok;
            const float o0 = so[tok][lane], o1 = so[tok][lane + 64]; const float ss = wave_sum(o0 * o0 + o1 * o1);
            const float rstd = 1.0f / sqrtf(ss * (1.f / 128.f) + EPSN);
            const float z0 = bf2f(Z[row * 1024 + h * 128 + lane]), z1 = bf2f(Z[row * 1024 + h * 128 + lane + 64]);
            OG[row * 1024 + h * 128 + lane] = (bf16)f2bf(o0 * rstd * gnorm_g[lane] * siluf_(z0));
            OG[row * 1024 + h * 128 + lane + 64] = (bf16)f2bf(o1 * rstd * gnorm_g[lane + 64] * siluf_(z1)); }
        __syncthreads();
    }
}

__device__ __forceinline__ unsigned f2ord(float f) { if (f == 0.f) f = 0.f; const unsigned u = __builtin_bit_cast(unsigned, f); return (u & 0x80000000u) ? ~u : (u | 0x80000000u); }

__device__ __forceinline__ void topk_naive_dev(int bx, int G, int hf, int tid, LAS unsigned char* lb, const bf16* IQ, const bf16* IK, const float* SM, unsigned short* TOPK) {
    LAS float* sq = (LAS float*)lb; LAS float* sw = sq + 512; LAS unsigned* skey = (LAS unsigned*)(sw + 8); LAS unsigned* hist = skey + SEQ; LAS unsigned* smisc = hist + 256; LAS unsigned* scnt = smisc + 4;
    for (int pair = bx; pair < MROWS / 2; pair += G) {
        const int row = pair * 2 + hf, b = row >> 13, t = row & (SEQ - 1);
        unsigned short* outp = TOPK + (size_t)row * 256;
        if (t < 256) { outp[tid] = tid <= t ? (unsigned short)tid : (unsigned short)0xFFFF; continue; }
        sq[tid] = bf2f(IQ[(size_t)row * 512 + tid]); sq[tid + 256] = bf2f(IQ[(size_t)row * 512 + tid + 256]);
        if (tid < 8) sw[tid] = SM[(size_t)row * 32 + 16 + tid] * (0.35355339059327373f * 0.125f);
        if (tid == 0) smisc[2] = 0u;
        __syncthreads();
        const int n = t + 1;
        for (int s = tid; s < n; s += 256) {
            const v4u* kp = (const v4u*)(IK + ((size_t)b * SEQ + s) * 64); float k[64];
#pragma unroll
            for (int i = 0; i < 8; ++i) { const v4u w = kp[i]; k[8 * i] = bflo(w.x); k[8 * i + 1] = bfhi(w.x); k[8 * i + 2] = bflo(w.y); k[8 * i + 3] = bfhi(w.y); k[8 * i + 4] = bflo(w.z); k[8 * i + 5] = bfhi(w.z); k[8 * i + 6] = bflo(w.w); k[8 * i + 7] = bfhi(w.w); }
            float sc = 0.f;
#pragma unroll 1
            for (int hh = 0; hh < 8; ++hh) { float d = 0.f;
#pragma unroll
                for (int i = 0; i < 64; ++i) d += sq[hh * 64 + i] * k[i];
                sc += sw[hh] * fmaxf(d, 0.f); }
            skey[s] = f2ord(sc);
        }
        __syncthreads();
        unsigned prefix = 0u, mask = 0u, need = 256u;
        for (int pass = 0; pass < 4; ++pass) { const int shift = 24 - 8 * pass;
            hist[tid] = 0u; __syncthreads();
            for (int s = tid; s < n; s += 256) { const unsigned k = skey[s]; if ((k & mask) == prefix) atomicAdd((unsigned*)&hist[(k >> shift) & 255u], 1u); }
            __syncthreads();
            if (tid == 0) { unsigned cum = 0u; int d = 255; for (; d > 0; --d) { const unsigned c = hist[d]; if (cum + c >= need) break; cum += c; } smisc[0] = (unsigned)d; smisc[1] = need - cum; }
            __syncthreads();
            prefix |= smisc[0] << shift; mask |= 0xFFu << shift; need = smisc[1];
            __syncthreads();
        }
        const int per = (n + 255) / 256; const int s0 = tid * per, s1 = min(n, s0 + per);
        unsigned ceq = 0u;
        for (int s = s0; s < s1; ++s) { const unsigned k = skey[s]; if (k > prefix) { const unsigned pos = atomicAdd((unsigned*)&smisc[2], 1u); outp[pos] = (unsigned short)s; } else if (k == prefix) ++ceq; }
        scnt[tid] = ceq; __syncthreads();
        if (tid == 0) { unsigned run = 0u; for (int i = 0; i < 256; ++i) { const unsigned c = scnt[i]; scnt[i] = run; run += c; } }
        __syncthreads();
        const unsigned ngt = smisc[2]; unsigned rk = scnt[tid];
        for (int s = s0; s < s1; ++s) { if (skey[s] == prefix) { if (rk < need) outp[ngt + rk] = (unsigned short)s; ++rk; } }
        __syncthreads();
    }
}

__device__ __forceinline__ void attn_simple_dev(int bx, int G, int hf, int tid, LAS unsigned char* lb, bf16* AQ, const bf16* AKV, const unsigned short* TOPK) {
    const int lane = tid & 63, wave = tid >> 6;
    typedef float row256[256];
    LAS float* sq = (LAS float*)lb; LAS row256* sp = (LAS row256*)(sq + 1024); LAS int* sidx = (LAS int*)(sp + 8); LAS float* sred = (LAS float*)(sidx + 256);
    for (int pair = bx; pair < MROWS / 2; pair += G) {
        const int row = pair * 2 + hf, b = row >> 13;
        { const v2u w = *(const v2u*)(AQ + (size_t)row * 1024 + tid * 4); sq[tid * 4] = bflo(w.x); sq[tid * 4 + 1] = bfhi(w.x); sq[tid * 4 + 2] = bflo(w.y); sq[tid * 4 + 3] = bfhi(w.y); }
        const int idx = TOPK[(size_t)row * 256 + tid]; const bool valid = idx != 0xFFFF; sidx[tid] = valid ? idx : -1;
        __syncthreads();
        float lg[8];
        if (valid) { const bf16* kr = AKV + ((size_t)b * SEQ + idx) * 512;
#pragma unroll
            for (int c = 0; c < 2; ++c) { float acc4[4] = {0.f, 0.f, 0.f, 0.f};
                for (int i = 0; i < 16; ++i) { const v4u w = *(const v4u*)(kr + c * 128 + i * 8); const float kf[8] = {bflo(w.x), bfhi(w.x), bflo(w.y), bfhi(w.y), bflo(w.z), bfhi(w.z), bflo(w.w), bfhi(w.w)};
#pragma unroll
                    for (int g = 0; g < 4; ++g) { const LAS float* q = sq + (c * 4 + g) * 128 + i * 8;
#pragma unroll
                        for (int j = 0; j < 8; ++j) acc4[g] += q[j] * kf[j]; } }
#pragma unroll
                for (int g = 0; g < 4; ++g) lg[c * 4 + g] = acc4[g] * 0.08838834764831845f; }
        } else {
#pragma unroll
            for (int hh = 0; hh < 8; ++hh) lg[hh] = -INFINITY;
        }
#pragma unroll
        for (int hh = 0; hh < 8; ++hh) { float m = lg[hh];
#pragma unroll
            for (int o = 1; o < 64; o <<= 1) m = fmaxf(m, __shfl_xor(m, o));
            if (lane == 0) sred[hh * 4 + wave] = m; }
        __syncthreads();
        float ex[8];
#pragma unroll
        for (int hh = 0; hh < 8; ++hh) { const float m = fmaxf(fmaxf(sred[hh * 4], sred[hh * 4 + 1]), fmaxf(sred[hh * 4 + 2], sred[hh * 4 + 3])); ex[hh] = valid ? __expf(lg[hh] - m) : 0.f; }
        __syncthreads();
#pragma unroll
        for (int hh = 0; hh < 8; ++hh) { const float s = wave_sum(ex[hh]); if (lane == 0) sred[hh * 4 + wave] = s; }
        __syncthreads();
#pragma unroll
        for (int hh = 0; hh < 8; ++hh) { const float s = (sred[hh * 4] + sred[hh * 4 + 1]) + (sred[hh * 4 + 2] + sred[hh * 4 + 3]); sp[hh][tid] = ex[hh] / s; }
        __syncthreads();
        const int hh = tid >> 5, d0 = (tid & 31) * 4, c = hh >> 2; float o4[4] = {0.f, 0.f, 0.f, 0.f};
        for (int nn = 0; nn < 256; ++nn) { const int id = sidx[nn]; if (id < 0) continue; const float p = sp[hh][nn];
            const v2u w = *(const v2u*)(AKV + ((size_t)b * SEQ + id) * 512 + 256 + c * 128 + d0);
            o4[0] += p * bflo(w.x); o4[1] += p * bfhi(w.x); o4[2] += p * bflo(w.y); o4[3] += p * bfhi(w.y); }
        v2u o; o.x = pk2(o4[0], o4[1]); o.y = pk2(o4[2], o4[3]); *(v2u*)(AQ + (size_t)row * 1024 + tid * 4) = o;
        __syncthreads();
    }
}

namespace cg = cooperative_groups;
constexpr int NPHASE = 11;
__global__ void __launch_bounds__(NWAVES * 64, 2) fwd(Args a) {
    extern __shared__ __attribute__((aligned(16))) unsigned char lds_raw[];
    LAS unsigned char* lds = (LAS unsigned char*)lds_raw;
    const int tid = threadIdx.x, lane = tid & 63, wave = __builtin_amdgcn_readfirstlane(tid >> 6);
    const int G = gridDim.x, bx = blockIdx.x; const int vcu = (G % 8 == 0) ? (bx % 8) * (G / 8) + bx / 8 : bx;
    const int gw = vcu * NWAVES + wave, NGW = G * NWAVES;
    unsigned char* ws = a.ws;
    bf16* H = (bf16*)a.out; bf16* OG = (bf16*)a.out + (size_t)MROWS * DM;
    bf16* WinT = (bf16*)(ws + WS_WINT);
    const int lo = a.ph_lo, hi = a.ph_hi;
    const int vt = tid & 255, hf = tid >> 8; LAS unsigned char* lb = lds + hf * 69632;
#define IN(k) (lo <= (k) && (k) < hi)
#define SEAM(k) do { if (IN(k) && IN((k) + 1)) cg::this_grid().sync(); } while (0)
    if (IN(0)) phase_p0(a, lds, gw, NGW, wave, lane);
    SEAM(0);
    if (IN(1)) {
        pg8::Gemm g{H, WinT, MROWS, N_IN1, DM}; pg8::StaticOrder S; S.init(MROWS, N_IN1, G, bx);
        pg8::EpiInProj E{(bf16*)(ws + WS_QKV), (bf16*)(ws + WS_Z), (bf16*)(ws + WS_AQ), (bf16*)(ws + WS_AKV), (bf16*)(ws + WS_IQ), (bf16*)(ws + WS_IK), (bf16*)(ws + WS_HALO), (float*)(ws + WS_SM)};
        pg8::gemm_phase<pg8::EpiInProj, pg8::StaticOrder, PG8_ALIGN, PG8_SP2>(lds, g, S, E);
    }
    SEAM(1);
    if (IN(2)) phase_p1b(a, gw, NGW, lane);
    SEAM(2);
    if (IN(3)) { if (bx < 16) gdn_naive_dev(bx * 2 + hf, vt, lb, (const bf16*)(ws + WS_QKV), (const bf16*)(ws + WS_Z), (const float*)(ws + WS_SM), a.conv_w, a.a_log, a.dt_bias, a.gdn_norm_g, OG); }
    SEAM(3);
    if (IN(4)) topk_naive_dev(bx, G, hf, vt, lb, (const bf16*)(ws + WS_IQ), (const bf16*)(ws + WS_IK), (const float*)(ws + WS_SM), (unsigned short*)(ws + WS_TOPK));
    SEAM(4);
    if (IN(5)) attn_simple_dev(bx, G, hf, vt, lb, (bf16*)(ws + WS_AQ), (const bf16*)(ws + WS_AKV), (const unsigned short*)(ws + WS_TOPK));
    SEAM(5);
    if (IN(6)) {
        pg8::Gemm g{H, WinT + (size_t)N_IN1 * DM, MROWS, 2048, DM}; pg8::StaticOrder S; S.init(MROWS, 2048, G, bx);
        pg8::EpiGate E{OG, 1024, (const bf16*)(ws + WS_AQ), 1024, (bf16*)(ws + WS_Z)};
        pg8::gemm_phase<pg8::EpiGate, pg8::StaticOrder, PG8_ALIGN, PG8_SP2>(lds, g, S, E);
    }
    SEAM(6);
    if (IN(7)) {
        pg8::Gemm g{(const bf16*)(ws + WS_Z), (const bf16*)(ws + WS_WOT), MROWS, DM, DM}; pg8::StaticOrder S; S.init(MROWS, DM, G, bx);
        pg8::EpiResF32 E{a.x, a.out};
        pg8::gemm_phase<pg8::EpiResF32, pg8::StaticOrder, PG8_ALIGN, PG8_SP2>(lds, g, S, E);
    }
    SEAM(7);
    if (IN(8)) phase_p4b(a, gw, NGW, lane);
    SEAM(8);
    if (IN(9)) {
        pg8::Gemm g{(const bf16*)(ws + WS_AQ), (const bf16*)(ws + WS_WUT), MROWS, DFF, DM}; pg8::StaticOrder S; S.init(MROWS, DFF, G, bx);
        pg8::EpiRelu2 E{(bf16*)(ws + WS_HID), DFF};
        pg8::gemm_phase<pg8::EpiRelu2, pg8::StaticOrder, PG8_ALIGN, PG8_SP2>(lds, g, S, E);
    }
    SEAM(9);
    if (IN(10)) {
        pg8::Gemm g{(const bf16*)(ws + WS_HID), (const bf16*)(ws + WS_WDT), MROWS, DM, DFF}; pg8::StaticOrder S; S.init(MROWS, DM, G, bx);
        pg8::EpiResF32 E{a.out, a.out};
        pg8::gemm_phase<pg8::EpiResF32, pg8::StaticOrder, PG8_ALIGN, PG8_SP2>(lds, g, S, E);
    }
}

#ifndef MK_ONE_LAUNCH
#define MK_ONE_LAUNCH 1
#endif
extern "C" void kernel_launch(void* const* d_in, const int* in_sizes, int n_in, void* d_out, int out_size, void* d_ws, size_t ws_size, hipStream_t stream) {
    static int grid = 0;
    if (grid == 0) {
        if (n_in != 13 || in_sizes[0] != MROWS * DM || out_size != MROWS * DM || ws_size < WS_NEED) { fprintf(stderr, "kernel_launch: unexpected shapes/workspace (%d inputs, ws %zu)\n", n_in, ws_size); grid = -1; return; }
        if (hipFuncSetAttribute((const void*)fwd, hipFuncAttributeMaxDynamicSharedMemorySize, LDS_BYTES) != hipSuccess) { fprintf(stderr, "kernel_launch: hipFuncSetAttribute failed\n"); grid = -1; return; }
        int dev = 0, cus = 0, per_cu = 0;
        hipGetDevice(&dev); hipDeviceGetAttribute(&cus, hipDeviceAttributeMultiprocessorCount, dev);
        hipOccupancyMaxActiveBlocksPerMultiprocessor(&per_cu, (const void*)fwd, NWAVES * 64, LDS_BYTES);
        if (per_cu < 1 || cus < 1) { fprintf(stderr, "kernel_launch: occupancy query says %d blocks/CU on %d CUs\n", per_cu, cus); grid = -1; return; }
        grid = cus;
    }
    if (grid < 0) return;
    Args a{};
    a.x = (const float*)d_in[0]; a.norm_mix_g = (const float*)d_in[1]; a.w_in = (const float*)d_in[2]; a.conv_w = (const float*)d_in[3]; a.a_log = (const float*)d_in[4];
    a.dt_bias = (const float*)d_in[5]; a.gdn_norm_g = (const float*)d_in[6]; a.q_norm_g = (const float*)d_in[7]; a.k_norm_g = (const float*)d_in[8]; a.w_out = (const float*)d_in[9];
    a.norm_mlp_g = (const float*)d_in[10]; a.w_up = (const float*)d_in[11]; a.w_down = (const float*)d_in[12];
    a.out = (float*)d_out; a.ws = (unsigned char*)d_ws;
#if MK_ONE_LAUNCH
    a.ph_lo = 0; a.ph_hi = NPHASE;
    void* args[] = {&a};
    hipError_t e = hipLaunchCooperativeKernel((const void*)fwd, dim3(grid), dim3(NWAVES * 64), args, LDS_BYTES, stream);
    if (e != hipSuccess) fprintf(stderr, "cooperative launch failed: %s (grid %d)\n", hipGetErrorString(e), grid);
#else
    for (int p = 0; p < NPHASE; ++p) { a.ph_lo = p; a.ph_hi = p + 1; hipLaunchKernelGGL(fwd, dim3(grid), dim3(NWAVES * 64), LDS_BYTES, stream, a); }
#endif
}
```

```cpp
#include <hip/hip_runtime.h>
#include <hip/hip_cooperative_groups.h>
#include <cstdio>
#include <cstdint>
namespace pg8 {
#define PG8_LAS __attribute__((address_space(3)))
typedef unsigned short bf16_t;
typedef short bf16x8 __attribute__((ext_vector_type(8)));
typedef float f32x4 __attribute__((ext_vector_type(4)));
typedef unsigned u32x4 __attribute__((ext_vector_type(4)));
constexpr int BM = 256, BK = 64, HALF = 128, HTB = HALF * BK * 2  , STAGE_BYTES = 8 * HTB, NXCD = 8, WGM = 8;

__host__ __device__ __forceinline__ int lds_byte(int r, int c) { const int st = (r >> 4) * 2 + (c >> 5), rr = r & 15, cc = c & 31, ob = rr * 64 + cc * 2; return st * 1024 + (ob ^ (((ob >> 9) & 1) << 5)); }
__host__ __device__ __forceinline__ void stage_rc(int b, int& R, int& C) { const int st = b / 1024, sb = b % 1024, swz = sb ^ (((sb >> 9) & 1) << 5); R = (st >> 1) * 16 + swz / 64; C = (st & 1) * 32 + (swz % 64) / 2; }
__host__ __device__ __forceinline__ int perm32(int rho) { const int n = rho >> 4, i = rho & 15; return 8 * (i >> 2) + 4 * n + (i & 3); }

struct Unit { int pm, pn; };
struct Gemm { const bf16_t* A; const bf16_t* Bt; int M, N, K; };

struct StaticOrder {
    int nM, nN, nwg, G, c;
    __host__ __device__ void init(int M, int N, int G_, int c_) { nM = M / BM; nN = N / BM; nwg = nM * nN; G = G_; c = c_; }
    __host__ __device__ bool next(int i, Unit& u) const {
        const long L = (long)i * G + c; if (L >= nwg) return false;
        int wgid = (int)L; { const int q = nwg / NXCD, r = nwg % NXCD, xcd = wgid % NXCD, off = wgid / NXCD; wgid = (xcd < r ? xcd * (q + 1) : r * (q + 1) + (xcd - r) * q) + off; }
        const int nig = WGM * nN, gid = wgid / nig, fm = gid * WGM, gsz = (nM - fm) < WGM ? (nM - fm) : WGM;
        u.pm = fm + ((wgid % nig) % gsz); u.pn = (wgid % nig) / gsz; return true;
    }
    __device__ __forceinline__ void a_ready(const Unit&) const {}
    __device__ __forceinline__ void done(const Unit&) const {}
};

__device__ __forceinline__ unsigned cvt_pk_bf16(float lo, float hi) { unsigned r; asm volatile("v_cvt_pk_bf16_f32 %0, %1, %2" : "=v"(r) : "v"(lo), "v"(hi)); return r; }
typedef unsigned u32x2 __attribute__((ext_vector_type(2)));
__device__ __forceinline__ float bf_lo(unsigned w) { return __builtin_bit_cast(float, w << 16); }
__device__ __forceinline__ float bf_hi(unsigned w) { return __builtin_bit_cast(float, w & 0xffff0000u); }
__device__ __forceinline__ float sigmoidf_(float x) { return 1.0f / (1.0f + __expf(-x)); }

struct EpiInProj {
    static constexpr bool PERM = true, AFTER_DRAIN = false;
    bf16_t *QKV, *Z, *AQ, *AKV, *IQ, *IK, *HALO; float* SM;
    __device__ __forceinline__ void operator()(const f32x4 (&acc)[2][2][4][2], const Unit& u, int wr, int wc, int fr, int fq) const {
        const int pn = u.pn; const int row0 = u.pm * BM + wr * 64 + fr;
        if (pn < 24) {
            bf16_t* base; int ldc, colt;
            if (pn < 12) { base = QKV; ldc = 3072; colt = pn * 256; }
            else if (pn < 16) { base = Z; ldc = 1024; colt = (pn - 12) * 256; }
            else if (pn < 20) { base = AQ; ldc = 1024; colt = (pn - 16) * 256; }
            else if (pn < 22) { base = AKV; ldc = 512; colt = (pn - 20) * 256; }
            else { base = IQ; ldc = 512; colt = (pn - 22) * 256; }
            const int col0 = colt + wc * 32 + 8 * fq;
#pragma unroll
            for (int ai = 0; ai < 2; ++ai)
#pragma unroll
                for (int m = 0; m < 4; ++m) { const int row = row0 + ai * HALF + m * 16; bf16_t* rowp = base + (size_t)row * ldc + col0;
#pragma unroll
                    for (int bj = 0; bj < 2; ++bj) { const f32x4 v0 = acc[ai][bj][m][0], v1 = acc[ai][bj][m][1];
                        u32x4 w; w.x = cvt_pk_bf16(v0[0], v0[1]); w.y = cvt_pk_bf16(v0[2], v0[3]); w.z = cvt_pk_bf16(v1[0], v1[1]); w.w = cvt_pk_bf16(v1[2], v1[3]);
                        *(u32x4*)(rowp + bj * HALF) = w;
                        if (pn < 12 && m == 3 && fr >= 13) *(u32x4*)(HALO + ((size_t)(row >> 6) * 3 + (fr - 13)) * 3072 + col0 + bj * HALF) = w; } }
        } else {
#pragma unroll
            for (int ai = 0; ai < 2; ++ai)
#pragma unroll
                for (int m = 0; m < 4; ++m) { const int row = row0 + ai * HALF + m * 16; const f32x4 v0 = acc[ai][0][m][0], v1 = acc[ai][0][m][1];
                    if (wc < 2) { u32x4 w; w.x = cvt_pk_bf16(v0[0], v0[1]); w.y = cvt_pk_bf16(v0[2], v0[3]); w.z = cvt_pk_bf16(v1[0], v1[1]); w.w = cvt_pk_bf16(v1[2], v1[3]);
                        *(u32x4*)(IK + (size_t)row * 64 + wc * 32 + 8 * fq) = w; }
                    else if (wc == 2 && fq < 3) { float* p = SM + (size_t)row * 32 + 8 * fq; *(f32x4*)p = v0; *(f32x4*)(p + 4) = v1; } }
        }
    }
};
struct EpiGate {
    static constexpr bool PERM = true, AFTER_DRAIN = false;
    const bf16_t* OG; int ldog; const bf16_t* OA; int ldoa; bf16_t* MG;
    __device__ __forceinline__ void operator()(const f32x4 (&acc)[2][2][4][2], const Unit& u, int wr, int wc, int fr, int fq) const {
        const int row0 = u.pm * BM + wr * 64 + fr; const int ch0 = u.pn * 128 + wc * 32 + 8 * fq;
#pragma unroll
        for (int ai = 0; ai < 2; ++ai)
#pragma unroll
            for (int m = 0; m < 4; ++m) { const int row = row0 + ai * HALF + m * 16;
                const u32x4 og = *(const u32x4*)(OG + (size_t)row * ldog + ch0); const u32x4 oa = *(const u32x4*)(OA + (size_t)row * ldoa + ch0);
                const f32x4 a0 = acc[ai][0][m][0], a1 = acc[ai][0][m][1], b0 = acc[ai][1][m][0], b1 = acc[ai][1][m][1];
                float r[8];
                r[0] = sigmoidf_(a0[0]) * bf_lo(og.x) + sigmoidf_(b0[0]) * bf_lo(oa.x); r[1] = sigmoidf_(a0[1]) * bf_hi(og.x) + sigmoidf_(b0[1]) * bf_hi(oa.x);
                r[2] = sigmoidf_(a0[2]) * bf_lo(og.y) + sigmoidf_(b0[2]) * bf_lo(oa.y); r[3] = sigmoidf_(a0[3]) * bf_hi(og.y) + sigmoidf_(b0[3]) * bf_hi(oa.y);
                r[4] = sigmoidf_(a1[0]) * bf_lo(og.z) + sigmoidf_(b1[0]) * bf_lo(oa.z); r[5] = sigmoidf_(a1[1]) * bf_hi(og.z) + sigmoidf_(b1[1]) * bf_hi(oa.z);
                r[6] = sigmoidf_(a1[2]) * bf_lo(og.w) + sigmoidf_(b1[2]) * bf_lo(oa.w); r[7] = sigmoidf_(a1[3]) * bf_hi(og.w) + sigmoidf_(b1[3]) * bf_hi(oa.w);
                u32x4 w; w.x = cvt_pk_bf16(r[0], r[1]); w.y = cvt_pk_bf16(r[2], r[3]); w.z = cvt_pk_bf16(r[4], r[5]); w.w = cvt_pk_bf16(r[6], r[7]);
                *(u32x4*)(MG + (size_t)row * 1024 + ch0) = w; }
    }
};
struct EpiResF32 {
    static constexpr bool PERM = false, AFTER_DRAIN = false;
    const float* base; float* out;
    __device__ __forceinline__ void operator()(const f32x4 (&acc)[2][2][4][2], const Unit& u, int wr, int wc, int fr, int fq) const {
        const int col0 = u.pn * BM + wc * 32 + 4 * fq;
#pragma unroll
        for (int ai = 0; ai < 2; ++ai)
#pragma unroll
            for (int m = 0; m < 4; ++m) { const size_t off = (size_t)(u.pm * BM + ai * HALF + wr * 64 + m * 16 + fr) * 1024 + col0;
#pragma unroll
                for (int bj = 0; bj < 2; ++bj)
#pragma unroll
                    for (int n = 0; n < 2; ++n) { const f32x4 bs = *(const f32x4*)(base + off + bj * HALF + n * 16); *(f32x4*)(out + off + bj * HALF + n * 16) = bs + acc[ai][bj][m][n]; } }
    }
};
struct EpiRelu2 {
    static constexpr bool PERM = true, AFTER_DRAIN = false;
    bf16_t* O; int ldc;
    __device__ __forceinline__ void operator()(const f32x4 (&acc)[2][2][4][2], const Unit& u, int wr, int wc, int fr, int fq) const {
        const int row0 = u.pm * BM + wr * 64 + fr; const int col0 = u.pn * BM + wc * 32 + 8 * fq;
#pragma unroll
        for (int ai = 0; ai < 2; ++ai)
#pragma unroll
            for (int m = 0; m < 4; ++m) { bf16_t* rowp = O + (size_t)(row0 + ai * HALF + m * 16) * ldc + col0;
#pragma unroll
                for (int bj = 0; bj < 2; ++bj) { f32x4 v0 = acc[ai][bj][m][0], v1 = acc[ai][bj][m][1];
#pragma unroll
                    for (int i = 0; i < 4; ++i) { const float a = fmaxf(v0[i], 0.f), b = fmaxf(v1[i], 0.f); v0[i] = a * a; v1[i] = b * b; }
                    u32x4 w; w.x = cvt_pk_bf16(v0[0], v0[1]); w.y = cvt_pk_bf16(v0[2], v0[3]); w.z = cvt_pk_bf16(v1[0], v1[1]); w.w = cvt_pk_bf16(v1[2], v1[3]);
                    *(u32x4*)(rowp + bj * HALF) = w; } }
    }
};
template <class Epi, class Sched, bool ALIGN_EPI = false, bool SP2 = false>
__device__ __forceinline__ void gemm_phase(PG8_LAS unsigned char* lds, const Gemm g, const Sched& S, const Epi& E) {
    const int tid = threadIdx.x, wid = __builtin_amdgcn_readfirstlane(tid >> 6), lane = tid & 63, wr = wid >> 2, wc = wid & 3, fr = lane & 15, fq = lane >> 4;
    const int K = g.K, nt = K / BK;
    unsigned voffA[2], voffB[2];
#pragma unroll
    for (int i = 0; i < 2; ++i) { int R, C; stage_rc(tid * 16 + i * 8192, R, C); const int Rb = Epi::PERM ? ((R & ~31) + perm32(R & 31)) : R;
        voffA[i] = (unsigned)(R * K + C) * 2u; voffB[i] = (unsigned)(Rb * K + C) * 2u; }
    const size_t kstep = (size_t)(BK * 2);
    const size_t hstep = (size_t)HALF * K * 2;
    const size_t tstep = 2 * hstep;
    const unsigned ldsw = (unsigned)wid * 1024u;
    const int aoff = lds_byte(wr * 64 + fr, fq * 8), boff = lds_byte(wc * 32 + fr, fq * 8);
#define PG8_SA(b, h) (((b) * 2 + (h)) * HTB)
#define PG8_SB(b, h) ((4 + (b) * 2 + (h)) * HTB)
#define PG8_STAGE(bufoff, gbase, voff) do { _Pragma("unroll") for (int _i = 0; _i < 2; ++_i) \
        __builtin_amdgcn_global_load_lds((const unsigned*)((const char*)(gbase) + (voff)[_i]), (PG8_LAS unsigned*)(lds + (bufoff) + ldsw + _i * 8192), 16, 0, 0); } while (0)
#define PG8_LDA(dst, b, h) do { _Pragma("unroll") for (int m = 0; m < 4; ++m) _Pragma("unroll") for (int k = 0; k < 2; ++k) dst[m][k] = *(const PG8_LAS bf16x8*)(lds + PG8_SA(b, h) + aoff + m * 2048 + k * 1024); } while (0)
#define PG8_LDB(dst, b, h) do { _Pragma("unroll") for (int n = 0; n < 2; ++n) _Pragma("unroll") for (int k = 0; k < 2; ++k) dst[n][k] = *(const PG8_LAS bf16x8*)(lds + PG8_SB(b, h) + boff + n * 2048 + k * 1024); } while (0)
#define PG8_MMA(ai, bj, At, Bt) do { __builtin_amdgcn_s_setprio(1); _Pragma("unroll") for (int m = 0; m < 4; ++m) _Pragma("unroll") for (int n = 0; n < 2; ++n) _Pragma("unroll") for (int k = 0; k < 2; ++k) \
        acc[ai][bj][m][n] = __builtin_amdgcn_mfma_f32_16x16x32_bf16(Bt[n][k], At[m][k], acc[ai][bj][m][n], 0, 0, 0); __builtin_amdgcn_s_setprio(0); } while (0)
#define PG8_WAIT_V(n) asm volatile("s_waitcnt vmcnt(" #n ")" ::: "memory")
#define PG8_WAIT_L(n) asm volatile("s_waitcnt lgkmcnt(" #n ")" ::: "memory")
#define PG8_BAR __builtin_amdgcn_s_barrier()
#define PG8_SCHED __builtin_amdgcn_sched_barrier(0)
    Unit cur, nxt; int ui = 0;
    if (!S.next(0, cur)) return;
    f32x4 acc[2][2][4][2];
#pragma unroll
    for (int a = 0; a < 2; ++a)
#pragma unroll
        for (int b = 0; b < 2; ++b)
#pragma unroll
            for (int m = 0; m < 4; ++m)
#pragma unroll
                for (int n = 0; n < 2; ++n) acc[a][b][m][n] = (f32x4){0.f, 0.f, 0.f, 0.f};
    bf16x8 At[4][2], B0[2][2], B1[2][2];
    const char* cA = (const char*)g.A + (size_t)cur.pm * tstep; const char* cB = (const char*)g.Bt + (size_t)cur.pn * tstep;
    S.a_ready(cur);
    if constexpr (SP2) {
        PG8_STAGE(PG8_SB(0, 0), cB, voffB); PG8_STAGE(PG8_SB(0, 1), cB + hstep, voffB); PG8_STAGE(PG8_SA(0, 0), cA, voffA); PG8_STAGE(PG8_SA(0, 1), cA + hstep, voffA);
        if (wr == 1) PG8_BAR;
        PG8_WAIT_V(2); PG8_BAR;
        PG8_STAGE(PG8_SB(1, 0), cB + kstep, voffB); PG8_STAGE(PG8_SA(1, 0), cA + kstep, voffA); PG8_STAGE(PG8_SB(1, 1), cB + hstep + kstep, voffB);
        PG8_WAIT_V(6); PG8_BAR;
    } else {
        PG8_STAGE(PG8_SB(0, 0), cB, voffB); PG8_STAGE(PG8_SA(0, 0), cA, voffA); PG8_STAGE(PG8_SB(0, 1), cB + hstep, voffB); PG8_STAGE(PG8_SA(0, 1), cA + hstep, voffA);
        if (wr == 1) PG8_BAR;
        PG8_WAIT_V(4); PG8_BAR;
        PG8_STAGE(PG8_SB(1, 0), cB + kstep, voffB); PG8_STAGE(PG8_SA(1, 0), cA + kstep, voffA); PG8_STAGE(PG8_SB(1, 1), cB + hstep + kstep, voffB);
        PG8_WAIT_V(6); PG8_BAR;
    }
    for (;;) {
        const bool has_next = S.next(ui + 1, nxt);
        const char* nA = has_next ? (const char*)g.A + (size_t)nxt.pm * tstep : cA; const char* nB = has_next ? (const char*)g.Bt + (size_t)nxt.pn * tstep : cB;
        for (int t = 0; t < nt; t += 2) {
            const bool last = (t == nt - 2);
            const char* a1 = cA + (size_t)(t + 1) * kstep;
            const char* a2 = last ? nA : cA + (size_t)(t + 2) * kstep; const char* b2 = last ? nB : cB + (size_t)(t + 2) * kstep;
            const char* a3 = a2 + kstep; const char* b3 = b2 + kstep;
            if (last && has_next) S.a_ready(nxt);
            if constexpr (SP2) {
            PG8_LDB(B0, 0, 0); PG8_LDB(B1, 0, 1); PG8_SCHED; PG8_LDA(At, 0, 0); PG8_STAGE(PG8_SA(1, 1), a1 + hstep, voffA);
            PG8_WAIT_V(8); PG8_WAIT_L(0); PG8_BAR; PG8_MMA(0, 0, At, B0); PG8_MMA(0, 1, At, B1); PG8_BAR; PG8_SCHED;
            PG8_LDA(At, 0, 1); PG8_STAGE(PG8_SB(0, 0), b2, voffB); PG8_STAGE(PG8_SB(0, 1), b2 + hstep, voffB); PG8_STAGE(PG8_SA(0, 0), a2, voffA);
            PG8_WAIT_V(8); PG8_WAIT_L(0); PG8_BAR; PG8_MMA(1, 0, At, B0); PG8_MMA(1, 1, At, B1); PG8_BAR; PG8_SCHED;
            PG8_LDB(B0, 1, 0); PG8_LDB(B1, 1, 1); PG8_SCHED; PG8_LDA(At, 1, 0); PG8_STAGE(PG8_SA(0, 1), a2 + hstep, voffA);
            PG8_WAIT_V(8); PG8_WAIT_L(0); PG8_BAR; PG8_MMA(0, 0, At, B0); PG8_MMA(0, 1, At, B1); PG8_BAR; PG8_SCHED;
            PG8_LDA(At, 1, 1); PG8_STAGE(PG8_SB(1, 0), b3, voffB); PG8_STAGE(PG8_SB(1, 1), b3 + hstep, voffB); PG8_STAGE(PG8_SA(1, 0), a3, voffA);
            PG8_WAIT_V(8); PG8_WAIT_L(0); PG8_BAR; PG8_MMA(1, 0, At, B0); PG8_MMA(1, 1, At, B1); PG8_BAR; PG8_SCHED;
            } else {
            PG8_LDB(B0, 0, 0); PG8_SCHED; PG8_LDA(At, 0, 0); PG8_STAGE(PG8_SA(1, 1), a1 + hstep, voffA);
            PG8_WAIT_L(8); PG8_BAR; PG8_WAIT_L(0); PG8_MMA(0, 0, At, B0); PG8_BAR; PG8_SCHED;
            PG8_LDB(B1, 0, 1); PG8_STAGE(PG8_SB(0, 0), b2, voffB);
            PG8_BAR; PG8_WAIT_L(0); PG8_MMA(0, 1, At, B1); PG8_BAR;
            PG8_LDA(At, 0, 1); PG8_STAGE(PG8_SA(0, 0), a2, voffA);
            PG8_BAR; PG8_WAIT_L(0); PG8_MMA(1, 0, At, B0); PG8_BAR; PG8_SCHED;
            PG8_STAGE(PG8_SB(0, 1), b2 + hstep, voffB);
            PG8_WAIT_V(6); PG8_BAR; PG8_MMA(1, 1, At, B1); PG8_BAR;
            PG8_LDB(B0, 1, 0); PG8_SCHED; PG8_LDA(At, 1, 0); PG8_STAGE(PG8_SA(0, 1), a2 + hstep, voffA);
            PG8_WAIT_L(8); PG8_BAR; PG8_WAIT_L(0); PG8_MMA(0, 0, At, B0); PG8_BAR; PG8_SCHED;
            PG8_LDB(B1, 1, 1); PG8_STAGE(PG8_SB(1, 0), b3, voffB);
            PG8_BAR; PG8_WAIT_L(0); PG8_MMA(0, 1, At, B1); PG8_BAR;
            PG8_LDA(At, 1, 1); PG8_STAGE(PG8_SA(1, 0), a3, voffA);
            PG8_BAR; PG8_WAIT_L(0); PG8_MMA(1, 0, At, B0); PG8_BAR; PG8_SCHED;
            PG8_STAGE(PG8_SB(1, 1), b3 + hstep, voffB);
            PG8_WAIT_V(6); PG8_BAR; PG8_MMA(1, 1, At, B1); PG8_BAR;
            }
        }
        if constexpr (ALIGN_EPI) { if (wr == 0) PG8_BAR; }
        if constexpr (!Epi::AFTER_DRAIN) { E(acc, cur, wr, wc, fr, fq); S.done(cur); }
        if (!has_next) break;
#pragma unroll
        for (int a = 0; a < 2; ++a)
#pragma unroll
            for (int b = 0; b < 2; ++b)
#pragma unroll
                for (int m = 0; m < 4; ++m)
#pragma unroll
                    for (int n = 0; n < 2; ++n) acc[a][b][m][n] = (f32x4){0.f, 0.f, 0.f, 0.f};
        cur = nxt; cA = nA; cB = nB; ++ui;
        if constexpr (ALIGN_EPI) { if (wr == 1) PG8_BAR; }
    }
    PG8_WAIT_V(0);
    if constexpr (!ALIGN_EPI) { if (wr == 0) PG8_BAR; }
    PG8_BAR;
    if constexpr (Epi::AFTER_DRAIN) { E.fused(acc, cur, wr, wc, fr, fq, lds, wid, lane); S.done(cur); }
#undef PG8_SA
#undef PG8_SB
#undef PG8_STAGE
#undef PG8_LDA
#undef PG8_LDB
#undef PG8_MMA
#undef PG8_WAIT_V
#undef PG8_WAIT_L
#undef PG8_BAR
#undef PG8_SCHED
}
}

#ifndef PG8_SP2
#define PG8_SP2 true
#endif
#ifndef PG8_ALIGN
#define PG8_ALIGN true
#endif
constexpr int NB = 4, SEQ = 8192, DM = 1024, MROWS = NB * SEQ, DFF = 4096;
constexpr int NWAVES = 8;
constexpr float EPSN = 1e-6f;
constexpr int N_IN1 = 6400;
constexpr int N_INT = 8448;
constexpr size_t MiB = 1u << 20;
constexpr size_t WS_CTL = 0, CTL_ZERO_BYTES = 1 * MiB;
constexpr size_t WS_ROPEI = 1 * MiB;
constexpr size_t WS_ROPEA = 1 * MiB + 512 * 1024;
constexpr size_t WS_WINT = 3 * MiB;
constexpr size_t WS_WOT = 20 * MiB, WS_WUT = 22 * MiB, WS_WDT = 30 * MiB;
constexpr size_t WS_QKV = 40 * MiB;
constexpr size_t WS_Z = 232 * MiB;
constexpr size_t WS_AQ = 296 * MiB;
constexpr size_t WS_AKV = 360 * MiB;
constexpr size_t WS_IQ = 392 * MiB;
constexpr size_t WS_IK = 424 * MiB;
constexpr size_t WS_SM = 428 * MiB;
constexpr size_t WS_HALO = 432 * MiB;
constexpr size_t WS_TOPK = 442 * MiB;
constexpr size_t WS_HID = 40 * MiB;
constexpr size_t WS_NEED = 460 * MiB;

constexpr int LDS_BYTES = 163840;

#define GAS __attribute__((address_space(1)))
#define LAS __attribute__((address_space(3)))
typedef unsigned short bf16;
typedef unsigned v4u __attribute__((ext_vector_type(4)));
typedef unsigned v2u __attribute__((ext_vector_type(2)));
typedef float f32x4 __attribute__((ext_vector_type(4)));
#define LDS_WAIT() asm volatile("s_waitcnt lgkmcnt(0)" ::: "memory")
__device__ __forceinline__ unsigned f2bf(float f) { unsigned u = __builtin_bit_cast(unsigned, f); return (u + 0x7fffu + ((u >> 16) & 1u)) >> 16; }
__device__ __forceinline__ unsigned pk2(float lo, float hi) { return f2bf(lo) | (f2bf(hi) << 16); }
__device__ __forceinline__ float bflo(unsigned w) { return __builtin_bit_cast(float, w << 16); }
__device__ __forceinline__ float bfhi(unsigned w) { return __builtin_bit_cast(float, w & 0xffff0000u); }
__device__ __forceinline__ float bf2f(bf16 v) { return __builtin_bit_cast(float, ((unsigned)v) << 16); }
__device__ __forceinline__ float wave_sum(float v) {
#pragma unroll
    for (int o = 1; o < 64; o <<= 1) v += __shfl_xor(v, o);
    return v;
}
__device__ __forceinline__ float siluf_(float x) { return x / (1.0f + __expf(-x)); }
__device__ __forceinline__ float sigm_(float x) { return 1.0f / (1.0f + __expf(-x)); }
__device__ __forceinline__ float softplusf_(float x) { return x > 20.f ? x : log1pf(__expf(x)); }

struct Args {
    const float* x; const float* norm_mix_g; const float* w_in; const float* conv_w; const float* a_log; const float* dt_bias;
    const float* gdn_norm_g; const float* q_norm_g; const float* k_norm_g; const float* w_out; const float* norm_mlp_g; const float* w_up; const float* w_down;
    float* out; unsigned char* ws; int ph_lo, ph_hi;
};

__device__ __forceinline__ int win_src_col(int n) {
    if (n < 4096) return n;
    if (n < 6208) return n + 16;
    if (n < 6216) return 4096 + (n - 6208);
    if (n < 6224) return 4104 + (n - 6216);
    if (n < 6232) return 6224 + (n - 6224);
    if (n < 6400) return -1;
    const int j = (n - 6400) >> 8, i = (n - 6400) & 255;
    return i < 128 ? 6232 + 128 * j + i : 7256 + 128 * j + (i - 128);
}
template <bool PERMUTE>
__device__ __forceinline__ void transpose_item(const float* W, int K, int Nsrc, bf16* WT, int n0, int k0, LAS float* scr, int lane) {
    const int nd = n0 + (lane & 31); const int sc = PERMUTE ? win_src_col(nd) : nd;
#pragma unroll 8
    for (int i = 0; i < 32; ++i) { const int kk = 2 * i + (lane >> 5); scr[kk * 33 + (lane & 31)] = sc >= 0 ? W[(size_t)(k0 + kk) * Nsrc + sc] : 0.f; }
    LDS_WAIT(); asm volatile("" ::: "memory");
    const int c = lane & 7;
#pragma unroll
    for (int j = 0; j < 4; ++j) { const int n = (lane >> 3) + 8 * j; const LAS float* s = scr + (8 * c) * 33 + n;
        v4u o; o.x = pk2(s[0 * 33], s[1 * 33]); o.y = pk2(s[2 * 33], s[3 * 33]); o.z = pk2(s[4 * 33], s[5 * 33]); o.w = pk2(s[6 * 33], s[7 * 33]);
        *(GAS v4u*)(WT + (size_t)(n0 + n) * K + k0 + 8 * c) = o; }
    LDS_WAIT(); asm volatile("" ::: "memory");
}
__device__ __forceinline__ void rms_row_to_bf16(const float* xrow, const float* g, bf16* orow, int lane) {
    const GAS f32x4* xr = (const GAS f32x4*)xrow + lane; const GAS f32x4* gr = (const GAS f32x4*)g + lane;
    f32x4 v[4]; float s = 0.f;
#pragma unroll
    for (int j = 0; j < 4; ++j) { v[j] = xr[64 * j]; s += (v[j].x * v[j].x + v[j].y * v[j].y) + (v[j].z * v[j].z + v[j].w * v[j].w); }
    const float rstd = 1.0f / sqrtf(wave_sum(s) * (1.f / DM) + EPSN);
    GAS unsigned long long* o8 = (GAS unsigned long long*)orow + lane;
#pragma unroll
    for (int j = 0; j < 4; ++j) { const f32x4 gv = gr[64 * j];
        o8[64 * j] = (unsigned long long)pk2(v[j].x * rstd * gv.x, v[j].y * rstd * gv.y) | ((unsigned long long)pk2(v[j].z * rstd * gv.z, v[j].w * rstd * gv.w) << 32); }
}

__device__ __forceinline__ void phase_p0(const Args& a, LAS unsigned char* lds, int gw, int NGW, int wave, int lane) {
    LAS float* scr = (LAS float*)(lds + wave * 16384);
    bf16* WinT = (bf16*)(a.ws + WS_WINT); bf16* WoT = (bf16*)(a.ws + WS_WOT); bf16* WuT = (bf16*)(a.ws + WS_WUT); bf16* WdT = (bf16*)(a.ws + WS_WDT);
    constexpr int I_IN = (N_INT / 32) * (DM / 64), I_O = (DM / 32) * (DM / 64), I_U = (DFF / 32) * (DM / 64), I_D = (DM / 32) * (DFF / 64);
    constexpr int NITEMS = I_IN + I_O + I_U + I_D;
    for (int it = gw; it < NITEMS; it += NGW) {
        int r = it;
        if (r < I_IN) { const int nb = r % (N_INT / 32), kb = r / (N_INT / 32); transpose_item<true>(a.w_in, DM, 8280, WinT, nb * 32, kb * 64, scr, lane); continue; } r -= I_IN;
        if (r < I_O) { const int nb = r % (DM / 32), kb = r / (DM / 32); transpose_item<false>(a.w_out, DM, DM, WoT, nb * 32, kb * 64, scr, lane); continue; } r -= I_O;
        if (r < I_U) { const int nb = r % (DFF / 32), kb = r / (DFF / 32); transpose_item<false>(a.w_up, DM, DFF, WuT, nb * 32, kb * 64, scr, lane); continue; } r -= I_U;
        { const int nb = r % (DM / 32), kb = r / (DM / 32); transpose_item<false>(a.w_down, DFF, DM, WdT, nb * 32, kb * 64, scr, lane); }
    }
    float2* RI = (float2*)(a.ws + WS_ROPEI); float2* RA = (float2*)(a.ws + WS_ROPEA);
    for (int e = gw * 64 + lane; e < SEQ * 24; e += NGW * 64) {
        const int t = e / 24, j = e % 24; float inv, sn, cs;
        if (j < 8) { inv = powf(500000.0f, -(float)(2 * j) / 16.0f); const float ang = (float)t * inv; sincosf(ang, &sn, &cs); RI[t * 8 + j] = make_float2(cs, sn); }
        else { const int jj = j - 8; inv = powf(500000.0f, -(float)(2 * jj) / 32.0f); const float ang = (float)t * inv; sincosf(ang, &sn, &cs); RA[t * 16 + jj] = make_float2(cs, sn); }
    }
    bf16* H = (bf16*)a.out;
    for (int m = gw; m < MROWS; m += NGW) rms_row_to_bf16(a.x + (size_t)m * DM, a.norm_mix_g, H + (size_t)m * DM, lane);
}

__device__ __forceinline__ void phase_p1b(const Args& a, int gw, int NGW, int lane) {
    bf16* AQ = (bf16*)(a.ws + WS_AQ); bf16* AKV = (bf16*)(a.ws + WS_AKV); bf16* IQ = (bf16*)(a.ws + WS_IQ); bf16* IK = (bf16*)(a.ws + WS_IK);
    const float2* RI = (const float2*)(a.ws + WS_ROPEI); const float2* RA = (const float2*)(a.ws + WS_ROPEA);
    for (int m = gw; m < MROWS; m += NGW) {
        const int t = m & (SEQ - 1);
        {
            const int seg = lane & 7; bf16* p = AQ + (size_t)m * 1024 + (lane >> 3) * 128 + seg * 16;
            const v4u w0 = *(const v4u*)p, w1 = *(const v4u*)(p + 8);
            float y[16]; y[0] = bflo(w0.x); y[1] = bfhi(w0.x); y[2] = bflo(w0.y); y[3] = bfhi(w0.y); y[4] = bflo(w0.z); y[5] = bfhi(w0.z); y[6] = bflo(w0.w); y[7] = bfhi(w0.w);
            y[8] = bflo(w1.x); y[9] = bfhi(w1.x); y[10] = bflo(w1.y); y[11] = bfhi(w1.y); y[12] = bflo(w1.z); y[13] = bfhi(w1.z); y[14] = bflo(w1.w); y[15] = bfhi(w1.w);
            float ss = 0.f;
#pragma unroll
            for (int i = 0; i < 16; ++i) ss += y[i] * y[i];
            ss += __shfl_xor(ss, 1); ss += __shfl_xor(ss, 2); ss += __shfl_xor(ss, 4);
            const float rstd = 1.0f / sqrtf(ss * (1.f / 128.f) + EPSN);
#pragma unroll
            for (int i = 0; i < 16; ++i) y[i] = y[i] * rstd * a.q_norm_g[seg * 16 + i];
#pragma unroll
            for (int i = 0; i < 16; ++i) { const float o = __shfl_xor(y[i], 1); const float2 cs = RA[t * 16 + i];
                if (seg == 0) y[i] = y[i] * cs.x - o * cs.y; else if (seg == 1) y[i] = y[i] * cs.x + o * cs.y; }
            v4u o0, o1; o0.x = pk2(y[0], y[1]); o0.y = pk2(y[2], y[3]); o0.z = pk2(y[4], y[5]); o0.w = pk2(y[6], y[7]);
            o1.x = pk2(y[8], y[9]); o1.y = pk2(y[10], y[11]); o1.z = pk2(y[12], y[13]); o1.w = pk2(y[14], y[15]);
            *(v4u*)p = o0; *(v4u*)(p + 8) = o1;
        }
        {
            const int sl = lane & 31; bf16* p = AKV + (size_t)m * 512 + (lane >> 5) * 128 + sl * 4;
            const v2u w = *(const v2u*)p; float y[4] = {bflo(w.x), bfhi(w.x), bflo(w.y), bfhi(w.y)};
            float ss = y[0] * y[0] + y[1] * y[1] + y[2] * y[2] + y[3] * y[3];
            ss += __shfl_xor(ss, 1); ss += __shfl_xor(ss, 2); ss += __shfl_xor(ss, 4); ss += __shfl_xor(ss, 8); ss += __shfl_xor(ss, 16);
            const float rstd = 1.0f / sqrtf(ss * (1.f / 128.f) + EPSN);
#pragma unroll
            for (int i = 0; i < 4; ++i) y[i] = y[i] * rstd * a.k_norm_g[sl * 4 + i];
#pragma unroll
            for (int i = 0; i < 4; ++i) { const float o = __shfl_xor(y[i], 4); const float2 cs = RA[t * 16 + ((sl & 3) * 4 + i)];
                if (sl < 4) y[i] = y[i] * cs.x - o * cs.y; else if (sl < 8) y[i] = y[i] * cs.x + o * cs.y; }
            v2u o; o.x = pk2(y[0], y[1]); o.y = pk2(y[2], y[3]); *(v2u*)p = o;
        }
        {
            const int seg = lane & 7; bf16* p = IQ + (size_t)m * 512 + (lane >> 3) * 64 + seg * 8;
            const v4u w = *(const v4u*)p; float y[8] = {bflo(w.x), bfhi(w.x), bflo(w.y), bfhi(w.y), bflo(w.z), bfhi(w.z), bflo(w.w), bfhi(w.w)};
#pragma unroll
            for (int i = 0; i < 8; ++i) { const float o = __shfl_xor(y[i], 1); const float2 cs = RI[t * 8 + i];
                if (seg == 0) y[i] = y[i] * cs.x - o * cs.y; else if (seg == 1) y[i] = y[i] * cs.x + o * cs.y; }
            v4u o; o.x = pk2(y[0], y[1]); o.y = pk2(y[2], y[3]); o.z = pk2(y[4], y[5]); o.w = pk2(y[6], y[7]); *(v4u*)p = o;
        }
        {
            bf16* p = IK + (size_t)m * 64 + lane; float y = bf2f(*p); const float o = __shfl_xor(y, 8); const float2 cs = RI[t * 8 + (lane & 7)];
            if (lane < 8) y = y * cs.x - o * cs.y; else if (lane < 16) y = y * cs.x + o * cs.y;
            *p = (bf16)f2bf(y);
        }
    }
}
typedef float f32x16 __attribute__((ext_vector_type(16)));
typedef short bf16x8 __attribute__((ext_vector_type(8)));
typedef float f32x2_ __attribute__((ext_vector_type(2)));
typedef __bf16 bf16x2_ __attribute__((ext_vector_type(2)));
__device__ __forceinline__ unsigned pkbf(float a, float b) { const f32x2_ v = {a, b}; return __builtin_bit_cast(unsigned, __builtin_convertvector(v, bf16x2_)); }
__device__ __forceinline__ int crow16(int reg, int h) { return (reg & 3) + 8 * (reg >> 2) + 4 * h; }
__device__ __forceinline__ int p16pos(int o) { return (o & ~12) | ((o & 4) << 1) | ((o & 8) >> 1); }
#define MFMA32(a, b, c) __builtin_amdgcn_mfma_f32_32x32x16_bf16((a), (b), (c), 0, 0, 0)
#define WG_BAR() do { asm volatile("s_waitcnt lgkmcnt(0)" ::: "memory"); __builtin_amdgcn_s_barrier(); asm volatile("" ::: "memory"); } while (0)

constexpr size_t WS_QKP = 458 * MiB;
constexpr size_t WS_GCUM = 490 * MiB;

__device__ __forceinline__ void phase_gdn_prep(const Args& a, LAS unsigned char* lds, int bx, int G, int tid, int wave, int lane) {
    bf16* QKV = (bf16*)(a.ws + WS_QKV); const bf16* HALO = (const bf16*)(a.ws + WS_HALO); const float* SM = (const float*)(a.ws + WS_SM);
    bf16* WGB = (bf16*)a.out + (size_t)MROWS * DM; bf16* QKP = (bf16*)(a.ws + WS_QKP); float* GCUM = (float*)(a.ws + WS_GCUM);
    LAS unsigned char* KS = lds; LAS unsigned char* QS = lds + 17408; LAS float* K32 = (LAS float*)(lds + 34816); LAS float* V32 = (LAS float*)(lds + 67584);
    LAS float* A32 = (LAS float*)(lds + 100352); LAS bf16* QKO = (LAS bf16*)(lds + 116736); LAS float* GC = (LAS float*)(lds + 124928); LAS float* BETA = (LAS float*)(lds + 125184); LAS float* BETAW = (LAS float*)(lds + 125440);
    const int lr = lane & 31, lh = lane >> 5;
    for (int item = bx; item < 4096; item += G) {
        const int b = item >> 10, n = (item >> 3) & 127, h = item & 7; const int row0 = b * SEQ + n * 64; const int ch = (b * 8 + h) * 128 + n;
        if (wave == 0) {
            const size_t row = (size_t)row0 + lane; const float ga = SM[row * 32 + h], gb = SM[row * 32 + 8 + h];
            float g = -__expf(a.a_log[h]) * softplusf_(ga + a.dt_bias[h]);
#pragma unroll
            for (int o = 1; o < 64; o <<= 1) { const float t = __shfl_up(g, o); if (lane >= o) g += t; }
            const float bt = sigm_(gb); GC[lane] = g; BETA[lane] = bt; BETAW[lane] = bt * __expf(g); GCUM[row * 8 + h] = g;
        }
        unsigned qpk[2][4], kpk[2][4];
        {
            const int c = tid & 15, pp = tid >> 4;
#pragma unroll
            for (int pass = 0; pass < 2; ++pass) { const int p = pp + 32 * pass;
#pragma unroll
                for (int m = 0; m < 3; ++m) { const int col = m * 1024 + h * 128 + c * 8; float y[8];
#pragma unroll
                    for (int e = 0; e < 8; ++e) y[e] = 0.f;
#pragma unroll
                    for (int j = 0; j < 4; ++j) { const int r = p - 3 + j; v4u w = {0u, 0u, 0u, 0u};
                        if (r >= 0) w = *(const v4u*)(QKV + (size_t)(row0 + r) * 3072 + col);
                        else if (n > 0) w = *(const v4u*)(HALO + ((size_t)((row0 >> 6) - 1) * 3 + (r + 3)) * 3072 + col);
                        const f32x4 c0 = *(const f32x4*)(a.conv_w + j * 3072 + col), c1 = *(const f32x4*)(a.conv_w + j * 3072 + col + 4);
                        y[0] += c0.x * bflo(w.x); y[1] += c0.y * bfhi(w.x); y[2] += c0.z * bflo(w.y); y[3] += c0.w * bfhi(w.y);
                        y[4] += c1.x * bflo(w.z); y[5] += c1.y * bfhi(w.z); y[6] += c1.z * bflo(w.w); y[7] += c1.w * bfhi(w.w); }
#pragma unroll
                    for (int e = 0; e < 8; ++e) y[e] = siluf_(y[e]);
                    if (m < 2) { float ss = 0.f;
#pragma unroll
                        for (int e = 0; e < 8; ++e) ss += y[e] * y[e];
                        ss += __shfl_xor(ss, 1); ss += __shfl_xor(ss, 2); ss += __shfl_xor(ss, 4); ss += __shfl_xor(ss, 8);
                        float sc = 1.0f / sqrtf(ss + EPSN); if (m == 0) sc *= 0.08838834764831845f;
#pragma unroll
                        for (int e = 0; e < 8; ++e) y[e] *= sc;
                        v4u o; o.x = pkbf(y[0], y[1]); o.y = pkbf(y[2], y[3]); o.z = pkbf(y[4], y[5]); o.w = pkbf(y[6], y[7]);
                        if (m == 0) { qpk[pass][0] = o.x; qpk[pass][1] = o.y; qpk[pass][2] = o.z; qpk[pass][3] = o.w; *(LAS v4u*)(QS + p * 272 + c * 16) = o; }
                        else { kpk[pass][0] = o.x; kpk[pass][1] = o.y; kpk[pass][2] = o.z; kpk[pass][3] = o.w; *(LAS v4u*)(KS + p * 272 + c * 16) = o;
                            *(LAS f32x4*)(K32 + p * 128 + c * 8) = (f32x4){y[0], y[1], y[2], y[3]}; *(LAS f32x4*)(K32 + p * 128 + c * 8 + 4) = (f32x4){y[4], y[5], y[6], y[7]}; }
                    } else { *(LAS f32x4*)(V32 + p * 128 + c * 8) = (f32x4){y[0], y[1], y[2], y[3]}; *(LAS f32x4*)(V32 + p * 128 + c * 8 + 4) = (f32x4){y[4], y[5], y[6], y[7]}; }
                } }
        }
        __syncthreads();
        {
            const int c = tid & 15, pp = tid >> 4;
#pragma unroll
            for (int pass = 0; pass < 2; ++pass) { const int p = pp + 32 * pass; bf16* rp = QKV + (size_t)(row0 + p) * 3072 + h * 128 + c * 8;
                *(v4u*)rp = (v4u){qpk[pass][0], qpk[pass][1], qpk[pass][2], qpk[pass][3]}; *(v4u*)(rp + 1024) = (v4u){kpk[pass][0], kpk[pass][1], kpk[pass][2], kpk[pass][3]}; }
        }
        {
            const int wsub = wave & 3, ti = wsub >> 1, tj = wsub & 1; const bool isqk = wave >= 4;
            f32x16 acc;
#pragma unroll
            for (int i = 0; i < 16; ++i) acc[i] = 0.f;
            if (!(ti == 0 && tj == 1)) {
                const LAS unsigned char* XS = isqk ? QS : KS;
#pragma unroll
                for (int s = 0; s < 8; ++s) { const bf16x8 av = *(const LAS bf16x8*)(XS + (32 * ti + lr) * 272 + (16 * s + 8 * lh) * 2); const bf16x8 bv = *(const LAS bf16x8*)(KS + (32 * tj + lr) * 272 + (16 * s + 8 * lh) * 2);
                    acc = MFMA32(av, bv, acc); }
            }
            const int col = 32 * tj + lr; const float gcol = GC[col];
#pragma unroll
            for (int i = 0; i < 16; ++i) { const int row = 32 * ti + crow16(i, lh); const float dec = __expf(fminf(GC[row] - gcol, 0.f));
                if (!isqk) A32[row * 64 + col] = (row > col) ? acc[i] * BETA[row] * dec : 0.f;
                else QKO[row * 64 + p16pos(col)] = (bf16)((row >= col) ? (pkbf(acc[i] * dec, 0.f) & 0xffffu) : 0u); }
        }
        __syncthreads();
        if (wave < 4) {
            int vz; asm volatile("v_mov_b32 %0, 0" : "=v"(vz));
            const LAS float* A32v = A32 + vz; const LAS float* BMv = (wave >= 2 ? BETAW : BETA) + vz;
            const int cidx = wave * 64 + lane; const bool isw = wave >= 2; const LAS float* R = isw ? (K32 + (cidx - 128)) : (V32 + cidx);
            float t[64];
#pragma unroll
            for (int i = 0; i < 64; ++i) t[i] = 0.f;
#pragma unroll
            for (int i = 0; i < 64; ++i) {
                const float rhs = R[i * 128] * BMv[i];
                float a0 = rhs, a1 = 0.f, a2 = 0.f, a3 = 0.f;
#pragma unroll
                for (int j = 0; j < ((i + 3) & ~3); j += 4) { const f32x4 av = *(const LAS f32x4*)(A32v + i * 64 + j); a0 -= av.x * t[j]; a1 -= av.y * t[j + 1]; a2 -= av.z * t[j + 2]; a3 -= av.w * t[j + 3]; }
                t[i] = (a0 + a1) + (a2 + a3);
                asm volatile("" ::: "memory");
            }
            if (!isw) { bf16* up = QKV + (size_t)row0 * 3072 + 2048 + h * 128 + cidx;
#pragma unroll
                for (int i = 0; i < 64; ++i) up[(size_t)i * 3072] = (bf16)(pkbf(t[i], 0.f) & 0xffffu); }
            else { bf16* wp = WGB + (size_t)row0 * 1024 + h * 128 + (cidx - 128);
#pragma unroll
                for (int i = 0; i < 64; ++i) wp[(size_t)i * 1024] = (bf16)(pkbf(t[i], 0.f) & 0xffffu); }
        } else {
            const int lt = tid - 256; const LAS v4u* src = (const LAS v4u*)QKO; v4u* dst = (v4u*)(QKP + (size_t)ch * 4096);
            dst[lt] = src[lt]; dst[lt + 256] = src[lt + 256];
        }
        __syncthreads();
    }
}
constexpr int SC_WL = 0, SC_QL = 17408, SC_KTL = 34816, SC_QKL = 53248, SC_UL = 62464, SC_BUF = 78848, SC_MISC = 2 * SC_BUF;
__device__ __forceinline__ void phase_scan(const Args& a, LAS unsigned char* lds, int bh, int tid, int wave, int lane) {
    bf16* QKV = (bf16*)(a.ws + WS_QKV); const bf16* WGB = (const bf16*)a.out + (size_t)MROWS * DM; const bf16* QKP = (const bf16*)(a.ws + WS_QKP);
    const float* GCUM = (const float*)(a.ws + WS_GCUM); const bf16* Z = (const bf16*)(a.ws + WS_Z);
    const int b = bh >> 3, h = bh & 7; const int lr = lane & 31, lh = lane >> 5;
    LAS float* GLs = (LAS float*)(lds + SC_MISC);
    if (wave < 4) {
        const int jb = wave;
        f32x16 Sacc[4]; bf16x8 Sf[4][2];
#pragma unroll
        for (int r = 0; r < 4; ++r) {
#pragma unroll
            for (int i = 0; i < 16; ++i) Sacc[r][i] = 0.f;
#pragma unroll
            for (int s = 0; s < 2; ++s)
#pragma unroll
                for (int e = 0; e < 8; ++e) Sf[r][s][e] = 0; }
        WG_BAR();
        for (int n = 0; n < 128; ++n) {
            LAS unsigned char* B = lds + (n & 1) * SC_BUF;
            f32x16 ws_[2];
#pragma unroll
            for (int rt = 0; rt < 2; ++rt) {
#pragma unroll
                for (int i = 0; i < 16; ++i) ws_[rt][i] = 0.f; }
#pragma unroll
            for (int ks = 0; ks < 8; ++ks) {
#pragma unroll
                for (int rt = 0; rt < 2; ++rt) {
                    const bf16x8 aw = *(const LAS bf16x8*)(B + SC_WL + (32 * rt + lr) * 272 + ks * 32 + lh * 16);
                    ws_[rt] = MFMA32(aw, Sf[ks >> 1][ks & 1], ws_[rt]); } }
            bf16x8 vf[2][2];
#pragma unroll
            for (int rt = 0; rt < 2; ++rt) {
                float vn[16];
#pragma unroll
                for (int i = 0; i < 16; ++i) { const int row = 32 * rt + crow16(i, lh); vn[i] = bf2f(*(const LAS bf16*)(B + SC_UL + row * 256 + (32 * jb + lr) * 2)) - ws_[rt][i]; }
#pragma unroll
                for (int s = 0; s < 2; ++s) { v4u p; p.x = pkbf(vn[8 * s], vn[8 * s + 1]); p.y = pkbf(vn[8 * s + 2], vn[8 * s + 3]); p.z = pkbf(vn[8 * s + 4], vn[8 * s + 5]); p.w = pkbf(vn[8 * s + 6], vn[8 * s + 7]);
                    vf[rt][s] = __builtin_bit_cast(bf16x8, p); } }
#pragma unroll
            for (int rt = 0; rt < 2; ++rt) {
                f32x16 qs_;
#pragma unroll
                for (int i = 0; i < 16; ++i) qs_[i] = 0.f;
#pragma unroll
                for (int ks = 0; ks < 8; ++ks) { const bf16x8 aq = *(const LAS bf16x8*)(B + SC_QL + (32 * rt + lr) * 272 + ks * 32 + lh * 16); qs_ = MFMA32(aq, Sf[ks >> 1][ks & 1], qs_); }
#pragma unroll
                for (int jt = 0; jt <= rt; ++jt)
#pragma unroll
                    for (int s = 0; s < 2; ++s) { const bf16x8 am = *(const LAS bf16x8*)(B + SC_QKL + (32 * rt + lr) * 144 + (jt * 2 + s) * 32 + lh * 16); qs_ = MFMA32(am, vf[jt][s], qs_); }
#pragma unroll
                for (int i = 0; i < 16; ++i) { const int row = 32 * rt + crow16(i, lh); *(LAS bf16*)(B + SC_UL + row * 256 + (32 * jb + lr) * 2) = (bf16)(pkbf(qs_[i], 0.f) & 0xffffu); }
            }
            const float gl = GLs[n & 1];
#pragma unroll
            for (int r = 0; r < 4; ++r) {
#pragma unroll
                for (int i = 0; i < 16; ++i) Sacc[r][i] *= gl;
#pragma unroll
                for (int ks = 0; ks < 4; ++ks) { const bf16x8 ak = *(const LAS bf16x8*)(B + SC_KTL + (32 * r + lr) * 144 + ks * 32 + lh * 16); Sacc[r] = MFMA32(ak, vf[ks >> 1][ks & 1], Sacc[r]); }
#pragma unroll
                for (int s = 0; s < 2; ++s) { v4u p; p.x = pkbf(Sacc[r][8 * s], Sacc[r][8 * s + 1]); p.y = pkbf(Sacc[r][8 * s + 2], Sacc[r][8 * s + 3]); p.z = pkbf(Sacc[r][8 * s + 4], Sacc[r][8 * s + 5]); p.w = pkbf(Sacc[r][8 * s + 6], Sacc[r][8 * s + 7]);
                    Sf[r][s] = __builtin_bit_cast(bf16x8, p); } }
            WG_BAR();
        }
    } else {
        const int lt = tid - 256; const int up = lt >> 2, uq = lt & 3;
        v4u rw[4], rq[4], rk[4], ru[4], rm[2], rz[4]; float gq[4], glast = 0.f;
        auto issue = [&](int m) {
            const size_t row0 = (size_t)b * SEQ + (size_t)m * 64; const size_t ch = (size_t)bh * 128 + m;
#pragma unroll
            for (int i = 0; i < 4; ++i) { const int idx = lt + 256 * i, p = idx >> 4, c = idx & 15;
                rw[i] = *(const v4u*)(WGB + (row0 + p) * 1024 + h * 128 + c * 8);
                rq[i] = *(const v4u*)(QKV + (row0 + p) * 3072 + h * 128 + c * 8);
                rk[i] = *(const v4u*)(QKV + (row0 + p) * 3072 + 1024 + h * 128 + c * 8);
                ru[i] = *(const v4u*)(QKV + (row0 + up) * 3072 + 2048 + h * 128 + uq * 32 + i * 8);
                gq[i] = GCUM[(row0 + p) * 8 + h]; }
#pragma unroll
            for (int i = 0; i < 2; ++i) rm[i] = *(const v4u*)(QKP + ch * 4096 + (size_t)(lt + 256 * i) * 8);
            glast = GCUM[(row0 + 63) * 8 + h];
        };
        auto stage = [&](int bb) {
            LAS unsigned char* B = lds + bb * SC_BUF;
#pragma unroll
            for (int i = 0; i < 4; ++i) { const int idx = lt + 256 * i, p = idx >> 4, c = idx & 15; const int g16 = c >> 1, o8 = (c & 1) * 8;
                LAS unsigned char* wd = B + SC_WL + p * 272 + g16 * 32 + o8;
                *(LAS v2u*)wd = (v2u){rw[i].x, rw[i].y}; *(LAS v2u*)(wd + 16) = (v2u){rw[i].z, rw[i].w};
                const float eq = __expf(gq[i]); v4u q = rq[i];
                q.x = pkbf(bflo(q.x) * eq, bfhi(q.x) * eq); q.y = pkbf(bflo(q.y) * eq, bfhi(q.y) * eq); q.z = pkbf(bflo(q.z) * eq, bfhi(q.z) * eq); q.w = pkbf(bflo(q.w) * eq, bfhi(q.w) * eq);
                LAS unsigned char* qd = B + SC_QL + p * 272 + g16 * 32 + o8;
                *(LAS v2u*)qd = (v2u){q.x, q.y}; *(LAS v2u*)(qd + 16) = (v2u){q.z, q.w};
                const float ek = __expf(glast - gq[i]); const v4u k = rk[i]; const int pc = p16pos(p);
                LAS unsigned char* kd = B + SC_KTL + (c * 8) * 144 + pc * 2;
                *(LAS bf16*)(kd + 0 * 144) = (bf16)(pkbf(bflo(k.x) * ek, 0.f) & 0xffffu); *(LAS bf16*)(kd + 1 * 144) = (bf16)(pkbf(bfhi(k.x) * ek, 0.f) & 0xffffu);
                *(LAS bf16*)(kd + 2 * 144) = (bf16)(pkbf(bflo(k.y) * ek, 0.f) & 0xffffu); *(LAS bf16*)(kd + 3 * 144) = (bf16)(pkbf(bfhi(k.y) * ek, 0.f) & 0xffffu);
                *(LAS bf16*)(kd + 4 * 144) = (bf16)(pkbf(bflo(k.z) * ek, 0.f) & 0xffffu); *(LAS bf16*)(kd + 5 * 144) = (bf16)(pkbf(bfhi(k.z) * ek, 0.f) & 0xffffu);
                *(LAS bf16*)(kd + 6 * 144) = (bf16)(pkbf(bflo(k.w) * ek, 0.f) & 0xffffu); *(LAS bf16*)(kd + 7 * 144) = (bf16)(pkbf(bfhi(k.w) * ek, 0.f) & 0xffffu);
                *(LAS v4u*)(B + SC_UL + up * 256 + (uq * 32 + i * 8) * 2) = ru[i]; }
#pragma unroll
            for (int i = 0; i < 2; ++i) { const int idx = lt + 256 * i; *(LAS v4u*)(B + SC_QKL + (idx >> 3) * 144 + (idx & 7) * 16) = rm[i]; }
            if (lt == 0) GLs[bb] = __expf(glast);
        };
        auto issue_z = [&](int m) { const size_t row = (size_t)b * SEQ + (size_t)m * 64 + up;
#pragma unroll
            for (int i = 0; i < 4; ++i) rz[i] = *(const v4u*)(Z + row * 1024 + h * 128 + uq * 32 + i * 8); };
        auto finish = [&](int m, int bb, bool do_store) {
            const LAS unsigned char* B = lds + bb * SC_BUF; float o[32]; float ss = 0.f;
#pragma unroll
            for (int i = 0; i < 4; ++i) { const v4u w = *(const LAS v4u*)(B + SC_UL + up * 256 + (uq * 32 + i * 8) * 2);
                o[8 * i] = bflo(w.x); o[8 * i + 1] = bfhi(w.x); o[8 * i + 2] = bflo(w.y); o[8 * i + 3] = bfhi(w.y); o[8 * i + 4] = bflo(w.z); o[8 * i + 5] = bfhi(w.z); o[8 * i + 6] = bflo(w.w); o[8 * i + 7] = bfhi(w.w); }
#pragma unroll
            for (int e = 0; e < 32; ++e) ss += o[e] * o[e];
            ss += __shfl_xor(ss, 1); ss += __shfl_xor(ss, 2);
            const float rstd = 1.0f / sqrtf(ss * (1.f / 128.f) + EPSN);
            bf16* op = QKV + ((size_t)b * SEQ + (size_t)m * 64 + up) * 3072 + h * 128 + uq * 32;
#pragma unroll
            for (int i = 0; i < 4; ++i) { const v4u zz = rz[i]; const float* gp = a.gdn_norm_g + uq * 32 + i * 8; const f32x4 g0 = *(const f32x4*)gp, g1 = *(const f32x4*)(gp + 4);
                v4u w; w.x = pkbf(o[8 * i] * rstd * g0.x * siluf_(bflo(zz.x)), o[8 * i + 1] * rstd * g0.y * siluf_(bfhi(zz.x)));
                w.y = pkbf(o[8 * i + 2] * rstd * g0.z * siluf_(bflo(zz.y)), o[8 * i + 3] * rstd * g0.w * siluf_(bfhi(zz.y)));
                w.z = pkbf(o[8 * i + 4] * rstd * g1.x * siluf_(bflo(zz.z)), o[8 * i + 5] * rstd * g1.y * siluf_(bfhi(zz.z)));
                w.w = pkbf(o[8 * i + 6] * rstd * g1.z * siluf_(bflo(zz.w)), o[8 * i + 7] * rstd * g1.w * siluf_(bfhi(zz.w)));
                if (do_store) *(v4u*)(op + i * 8) = w; }
        };
        issue(0); stage(0); issue(1);
        WG_BAR();
        for (int n = 0; n < 128; ++n) {
            finish(n - 1, (n - 1) & 1, n >= 1);
            asm volatile("" ::: "memory");
            stage((n + 1) & 1);
            asm volatile("" ::: "memory");
            issue(n + 2 < 128 ? n + 2 : 127);
            issue_z(n);
            WG_BAR();
        }
        finish(127, 1, true);
    }
}
__device__ __forceinline__ void phase_p4b(const Args& a, int gw, int NGW, int lane) {
    bf16* H2 = (bf16*)(a.ws + WS_AQ);
    for (int m = gw; m < MROWS; m += NGW) rms_row_to_bf16(a.out + (size_t)m * DM, a.norm_mlp_g, H2 + (size_t)m * DM, lane);
}

__device__ __forceinline__ void gdn_naive_dev(int chain, int tid, LAS unsigned char* lb, const bf16* QKV, const bf16* Z, const float* SM, const float* conv_w, const float* a_log, const float* dt_bias,
                                              const float* gnorm_g, bf16* OG) {
    const int b = chain >> 3, h = chain & 7, lane = tid & 63, wave = tid >> 6;
    typedef float row128[128];
    LAS row128* sq = (LAS row128*)lb; LAS row128* sk = sq + 32; LAS row128* sv = sk + 32; LAS row128* so = sv + 32;
    LAS float* sdec = (LAS float*)(so + 32); LAS float* sbeta = sdec + 32;
    LAS row128* redA = (LAS row128*)(sbeta + 32); LAS row128* redB = redA + 2;
    float S[64];
#pragma unroll
    for (int i = 0; i < 64; ++i) S[i] = 0.f;
    const int col = tid & 127, half = tid >> 7;
    const float aexp = __expf(a_log[h]), dtb = dt_bias[h];
    for (int t0 = 0; t0 < SEQ; t0 += 32) {
        for (int e = tid; e < 32 * 384; e += 256) {
            const int tok = e / 384, cch = e % 384, which = cch >> 7, d = cch & 127, ch = which * 1024 + h * 128 + d, t = t0 + tok;
            float y = 0.f;
#pragma unroll
            for (int j = 0; j < 4; ++j) { const int tt = t - 3 + j; if (tt >= 0) y += conv_w[j * 3072 + ch] * bf2f(QKV[((size_t)b * SEQ + tt) * 3072 + ch]); }
            y = siluf_(y);
            if (which == 0) sq[tok][d] = y; else if (which == 1) sk[tok][d] = y; else sv[tok][d] = y;
        }
        __syncthreads();
        for (int vi = wave; vi < 64; vi += 4) { const int tok = vi >> 1; LAS float* p = (vi & 1) ? sk[tok] : sq[tok];
            const float x0 = p[lane], x1 = p[lane + 64]; const float ss = wave_sum(x0 * x0 + x1 * x1);
            float sc = 1.0f / sqrtf(ss + EPSN); if (!(vi & 1)) sc *= 0.08838834764831845f;
            p[lane] = x0 * sc; p[lane + 64] = x1 * sc; }
        if (tid < 32) { const size_t row = (size_t)b * SEQ + t0 + tid; const float ga = SM[row * 32 + h], gb = SM[row * 32 + 8 + h];
            sbeta[tid] = sigm_(gb); sdec[tid] = __expf(-aexp * softplusf_(ga + dtb)); }
        __syncthreads();
        for (int tok = 0; tok < 32; ++tok) {
            const float decay = sdec[tok]; const LAS float* kk = sk[tok] + half * 64; const LAS float* qq = sq[tok] + half * 64;
            float p = 0.f;
#pragma unroll
            for (int i = 0; i < 64; ++i) p += S[i] * kk[i];
            redA[half][col] = p; __syncthreads();
            const float kv = (redA[0][col] + redA[1][col]) * decay;
            const float delta = sbeta[tok] * (sv[tok][col] - kv);
            float po = 0.f;
#pragma unroll
            for (int i = 0; i < 64; ++i) { S[i] = decay * S[i] + kk[i] * delta; po += S[i] * qq[i]; }
            redB[half][col] = po; __syncthreads();
            if (half == 0) so[tok][col] = redB[0][col] + redB[1][col];
        }
        __syncthreads();
        for (int tok = wave; tok < 32; tok += 4) { const size_t row = (size_t)b * SEQ + t0 + tok;
            const float o0 = so[tok][lane], o1 = so[tok][lane + 64]; const float ss = wave_sum(o0 * o0 + o1 * o1);
            const float rstd = 1.0f / sqrtf(ss * (1.f / 128.f) + EPSN);
            const float z0 = bf2f(Z[row * 1024 + h * 128 + lane]), z1 = bf2f(Z[row * 1024 + h * 128 + lane + 64]);
            OG[row * 1024 + h * 128 + lane] = (bf16)f2bf(o0 * rstd * gnorm_g[lane] * siluf_(z0));
            OG[row * 1024 + h * 128 + lane + 64] = (bf16)f2bf(o1 * rstd * gnorm_g[lane + 64] * siluf_(z1)); }
        __syncthreads();
    }
}

__device__ __forceinline__ unsigned f2ord(float f) { if (f == 0.f) f = 0.f; const unsigned u = __builtin_bit_cast(unsigned, f); return (u & 0x80000000u) ? ~u : (u | 0x80000000u); }

__device__ __forceinline__ void topk_naive_dev(int bx, int G, int hf, int tid, LAS unsigned char* lb, const bf16* IQ, const bf16* IK, const float* SM, unsigned short* TOPK) {
    LAS float* sq = (LAS float*)lb; LAS float* sw = sq + 512; LAS unsigned* skey = (LAS unsigned*)(sw + 8); LAS unsigned* hist = skey + SEQ; LAS unsigned* smisc = hist + 256; LAS unsigned* scnt = smisc + 4;
    for (int pair = bx; pair < MROWS / 2; pair += G) {
        const int row = pair * 2 + hf, b = row >> 13, t = row & (SEQ - 1);
        unsigned short* outp = TOPK + (size_t)row * 256;
        if (t < 256) { outp[tid] = tid <= t ? (unsigned short)tid : (unsigned short)0xFFFF; continue; }
        sq[tid] = bf2f(IQ[(size_t)row * 512 + tid]); sq[tid + 256] = bf2f(IQ[(size_t)row * 512 + tid + 256]);
        if (tid < 8) sw[tid] = SM[(size_t)row * 32 + 16 + tid] * (0.35355339059327373f * 0.125f);
        if (tid == 0) smisc[2] = 0u;
        __syncthreads();
        const int n = t + 1;
        for (int s = tid; s < n; s += 256) {
            const v4u* kp = (const v4u*)(IK + ((size_t)b * SEQ + s) * 64); float k[64];
#pragma unroll
            for (int i = 0; i < 8; ++i) { const v4u w = kp[i]; k[8 * i] = bflo(w.x); k[8 * i + 1] = bfhi(w.x); k[8 * i + 2] = bflo(w.y); k[8 * i + 3] = bfhi(w.y); k[8 * i + 4] = bflo(w.z); k[8 * i + 5] = bfhi(w.z); k[8 * i + 6] = bflo(w.w); k[8 * i + 7] = bfhi(w.w); }
            float sc = 0.f;
#pragma unroll 1
            for (int hh = 0; hh < 8; ++hh) { float d = 0.f;
#pragma unroll
                for (int i = 0; i < 64; ++i) d += sq[hh * 64 + i] * k[i];
                sc += sw[hh] * fmaxf(d, 0.f); }
            skey[s] = f2ord(sc);
        }
        __syncthreads();
        unsigned prefix = 0u, mask = 0u, need = 256u;
        for (int pass = 0; pass < 4; ++pass) { const int shift = 24 - 8 * pass;
            hist[tid] = 0u; __syncthreads();
            for (int s = tid; s < n; s += 256) { const unsigned k = skey[s]; if ((k & mask) == prefix) atomicAdd((unsigned*)&hist[(k >> shift) & 255u], 1u); }
            __syncthreads();
            if (tid == 0) { unsigned cum = 0u; int d = 255; for (; d > 0; --d) { const unsigned c = hist[d]; if (cum + c >= need) break; cum += c; } smisc[0] = (unsigned)d; smisc[1] = need - cum; }
            __syncthreads();
            prefix |= smisc[0] << shift; mask |= 0xFFu << shift; need = smisc[1];
            __syncthreads();
        }
        const int per = (n + 255) / 256; const int s0 = tid * per, s1 = min(n, s0 + per);
        unsigned ceq = 0u;
        for (int s = s0; s < s1; ++s) { const unsigned k = skey[s]; if (k > prefix) { const unsigned pos = atomicAdd((unsigned*)&smisc[2], 1u); outp[pos] = (unsigned short)s; } else if (k == prefix) ++ceq; }
        scnt[tid] = ceq; __syncthreads();
        if (tid == 0) { unsigned run = 0u; for (int i = 0; i < 256; ++i) { const unsigned c = scnt[i]; scnt[i] = run; run += c; } }
        __syncthreads();
        const unsigned ngt = smisc[2]; unsigned rk = scnt[tid];
        for (int s = s0; s < s1; ++s) { if (skey[s] == prefix) { if (rk < need) outp[ngt + rk] = (unsigned short)s; ++rk; } }
        __syncthreads();
    }
}

__device__ __forceinline__ void attn_simple_dev(int bx, int G, int hf, int tid, LAS unsigned char* lb, bf16* AQ, const bf16* AKV, const unsigned short* TOPK) {
    const int lane = tid & 63, wave = tid >> 6;
    typedef float row256[256];
    LAS float* sq = (LAS float*)lb; LAS row256* sp = (LAS row256*)(sq + 1024); LAS int* sidx = (LAS int*)(sp + 8); LAS float* sred = (LAS float*)(sidx + 256);
    for (int pair = bx; pair < MROWS / 2; pair += G) {
        const int row = pair * 2 + hf, b = row >> 13;
        { const v2u w = *(const v2u*)(AQ + (size_t)row * 1024 + tid * 4); sq[tid * 4] = bflo(w.x); sq[tid * 4 + 1] = bfhi(w.x); sq[tid * 4 + 2] = bflo(w.y); sq[tid * 4 + 3] = bfhi(w.y); }
        const int idx = TOPK[(size_t)row * 256 + tid]; const bool valid = idx != 0xFFFF; sidx[tid] = valid ? idx : -1;
        __syncthreads();
        float lg[8];
        if (valid) { const bf16* kr = AKV + ((size_t)b * SEQ + idx) * 512;
#pragma unroll
            for (int c = 0; c < 2; ++c) { float acc4[4] = {0.f, 0.f, 0.f, 0.f};
                for (int i = 0; i < 16; ++i) { const v4u w = *(const v4u*)(kr + c * 128 + i * 8); const float kf[8] = {bflo(w.x), bfhi(w.x), bflo(w.y), bfhi(w.y), bflo(w.z), bfhi(w.z), bflo(w.w), bfhi(w.w)};
#pragma unroll
                    for (int g = 0; g < 4; ++g) { const LAS float* q = sq + (c * 4 + g) * 128 + i * 8;
#pragma unroll
                        for (int j = 0; j < 8; ++j) acc4[g] += q[j] * kf[j]; } }
#pragma unroll
                for (int g = 0; g < 4; ++g) lg[c * 4 + g] = acc4[g] * 0.08838834764831845f; }
        } else {
#pragma unroll
            for (int hh = 0; hh < 8; ++hh) lg[hh] = -INFINITY;
        }
#pragma unroll
        for (int hh = 0; hh < 8; ++hh) { float m = lg[hh];
#pragma unroll
            for (int o = 1; o < 64; o <<= 1) m = fmaxf(m, __shfl_xor(m, o));
            if (lane == 0) sred[hh * 4 + wave] = m; }
        __syncthreads();
        float ex[8];
#pragma unroll
        for (int hh = 0; hh < 8; ++hh) { const float m = fmaxf(fmaxf(sred[hh * 4], sred[hh * 4 + 1]), fmaxf(sred[hh * 4 + 2], sred[hh * 4 + 3])); ex[hh] = valid ? __expf(lg[hh] - m) : 0.f; }
        __syncthreads();
#pragma unroll
        for (int hh = 0; hh < 8; ++hh) { const float s = wave_sum(ex[hh]); if (lane == 0) sred[hh * 4 + wave] = s; }
        __syncthreads();
#pragma unroll
        for (int hh = 0; hh < 8; ++hh) { const float s = (sred[hh * 4] + sred[hh * 4 + 1]) + (sred[hh * 4 + 2] + sred[hh * 4 + 3]); sp[hh][tid] = ex[hh] / s; }
        __syncthreads();
        const int hh = tid >> 5, d0 = (tid & 31) * 4, c = hh >> 2; float o4[4] = {0.f, 0.f, 0.f, 0.f};
        for (int nn = 0; nn < 256; ++nn) { const int id = sidx[nn]; if (id < 0) continue; const float p = sp[hh][nn];
            const v2u w = *(const v2u*)(AKV + ((size_t)b * SEQ + id) * 512 + 256 + c * 128 + d0);
            o4[0] += p * bflo(w.x); o4[1] += p * bfhi(w.x); o4[2] += p * bflo(w.y); o4[3] += p * bfhi(w.y); }
        v2u o; o.x = pk2(o4[0], o4[1]); o.y = pk2(o4[2], o4[3]); *(v2u*)(AQ + (size_t)row * 1024 + tid * 4) = o;
        __syncthreads();
    }
}

typedef GAS unsigned gu32;
#define RLX_AGENT __ATOMIC_RELAXED, __HIP_MEMORY_SCOPE_AGENT
constexpr int CW_BAR = 4096;
constexpr int LDS_MISC_OFF = 163840 - 64;
#define XB_TMO      128
#define XB_XCNT(j)  (256  + 64 * (j))
#define XB_XSUB(j)  (1280 + 64 * (j))
#define XB_XGEN(j)  (2304 + 64 * (j))
#define XB_TOP      3328
#define XB_TOPGEN   3392
#define XCD_BAR_WORDS 3456
#define XB_SPIN_CAP (1u << 18)

__device__ __forceinline__ unsigned xb_ld(unsigned* p)              { return __hip_atomic_load(p, __ATOMIC_RELAXED, __HIP_MEMORY_SCOPE_AGENT); }
__device__ __forceinline__ unsigned xb_add(unsigned* p, unsigned v) { return __hip_atomic_fetch_add(p, v, __ATOMIC_RELAXED, __HIP_MEMORY_SCOPE_AGENT); }
__device__ __forceinline__ unsigned xb_xcc_id() { return (unsigned)__builtin_amdgcn_s_getreg((3 << 11) | 20) & 0xFu; }
#define XB_SPIN(cond, bar) do { unsigned _sp = 0; while (cond) { __builtin_amdgcn_s_sleep(1); \
    if ((++_sp & 255u) == 0u) { if (xb_ld(&(bar)[XB_TMO])) break; if (_sp > XB_SPIN_CAP) { atomicAdd(&(bar)[XB_TMO], 1u); break; } } } } while (0)

struct XcdBarrier {
    unsigned* bar; unsigned x;
    volatile LAS unsigned* st;
};

__device__ __forceinline__ XcdBarrier xcd_barrier_post(unsigned* bar, volatile LAS unsigned* st) {
    XcdBarrier b; b.bar = bar; b.x = xb_xcc_id(); b.st = st;
    if (threadIdx.x == 0) (void)xb_add(&bar[XB_XCNT(b.x)], 1u);
    return b;
}
__device__ __forceinline__ void xcd_barrier_complete(unsigned* bar, unsigned x, unsigned& nloc, unsigned& nx) {
    const unsigned G = gridDim.x * gridDim.y * gridDim.z;
    unsigned sum, cnt, mine, sp = 0u;
    for (;;) {
        sum = 0u; cnt = 0u; mine = 0u;
#pragma unroll
        for (unsigned j = 0; j < 16; ++j) { const unsigned c = xb_ld(&bar[XB_XCNT(j)]); sum += c; cnt += (c > 0u) ? 1u : 0u; mine = (j == x) ? c : mine; }
        if (sum == G) break;
        __builtin_amdgcn_s_sleep(1);
        if ((++sp & 255u) == 0u) { if (xb_ld(&bar[XB_TMO])) break; if (sp > XB_SPIN_CAP) { atomicAdd(&bar[XB_TMO], 1u); break; } }
    }
    nloc = mine > 0u ? mine : 1u; nx = cnt > 0u ? cnt : 1u;
}

__device__ __forceinline__ void xcd_barrier(const XcdBarrier& b) {
    asm volatile("s_waitcnt vmcnt(0)" ::: "memory");
    __syncthreads();
    if (threadIdx.x == 0) {
        unsigned* bar = b.bar;
        __builtin_amdgcn_s_waitcnt(0);
        unsigned nloc = b.st[0], nx = b.st[1];
        if (nloc == 0u) { xcd_barrier_complete(bar, b.x, nloc, nx); b.st[0] = nloc; b.st[1] = nx; }
        const unsigned old = xb_add(&bar[XB_XSUB(b.x)], 1u);
        const unsigned gen = old / nloc;
        if (old + 1u == (gen + 1u) * nloc) {
            __builtin_amdgcn_fence(__ATOMIC_RELEASE, "agent");
            asm volatile("s_waitcnt vmcnt(0)" ::: "memory");
            const unsigned og = xb_add(&bar[XB_TOP], 1u);
            const unsigned tg = og / nx;
            if (og + 1u == (tg + 1u) * nx) xb_add(&bar[XB_TOPGEN], 1u);
            else XB_SPIN(xb_ld(&bar[XB_TOPGEN]) == tg, bar);
            __builtin_amdgcn_fence(__ATOMIC_ACQUIRE, "agent");
            xb_add(&bar[XB_XGEN(b.x)], 1u);
            asm volatile("s_waitcnt vmcnt(0)" ::: "memory");
        } else {
            XB_SPIN(xb_ld(&bar[XB_XGEN(b.x)]) == gen, bar);
            __builtin_amdgcn_fence(__ATOMIC_ACQUIRE, "agent");
            asm volatile("s_waitcnt vmcnt(0)" ::: "memory");
        }
    }
    __syncthreads();
}

namespace cg = cooperative_groups;
constexpr int NPHASE = 12;
__global__ void __launch_bounds__(NWAVES * 64, 2) fwd(Args a) {
    extern __shared__ __attribute__((aligned(16))) unsigned char lds_raw[];
    LAS unsigned char* lds = (LAS unsigned char*)lds_raw;
    const int wave = __builtin_amdgcn_readfirstlane((int)threadIdx.x >> 6);
    const int G = gridDim.x, bx = blockIdx.x; const int vcu = (G % 8 == 0) ? (bx % 8) * (G / 8) + bx / 8 : bx;
    const int gw = vcu * NWAVES + wave, NGW = G * NWAVES;
    unsigned char* ws = a.ws;
    bf16* H = (bf16*)a.out; bf16* OG = (bf16*)a.out + (size_t)MROWS * DM;
    bf16* WinT = (bf16*)(ws + WS_WINT);
    const int lo = a.ph_lo, hi = a.ph_hi;
    if (threadIdx.x < 16) ((LAS unsigned*)(lds + LDS_MISC_OFF))[threadIdx.x] = 0u;
    __syncthreads();
    XcdBarrier bar = xcd_barrier_post((unsigned*)(ws + WS_CTL) + CW_BAR, (volatile LAS unsigned*)(lds + LDS_MISC_OFF));
#define IN(k) (lo <= (k) && (k) < hi)
#define SEAM(k) do { if (IN(k) && IN((k) + 1)) { if ((k) == 0) cg::this_grid().sync(); else xcd_barrier(bar); } } while (0)
    if (IN(0)) phase_p0(a, lds, gw, NGW, wave, (int)(threadIdx.x & 63));
    SEAM(0);
    if (IN(1)) {
        pg8::Gemm g{H, WinT, MROWS, N_IN1, DM}; pg8::StaticOrder S; S.init(MROWS, N_IN1, G, bx);
        pg8::EpiInProj E{(bf16*)(ws + WS_QKV), (bf16*)(ws + WS_Z), (bf16*)(ws + WS_AQ), (bf16*)(ws + WS_AKV), (bf16*)(ws + WS_IQ), (bf16*)(ws + WS_IK), (bf16*)(ws + WS_HALO), (float*)(ws + WS_SM)};
        pg8::gemm_phase<pg8::EpiInProj, pg8::StaticOrder, PG8_ALIGN, PG8_SP2>(lds, g, S, E);
    }
    SEAM(1);
    if (IN(2)) phase_p1b(a, gw, NGW, (int)(threadIdx.x & 63));
    SEAM(2);
    if (IN(3)) phase_gdn_prep(a, lds, bx, G, (int)threadIdx.x, wave, (int)(threadIdx.x & 63));
    SEAM(3);
    if (IN(11)) { if (bx < 32) phase_scan(a, lds, bx, (int)threadIdx.x, wave, (int)(threadIdx.x & 63)); }
    if (IN(11) && IN(4)) xcd_barrier(bar);
    if (IN(4)) topk_naive_dev(bx, G, (int)(threadIdx.x >> 8), (int)(threadIdx.x & 255), lds + (threadIdx.x >> 8) * 69632, (const bf16*)(ws + WS_IQ), (const bf16*)(ws + WS_IK), (const float*)(ws + WS_SM), (unsigned short*)(ws + WS_TOPK));
    SEAM(4);
    if (IN(5)) attn_simple_dev(bx, G, (int)(threadIdx.x >> 8), (int)(threadIdx.x & 255), lds + (threadIdx.x >> 8) * 69632, (bf16*)(ws + WS_AQ), (const bf16*)(ws + WS_AKV), (const unsigned short*)(ws + WS_TOPK));
    SEAM(5);
    if (IN(6)) {
        pg8::Gemm g{H, WinT + (size_t)N_IN1 * DM, MROWS, 2048, DM}; pg8::StaticOrder S; S.init(MROWS, 2048, G, bx);
        pg8::EpiGate E{(const bf16*)(ws + WS_QKV), 3072, (const bf16*)(ws + WS_AQ), 1024, (bf16*)(ws + WS_Z)};
        pg8::gemm_phase<pg8::EpiGate, pg8::StaticOrder, PG8_ALIGN, PG8_SP2>(lds, g, S, E);
    }
    SEAM(6);
    if (IN(7)) {
        pg8::Gemm g{(const bf16*)(ws + WS_Z), (const bf16*)(ws + WS_WOT), MROWS, DM, DM}; pg8::StaticOrder S; S.init(MROWS, DM, G, bx);
        pg8::EpiResF32 E{a.x, a.out};
        pg8::gemm_phase<pg8::EpiResF32, pg8::StaticOrder, PG8_ALIGN, PG8_SP2>(lds, g, S, E);
    }
    SEAM(7);
    if (IN(8)) phase_p4b(a, gw, NGW, (int)(threadIdx.x & 63));
    SEAM(8);
    if (IN(9)) {
        pg8::Gemm g{(const bf16*)(ws + WS_AQ), (const bf16*)(ws + WS_WUT), MROWS, DFF, DM}; pg8::StaticOrder S; S.init(MROWS, DFF, G, bx);
        pg8::EpiRelu2 E{(bf16*)(ws + WS_HID), DFF};
        pg8::gemm_phase<pg8::EpiRelu2, pg8::StaticOrder, PG8_ALIGN, PG8_SP2>(lds, g, S, E);
    }
    SEAM(9);
    if (IN(10)) {
        pg8::Gemm g{(const bf16*)(ws + WS_HID), (const bf16*)(ws + WS_WDT), MROWS, DM, DFF}; pg8::StaticOrder S; S.init(MROWS, DM, G, bx);
        pg8::EpiResF32 E{a.out, a.out};
        pg8::gemm_phase<pg8::EpiResF32, pg8::StaticOrder, PG8_ALIGN, PG8_SP2>(lds, g, S, E);
    }
}

#ifndef MK_ONE_LAUNCH
#define MK_ONE_LAUNCH 1
#endif
extern "C" void kernel_launch(void* const* d_in, const int* in_sizes, int n_in, void* d_out, int out_size, void* d_ws, size_t ws_size, hipStream_t stream) {
    static int grid = 0;
    if (grid == 0) {
        if (n_in != 13 || in_sizes[0] != MROWS * DM || out_size != MROWS * DM || ws_size < WS_NEED) { fprintf(stderr, "kernel_launch: unexpected shapes/workspace (%d inputs, ws %zu)\n", n_in, ws_size); grid = -1; return; }
        if (hipFuncSetAttribute((const void*)fwd, hipFuncAttributeMaxDynamicSharedMemorySize, LDS_BYTES) != hipSuccess) { fprintf(stderr, "kernel_launch: hipFuncSetAttribute failed\n"); grid = -1; return; }
        int dev = 0, cus = 0, per_cu = 0;
        hipGetDevice(&dev); hipDeviceGetAttribute(&cus, hipDeviceAttributeMultiprocessorCount, dev);
        hipOccupancyMaxActiveBlocksPerMultiprocessor(&per_cu, (const void*)fwd, NWAVES * 64, LDS_BYTES);
        if (per_cu < 1 || cus < 1) { fprintf(stderr, "kernel_launch: occupancy query says %d blocks/CU on %d CUs\n", per_cu, cus); grid = -1; return; }
        grid = cus;
    }
    if (grid < 0) return;
    if (hipMemsetAsync((char*)d_ws + WS_CTL, 0, CTL_ZERO_BYTES, stream) != hipSuccess) { fprintf(stderr, "kernel_launch: memset failed\n"); return; }
    Args a{};
    a.x = (const float*)d_in[0]; a.norm_mix_g = (const float*)d_in[1]; a.w_in = (const float*)d_in[2]; a.conv_w = (const float*)d_in[3]; a.a_log = (const float*)d_in[4];
    a.dt_bias = (const float*)d_in[5]; a.gdn_norm_g = (const float*)d_in[6]; a.q_norm_g = (const float*)d_in[7]; a.k_norm_g = (const float*)d_in[8]; a.w_out = (const float*)d_in[9];
    a.norm_mlp_g = (const float*)d_in[10]; a.w_up = (const float*)d_in[11]; a.w_down = (const float*)d_in[12];
    a.out = (float*)d_out; a.ws = (unsigned char*)d_ws;
#if MK_ONE_LAUNCH
    a.ph_lo = 0; a.ph_hi = NPHASE;
    void* args[] = {&a};
    hipError_t e = hipLaunchCooperativeKernel((const void*)fwd, dim3(grid), dim3(NWAVES * 64), args, LDS_BYTES, stream);
    if (e != hipSuccess) fprintf(stderr, "cooperative launch failed: %s (grid %d)\n", hipGetErrorString(e), grid);
#else
    for (int p = 0; p < NPHASE; ++p) { a.ph_lo = p; a.ph_hi = p + 1; hipLaunchKernelGGL(fwd, dim3(grid), dim3(NWAVES * 64), LDS_BYTES, stream, a); }
#endif
}
```

```cpp
#include <hip/hip_runtime.h>
#include <hip/hip_cooperative_groups.h>
#include <cstdio>
#include <cstdint>
namespace pg8 {
#define PG8_LAS __attribute__((address_space(3)))
typedef unsigned short bf16_t;
typedef short bf16x8 __attribute__((ext_vector_type(8)));
typedef float f32x4 __attribute__((ext_vector_type(4)));
typedef unsigned u32x4 __attribute__((ext_vector_type(4)));
constexpr int BM = 256, BK = 64, HALF = 128, HTB = HALF * BK * 2  , STAGE_BYTES = 8 * HTB, NXCD = 8, WGM = 8;

__host__ __device__ __forceinline__ int lds_byte(int r, int c) { const int st = (r >> 4) * 2 + (c >> 5), rr = r & 15, cc = c & 31, ob = rr * 64 + cc * 2; return st * 1024 + (ob ^ (((ob >> 9) & 1) << 5)); }
__host__ __device__ __forceinline__ void stage_rc(int b, int& R, int& C) { const int st = b / 1024, sb = b % 1024, swz = sb ^ (((sb >> 9) & 1) << 5); R = (st >> 1) * 16 + swz / 64; C = (st & 1) * 32 + (swz % 64) / 2; }
__host__ __device__ __forceinline__ int perm32(int rho) { const int n = rho >> 4, i = rho & 15; return 8 * (i >> 2) + 4 * n + (i & 3); }

struct Unit { int pm, pn; };
struct Gemm { const bf16_t* A; const bf16_t* Bt; int M, N, K; };

struct StaticOrder {
    int nM, nN, nwg, G, c;
    __host__ __device__ void init(int M, int N, int G_, int c_) { nM = M / BM; nN = N / BM; nwg = nM * nN; G = G_; c = c_; }
    __host__ __device__ bool next(int i, Unit& u) const {
        const long L = (long)i * G + c; if (L >= nwg) return false;
        int wgid = (int)L; { const int q = nwg / NXCD, r = nwg % NXCD, xcd = wgid % NXCD, off = wgid / NXCD; wgid = (xcd < r ? xcd * (q + 1) : r * (q + 1) + (xcd - r) * q) + off; }
        const int nig = WGM * nN, gid = wgid / nig, fm = gid * WGM, gsz = (nM - fm) < WGM ? (nM - fm) : WGM;
        u.pm = fm + ((wgid % nig) % gsz); u.pn = (wgid % nig) / gsz; return true;
    }
    __device__ __forceinline__ void a_ready(const Unit&) const {}
    __device__ __forceinline__ void done(const Unit&) const {}
};

__device__ __forceinline__ unsigned cvt_pk_bf16(float lo, float hi) { unsigned r; asm volatile("v_cvt_pk_bf16_f32 %0, %1, %2" : "=v"(r) : "v"(lo), "v"(hi)); return r; }
typedef unsigned u32x2 __attribute__((ext_vector_type(2)));
__device__ __forceinline__ float bf_lo(unsigned w) { return __builtin_bit_cast(float, w << 16); }
__device__ __forceinline__ float bf_hi(unsigned w) { return __builtin_bit_cast(float, w & 0xffff0000u); }
__device__ __forceinline__ float sigmoidf_(float x) { return 1.0f / (1.0f + __expf(-x)); }

struct EpiInProj {
    static constexpr bool PERM = true, AFTER_DRAIN = false;
    bf16_t *QKV, *Z, *AQ, *AKV, *IQ, *IK, *HALO; float* SM;
    __device__ __forceinline__ void operator()(const f32x4 (&acc)[2][2][4][2], const Unit& u, int wr, int wc, int fr, int fq) const {
        const int pn = u.pn; const int row0 = u.pm * BM + wr * 64 + fr;
        if (pn < 24) {
            bf16_t* base; int ldc, colt;
            if (pn < 12) { base = QKV; ldc = 3072; colt = pn * 256; }
            else if (pn < 16) { base = Z; ldc = 1024; colt = (pn - 12) * 256; }
            else if (pn < 20) { base = AQ; ldc = 1024; colt = (pn - 16) * 256; }
            else if (pn < 22) { base = AKV; ldc = 512; colt = (pn - 20) * 256; }
            else { base = IQ; ldc = 512; colt = (pn - 22) * 256; }
            const int col0 = colt + wc * 32 + 8 * fq;
#pragma unroll
            for (int ai = 0; ai < 2; ++ai)
#pragma unroll
                for (int m = 0; m < 4; ++m) { const int row = row0 + ai * HALF + m * 16; bf16_t* rowp = base + (size_t)row * ldc + col0;
#pragma unroll
                    for (int bj = 0; bj < 2; ++bj) { const f32x4 v0 = acc[ai][bj][m][0], v1 = acc[ai][bj][m][1];
                        u32x4 w; w.x = cvt_pk_bf16(v0[0], v0[1]); w.y = cvt_pk_bf16(v0[2], v0[3]); w.z = cvt_pk_bf16(v1[0], v1[1]); w.w = cvt_pk_bf16(v1[2], v1[3]);
                        *(u32x4*)(rowp + bj * HALF) = w;
                        if (pn < 12 && m == 3 && fr >= 13) *(u32x4*)(HALO + ((size_t)(row >> 6) * 3 + (fr - 13)) * 3072 + col0 + bj * HALF) = w; } }
        } else {
#pragma unroll
            for (int ai = 0; ai < 2; ++ai)
#pragma unroll
                for (int m = 0; m < 4; ++m) { const int row = row0 + ai * HALF + m * 16; const f32x4 v0 = acc[ai][0][m][0], v1 = acc[ai][0][m][1];
                    if (wc < 2) { u32x4 w; w.x = cvt_pk_bf16(v0[0], v0[1]); w.y = cvt_pk_bf16(v0[2], v0[3]); w.z = cvt_pk_bf16(v1[0], v1[1]); w.w = cvt_pk_bf16(v1[2], v1[3]);
                        *(u32x4*)(IK + (size_t)row * 64 + wc * 32 + 8 * fq) = w; }
                    else if (wc == 2 && fq < 3) { float* p = SM + (size_t)row * 32 + 8 * fq; *(f32x4*)p = v0; *(f32x4*)(p + 4) = v1; } }
        }
    }
};
struct EpiGate {
    static constexpr bool PERM = true, AFTER_DRAIN = false;
    const bf16_t* OG; int ldog; const bf16_t* OA; int ldoa; bf16_t* MG;
    __device__ __forceinline__ void operator()(const f32x4 (&acc)[2][2][4][2], const Unit& u, int wr, int wc, int fr, int fq) const {
        const int row0 = u.pm * BM + wr * 64 + fr; const int ch0 = u.pn * 128 + wc * 32 + 8 * fq;
#pragma unroll
        for (int ai = 0; ai < 2; ++ai)
#pragma unroll
            for (int m = 0; m < 4; ++m) { const int row = row0 + ai * HALF + m * 16;
                const u32x4 og = *(const u32x4*)(OG + (size_t)row * ldog + ch0); const u32x4 oa = *(const u32x4*)(OA + (size_t)row * ldoa + ch0);
                const f32x4 a0 = acc[ai][0][m][0], a1 = acc[ai][0][m][1], b0 = acc[ai][1][m][0], b1 = acc[ai][1][m][1];
                float r[8];
                r[0] = sigmoidf_(a0[0]) * bf_lo(og.x) + sigmoidf_(b0[0]) * bf_lo(oa.x); r[1] = sigmoidf_(a0[1]) * bf_hi(og.x) + sigmoidf_(b0[1]) * bf_hi(oa.x);
                r[2] = sigmoidf_(a0[2]) * bf_lo(og.y) + sigmoidf_(b0[2]) * bf_lo(oa.y); r[3] = sigmoidf_(a0[3]) * bf_hi(og.y) + sigmoidf_(b0[3]) * bf_hi(oa.y);
                r[4] = sigmoidf_(a1[0]) * bf_lo(og.z) + sigmoidf_(b1[0]) * bf_lo(oa.z); r[5] = sigmoidf_(a1[1]) * bf_hi(og.z) + sigmoidf_(b1[1]) * bf_hi(oa.z);
                r[6] = sigmoidf_(a1[2]) * bf_lo(og.w) + sigmoidf_(b1[2]) * bf_lo(oa.w); r[7] = sigmoidf_(a1[3]) * bf_hi(og.w) + sigmoidf_(b1[3]) * bf_hi(oa.w);
                u32x4 w; w.x = cvt_pk_bf16(r[0], r[1]); w.y = cvt_pk_bf16(r[2], r[3]); w.z = cvt_pk_bf16(r[4], r[5]); w.w = cvt_pk_bf16(r[6], r[7]);
                *(u32x4*)(MG + (size_t)row * 1024 + ch0) = w; }
    }
};
struct EpiResF32 {
    static constexpr bool PERM = false, AFTER_DRAIN = false;
    const float* base; float* out;
    __device__ __forceinline__ void operator()(const f32x4 (&acc)[2][2][4][2], const Unit& u, int wr, int wc, int fr, int fq) const {
        const int col0 = u.pn * BM + wc * 32 + 4 * fq;
#pragma unroll
        for (int ai = 0; ai < 2; ++ai)
#pragma unroll
            for (int m = 0; m < 4; ++m) { const size_t off = (size_t)(u.pm * BM + ai * HALF + wr * 64 + m * 16 + fr) * 1024 + col0;
#pragma unroll
                for (int bj = 0; bj < 2; ++bj)
#pragma unroll
                    for (int n = 0; n < 2; ++n) { const f32x4 bs = *(const f32x4*)(base + off + bj * HALF + n * 16); *(f32x4*)(out + off + bj * HALF + n * 16) = bs + acc[ai][bj][m][n]; } }
    }
};
struct EpiRelu2 {
    static constexpr bool PERM = true, AFTER_DRAIN = false;
    bf16_t* O; int ldc;
    __device__ __forceinline__ void operator()(const f32x4 (&acc)[2][2][4][2], const Unit& u, int wr, int wc, int fr, int fq) const {
        const int row0 = u.pm * BM + wr * 64 + fr; const int col0 = u.pn * BM + wc * 32 + 8 * fq;
#pragma unroll
        for (int ai = 0; ai < 2; ++ai)
#pragma unroll
            for (int m = 0; m < 4; ++m) { bf16_t* rowp = O + (size_t)(row0 + ai * HALF + m * 16) * ldc + col0;
#pragma unroll
                for (int bj = 0; bj < 2; ++bj) { f32x4 v0 = acc[ai][bj][m][0], v1 = acc[ai][bj][m][1];
#pragma unroll
                    for (int i = 0; i < 4; ++i) { const float a = fmaxf(v0[i], 0.f), b = fmaxf(v1[i], 0.f); v0[i] = a * a; v1[i] = b * b; }
                    u32x4 w; w.x = cvt_pk_bf16(v0[0], v0[1]); w.y = cvt_pk_bf16(v0[2], v0[3]); w.z = cvt_pk_bf16(v1[0], v1[1]); w.w = cvt_pk_bf16(v1[2], v1[3]);
                    *(u32x4*)(rowp + bj * HALF) = w; } }
    }
};
template <class Epi, class Sched, bool ALIGN_EPI = false, bool SP2 = false>
__device__ __forceinline__ void gemm_phase(PG8_LAS unsigned char* lds, const Gemm g, const Sched& S, const Epi& E) {
    const int tid = threadIdx.x, wid = __builtin_amdgcn_readfirstlane(tid >> 6), lane = tid & 63, wr = wid >> 2, wc = wid & 3, fr = lane & 15, fq = lane >> 4;
    const int K = g.K, nt = K / BK;
    unsigned voffA[2], voffB[2];
#pragma unroll
    for (int i = 0; i < 2; ++i) { int R, C; stage_rc(tid * 16 + i * 8192, R, C); const int Rb = Epi::PERM ? ((R & ~31) + perm32(R & 31)) : R;
        voffA[i] = (unsigned)(R * K + C) * 2u; voffB[i] = (unsigned)(Rb * K + C) * 2u; }
    const size_t kstep = (size_t)(BK * 2);
    const size_t hstep = (size_t)HALF * K * 2;
    const size_t tstep = 2 * hstep;
    const unsigned ldsw = (unsigned)wid * 1024u;
    const int aoff = lds_byte(wr * 64 + fr, fq * 8), boff = lds_byte(wc * 32 + fr, fq * 8);
#define PG8_SA(b, h) (((b) * 2 + (h)) * HTB)
#define PG8_SB(b, h) ((4 + (b) * 2 + (h)) * HTB)
#define PG8_STAGE(bufoff, gbase, voff) do { _Pragma("unroll") for (int _i = 0; _i < 2; ++_i) \
        __builtin_amdgcn_global_load_lds((const unsigned*)((const char*)(gbase) + (voff)[_i]), (PG8_LAS unsigned*)(lds + (bufoff) + ldsw + _i * 8192), 16, 0, 0); } while (0)
#define PG8_LDA(dst, b, h) do { _Pragma("unroll") for (int m = 0; m < 4; ++m) _Pragma("unroll") for (int k = 0; k < 2; ++k) dst[m][k] = *(const PG8_LAS bf16x8*)(lds + PG8_SA(b, h) + aoff + m * 2048 + k * 1024); } while (0)
#define PG8_LDB(dst, b, h) do { _Pragma("unroll") for (int n = 0; n < 2; ++n) _Pragma("unroll") for (int k = 0; k < 2; ++k) dst[n][k] = *(const PG8_LAS bf16x8*)(lds + PG8_SB(b, h) + boff + n * 2048 + k * 1024); } while (0)
#define PG8_MMA(ai, bj, At, Bt) do { __builtin_amdgcn_s_setprio(1); _Pragma("unroll") for (int m = 0; m < 4; ++m) _Pragma("unroll") for (int n = 0; n < 2; ++n) _Pragma("unroll") for (int k = 0; k < 2; ++k) \
        acc[ai][bj][m][n] = __builtin_amdgcn_mfma_f32_16x16x32_bf16(Bt[n][k], At[m][k], acc[ai][bj][m][n], 0, 0, 0); __builtin_amdgcn_s_setprio(0); } while (0)
#define PG8_WAIT_V(n) asm volatile("s_waitcnt vmcnt(" #n ")" ::: "memory")
#define PG8_WAIT_L(n) asm volatile("s_waitcnt lgkmcnt(" #n ")" ::: "memory")
#define PG8_BAR __builtin_amdgcn_s_barrier()
#define PG8_SCHED __builtin_amdgcn_sched_barrier(0)
    Unit cur, nxt; int ui = 0;
    if (!S.next(0, cur)) return;
    f32x4 acc[2][2][4][2];
#pragma unroll
    for (int a = 0; a < 2; ++a)
#pragma unroll
        for (int b = 0; b < 2; ++b)
#pragma unroll
            for (int m = 0; m < 4; ++m)
#pragma unroll
                for (int n = 0; n < 2; ++n) acc[a][b][m][n] = (f32x4){0.f, 0.f, 0.f, 0.f};
    bf16x8 At[4][2], B0[2][2], B1[2][2];
    const char* cA = (const char*)g.A + (size_t)cur.pm * tstep; const char* cB = (const char*)g.Bt + (size_t)cur.pn * tstep;
    S.a_ready(cur);
    if constexpr (SP2) {
        PG8_STAGE(PG8_SB(0, 0), cB, voffB); PG8_STAGE(PG8_SB(0, 1), cB + hstep, voffB); PG8_STAGE(PG8_SA(0, 0), cA, voffA); PG8_STAGE(PG8_SA(0, 1), cA + hstep, voffA);
        if (wr == 1) PG8_BAR;
        PG8_WAIT_V(2); PG8_BAR;
        PG8_STAGE(PG8_SB(1, 0), cB + kstep, voffB); PG8_STAGE(PG8_SA(1, 0), cA + kstep, voffA); PG8_STAGE(PG8_SB(1, 1), cB + hstep + kstep, voffB);
        PG8_WAIT_V(6); PG8_BAR;
    } else {
        PG8_STAGE(PG8_SB(0, 0), cB, voffB); PG8_STAGE(PG8_SA(0, 0), cA, voffA); PG8_STAGE(PG8_SB(0, 1), cB + hstep, voffB); PG8_STAGE(PG8_SA(0, 1), cA + hstep, voffA);
        if (wr == 1) PG8_BAR;
        PG8_WAIT_V(4); PG8_BAR;
        PG8_STAGE(PG8_SB(1, 0), cB + kstep, voffB); PG8_STAGE(PG8_SA(1, 0), cA + kstep, voffA); PG8_STAGE(PG8_SB(1, 1), cB + hstep + kstep, voffB);
        PG8_WAIT_V(6); PG8_BAR;
    }
    for (;;) {
        const bool has_next = S.next(ui + 1, nxt);
        const char* nA = has_next ? (const char*)g.A + (size_t)nxt.pm * tstep : cA; const char* nB = has_next ? (const char*)g.Bt + (size_t)nxt.pn * tstep : cB;
        for (int t = 0; t < nt; t += 2) {
            const bool last = (t == nt - 2);
            const char* a1 = cA + (size_t)(t + 1) * kstep;
            const char* a2 = last ? nA : cA + (size_t)(t + 2) * kstep; const char* b2 = last ? nB : cB + (size_t)(t + 2) * kstep;
            const char* a3 = a2 + kstep; const char* b3 = b2 + kstep;
            if (last && has_next) S.a_ready(nxt);
            if constexpr (SP2) {
            PG8_LDB(B0, 0, 0); PG8_LDB(B1, 0, 1); PG8_SCHED; PG8_LDA(At, 0, 0); PG8_STAGE(PG8_SA(1, 1), a1 + hstep, voffA);
            PG8_WAIT_V(8); PG8_WAIT_L(0); PG8_BAR; PG8_MMA(0, 0, At, B0); PG8_MMA(0, 1, At, B1); PG8_BAR; PG8_SCHED;
            PG8_LDA(At, 0, 1); PG8_STAGE(PG8_SB(0, 0), b2, voffB); PG8_STAGE(PG8_SB(0, 1), b2 + hstep, voffB); PG8_STAGE(PG8_SA(0, 0), a2, voffA);
            PG8_WAIT_V(8); PG8_WAIT_L(0); PG8_BAR; PG8_MMA(1, 0, At, B0); PG8_MMA(1, 1, At, B1); PG8_BAR; PG8_SCHED;
            PG8_LDB(B0, 1, 0); PG8_LDB(B1, 1, 1); PG8_SCHED; PG8_LDA(At, 1, 0); PG8_STAGE(PG8_SA(0, 1), a2 + hstep, voffA);
            PG8_WAIT_V(8); PG8_WAIT_L(0); PG8_BAR; PG8_MMA(0, 0, At, B0); PG8_MMA(0, 1, At, B1); PG8_BAR; PG8_SCHED;
            PG8_LDA(At, 1, 1); PG8_STAGE(PG8_SB(1, 0), b3, voffB); PG8_STAGE(PG8_SB(1, 1), b3 + hstep, voffB); PG8_STAGE(PG8_SA(1, 0), a3, voffA);
            PG8_WAIT_V(8); PG8_WAIT_L(0); PG8_BAR; PG8_MMA(1, 0, At, B0); PG8_MMA(1, 1, At, B1); PG8_BAR; PG8_SCHED;
            } else {
            PG8_LDB(B0, 0, 0); PG8_SCHED; PG8_LDA(At, 0, 0); PG8_STAGE(PG8_SA(1, 1), a1 + hstep, voffA);
            PG8_WAIT_L(8); PG8_BAR; PG8_WAIT_L(0); PG8_MMA(0, 0, At, B0); PG8_BAR; PG8_SCHED;
            PG8_LDB(B1, 0, 1); PG8_STAGE(PG8_SB(0, 0), b2, voffB);
            PG8_BAR; PG8_WAIT_L(0); PG8_MMA(0, 1, At, B1); PG8_BAR;
            PG8_LDA(At, 0, 1); PG8_STAGE(PG8_SA(0, 0), a2, voffA);
            PG8_BAR; PG8_WAIT_L(0); PG8_MMA(1, 0, At, B0); PG8_BAR; PG8_SCHED;
            PG8_STAGE(PG8_SB(0, 1), b2 + hstep, voffB);
            PG8_WAIT_V(6); PG8_BAR; PG8_MMA(1, 1, At, B1); PG8_BAR;
            PG8_LDB(B0, 1, 0); PG8_SCHED; PG8_LDA(At, 1, 0); PG8_STAGE(PG8_SA(0, 1), a2 + hstep, voffA);
            PG8_WAIT_L(8); PG8_BAR; PG8_WAIT_L(0); PG8_MMA(0, 0, At, B0); PG8_BAR; PG8_SCHED;
            PG8_LDB(B1, 1, 1); PG8_STAGE(PG8_SB(1, 0), b3, voffB);
            PG8_BAR; PG8_WAIT_L(0); PG8_MMA(0, 1, At, B1); PG8_BAR;
            PG8_LDA(At, 1, 1); PG8_STAGE(PG8_SA(1, 0), a3, voffA);
            PG8_BAR; PG8_WAIT_L(0); PG8_MMA(1, 0, At, B0); PG8_BAR; PG8_SCHED;
            PG8_STAGE(PG8_SB(1, 1), b3 + hstep, voffB);
            PG8_WAIT_V(6); PG8_BAR; PG8_MMA(1, 1, At, B1); PG8_BAR;
            }
        }
        if constexpr (ALIGN_EPI) { if (wr == 0) PG8_BAR; }
        if constexpr (!Epi::AFTER_DRAIN) { E(acc, cur, wr, wc, fr, fq); S.done(cur); }
        if (!has_next) break;
#pragma unroll
        for (int a = 0; a < 2; ++a)
#pragma unroll
            for (int b = 0; b < 2; ++b)
#pragma unroll
                for (int m = 0; m < 4; ++m)
#pragma unroll
                    for (int n = 0; n < 2; ++n) acc[a][b][m][n] = (f32x4){0.f, 0.f, 0.f, 0.f};
        cur = nxt; cA = nA; cB = nB; ++ui;
        if constexpr (ALIGN_EPI) { if (wr == 1) PG8_BAR; }
    }
    PG8_WAIT_V(0);
    if constexpr (!ALIGN_EPI) { if (wr == 0) PG8_BAR; }
    PG8_BAR;
    if constexpr (Epi::AFTER_DRAIN) { E.fused(acc, cur, wr, wc, fr, fq, lds, wid, lane); S.done(cur); }
#undef PG8_SA
#undef PG8_SB
#undef PG8_STAGE
#undef PG8_LDA
#undef PG8_LDB
#undef PG8_MMA
#undef PG8_WAIT_V
#undef PG8_WAIT_L
#undef PG8_BAR
#undef PG8_SCHED
}
}

#ifndef PG8_SP2
#define PG8_SP2 true
#endif
#ifndef PG8_ALIGN
#define PG8_ALIGN true
#endif
constexpr int NB = 4, SEQ = 8192, DM = 1024, MROWS = NB * SEQ, DFF = 4096;
constexpr int NWAVES = 8;
constexpr float EPSN = 1e-6f;
constexpr int N_IN1 = 6400;
constexpr int N_INT = 8448;
constexpr size_t MiB = 1u << 20;
constexpr size_t WS_CTL = 0, CTL_ZERO_BYTES = 1 * MiB;
constexpr size_t WS_ROPEI = 1 * MiB;
constexpr size_t WS_ROPEA = 1 * MiB + 512 * 1024;
constexpr size_t WS_WINT = 3 * MiB;
constexpr size_t WS_WOT = 20 * MiB, WS_WUT = 22 * MiB, WS_WDT = 30 * MiB;
constexpr size_t WS_QKV = 40 * MiB;
constexpr size_t WS_Z = 232 * MiB;
constexpr size_t WS_AQ = 296 * MiB;
constexpr size_t WS_AKV = 360 * MiB;
constexpr size_t WS_IQ = 392 * MiB;
constexpr size_t WS_IK = 424 * MiB;
constexpr size_t WS_SM = 428 * MiB;
constexpr size_t WS_HALO = 432 * MiB;
constexpr size_t WS_TOPK = 442 * MiB;
constexpr size_t WS_HID = 40 * MiB;
constexpr size_t WS_NEED = 460 * MiB;

constexpr int LDS_BYTES = 163840;

#define GAS __attribute__((address_space(1)))
#define LAS __attribute__((address_space(3)))
typedef unsigned short bf16;
typedef unsigned v4u __attribute__((ext_vector_type(4)));
typedef unsigned v2u __attribute__((ext_vector_type(2)));
typedef float f32x4 __attribute__((ext_vector_type(4)));
#define LDS_WAIT() asm volatile("s_waitcnt lgkmcnt(0)" ::: "memory")
__device__ __forceinline__ unsigned f2bf(float f) { unsigned u = __builtin_bit_cast(unsigned, f); return (u + 0x7fffu + ((u >> 16) & 1u)) >> 16; }
__device__ __forceinline__ unsigned pk2(float lo, float hi) { return f2bf(lo) | (f2bf(hi) << 16); }
__device__ __forceinline__ float bflo(unsigned w) { return __builtin_bit_cast(float, w << 16); }
__device__ __forceinline__ float bfhi(unsigned w) { return __builtin_bit_cast(float, w & 0xffff0000u); }
__device__ __forceinline__ float bf2f(bf16 v) { return __builtin_bit_cast(float, ((unsigned)v) << 16); }
__device__ __forceinline__ float wave_sum(float v) {
#pragma unroll
    for (int o = 1; o < 64; o <<= 1) v += __shfl_xor(v, o);
    return v;
}
__device__ __forceinline__ float siluf_(float x) { return x / (1.0f + __expf(-x)); }
__device__ __forceinline__ float sigm_(float x) { return 1.0f / (1.0f + __expf(-x)); }
__device__ __forceinline__ float softplusf_(float x) { return x > 20.f ? x : log1pf(__expf(x)); }

struct Args {
    const float* x; const float* norm_mix_g; const float* w_in; const float* conv_w; const float* a_log; const float* dt_bias;
    const float* gdn_norm_g; const float* q_norm_g; const float* k_norm_g; const float* w_out; const float* norm_mlp_g; const float* w_up; const float* w_down;
    float* out; unsigned char* ws; int ph_lo, ph_hi;
};

__device__ __forceinline__ int win_src_col(int n) {
    if (n < 4096) return n;
    if (n < 6208) return n + 16;
    if (n < 6216) return 4096 + (n - 6208);
    if (n < 6224) return 4104 + (n - 6216);
    if (n < 6232) return 6224 + (n - 6224);
    if (n < 6400) return -1;
    const int j = (n - 6400) >> 8, i = (n - 6400) & 255;
    return i < 128 ? 6232 + 128 * j + i : 7256 + 128 * j + (i - 128);
}
template <bool PERMUTE>
__device__ __forceinline__ void transpose_item(const float* W, int K, int Nsrc, bf16* WT, int n0, int k0, LAS float* scr, int lane) {
    const int nd = n0 + (lane & 31); const int sc = PERMUTE ? win_src_col(nd) : nd;
#pragma unroll 8
    for (int i = 0; i < 32; ++i) { const int kk = 2 * i + (lane >> 5); scr[kk * 33 + (lane & 31)] = sc >= 0 ? W[(size_t)(k0 + kk) * Nsrc + sc] : 0.f; }
    LDS_WAIT(); asm volatile("" ::: "memory");
    const int c = lane & 7;
#pragma unroll
    for (int j = 0; j < 4; ++j) { const int n = (lane >> 3) + 8 * j; const LAS float* s = scr + (8 * c) * 33 + n;
        v4u o; o.x = pk2(s[0 * 33], s[1 * 33]); o.y = pk2(s[2 * 33], s[3 * 33]); o.z = pk2(s[4 * 33], s[5 * 33]); o.w = pk2(s[6 * 33], s[7 * 33]);
        *(GAS v4u*)(WT + (size_t)(n0 + n) * K + k0 + 8 * c) = o; }
    LDS_WAIT(); asm volatile("" ::: "memory");
}
__device__ __forceinline__ void rms_row_to_bf16(const float* xrow, const float* g, bf16* orow, int lane) {
    const GAS f32x4* xr = (const GAS f32x4*)xrow + lane; const GAS f32x4* gr = (const GAS f32x4*)g + lane;
    f32x4 v[4]; float s = 0.f;
#pragma unroll
    for (int j = 0; j < 4; ++j) { v[j] = xr[64 * j]; s += (v[j].x * v[j].x + v[j].y * v[j].y) + (v[j].z * v[j].z + v[j].w * v[j].w); }
    const float rstd = 1.0f / sqrtf(wave_sum(s) * (1.f / DM) + EPSN);
    GAS unsigned long long* o8 = (GAS unsigned long long*)orow + lane;
#pragma unroll
    for (int j = 0; j < 4; ++j) { const f32x4 gv = gr[64 * j];
        o8[64 * j] = (unsigned long long)pk2(v[j].x * rstd * gv.x, v[j].y * rstd * gv.y) | ((unsigned long long)pk2(v[j].z * rstd * gv.z, v[j].w * rstd * gv.w) << 32); }
}

__device__ __forceinline__ void phase_p0(const Args& a, LAS unsigned char* lds, int gw, int NGW, int wave, int lane) {
    LAS float* scr = (LAS float*)(lds + wave * 16384);
    bf16* WinT = (bf16*)(a.ws + WS_WINT); bf16* WoT = (bf16*)(a.ws + WS_WOT); bf16* WuT = (bf16*)(a.ws + WS_WUT); bf16* WdT = (bf16*)(a.ws + WS_WDT);
    constexpr int I_IN = (N_INT / 32) * (DM / 64), I_O = (DM / 32) * (DM / 64), I_U = (DFF / 32) * (DM / 64), I_D = (DM / 32) * (DFF / 64);
    constexpr int NITEMS = I_IN + I_O + I_U + I_D;
    for (int it = gw; it < NITEMS; it += NGW) {
        int r = it;
        if (r < I_IN) { const int nb = r % (N_INT / 32), kb = r / (N_INT / 32); transpose_item<true>(a.w_in, DM, 8280, WinT, nb * 32, kb * 64, scr, lane); continue; } r -= I_IN;
        if (r < I_O) { const int nb = r % (DM / 32), kb = r / (DM / 32); transpose_item<false>(a.w_out, DM, DM, WoT, nb * 32, kb * 64, scr, lane); continue; } r -= I_O;
        if (r < I_U) { const int nb = r % (DFF / 32), kb = r / (DFF / 32); transpose_item<false>(a.w_up, DM, DFF, WuT, nb * 32, kb * 64, scr, lane); continue; } r -= I_U;
        { const int nb = r % (DM / 32), kb = r / (DM / 32); transpose_item<false>(a.w_down, DFF, DM, WdT, nb * 32, kb * 64, scr, lane); }
    }
    float2* RI = (float2*)(a.ws + WS_ROPEI); float2* RA = (float2*)(a.ws + WS_ROPEA);
    for (int e = gw * 64 + lane; e < SEQ * 24; e += NGW * 64) {
        const int t = e / 24, j = e % 24; float inv, sn, cs;
        if (j < 8) { inv = powf(500000.0f, -(float)(2 * j) / 16.0f); const float ang = (float)t * inv; sincosf(ang, &sn, &cs); RI[t * 8 + j] = make_float2(cs, sn); }
        else { const int jj = j - 8; inv = powf(500000.0f, -(float)(2 * jj) / 32.0f); const float ang = (float)t * inv; sincosf(ang, &sn, &cs); RA[t * 16 + jj] = make_float2(cs, sn); }
    }
    bf16* H = (bf16*)a.out;
    for (int m = gw; m < MROWS; m += NGW) rms_row_to_bf16(a.x + (size_t)m * DM, a.norm_mix_g, H + (size_t)m * DM, lane);
}

__device__ __forceinline__ void phase_p1b(const Args& a, int gw, int NGW, int lane) {
    bf16* AQ = (bf16*)(a.ws + WS_AQ); bf16* AKV = (bf16*)(a.ws + WS_AKV); bf16* IQ = (bf16*)(a.ws + WS_IQ); bf16* IK = (bf16*)(a.ws + WS_IK);
    const float2* RI = (const float2*)(a.ws + WS_ROPEI); const float2* RA = (const float2*)(a.ws + WS_ROPEA);
    for (int m = gw; m < MROWS; m += NGW) {
        const int t = m & (SEQ - 1);
        {
            const int seg = lane & 7; bf16* p = AQ + (size_t)m * 1024 + (lane >> 3) * 128 + seg * 16;
            const v4u w0 = *(const v4u*)p, w1 = *(const v4u*)(p + 8);
            float y[16]; y[0] = bflo(w0.x); y[1] = bfhi(w0.x); y[2] = bflo(w0.y); y[3] = bfhi(w0.y); y[4] = bflo(w0.z); y[5] = bfhi(w0.z); y[6] = bflo(w0.w); y[7] = bfhi(w0.w);
            y[8] = bflo(w1.x); y[9] = bfhi(w1.x); y[10] = bflo(w1.y); y[11] = bfhi(w1.y); y[12] = bflo(w1.z); y[13] = bfhi(w1.z); y[14] = bflo(w1.w); y[15] = bfhi(w1.w);
            float ss = 0.f;
#pragma unroll
            for (int i = 0; i < 16; ++i) ss += y[i] * y[i];
            ss += __shfl_xor(ss, 1); ss += __shfl_xor(ss, 2); ss += __shfl_xor(ss, 4);
            const float rstd = 1.0f / sqrtf(ss * (1.f / 128.f) + EPSN);
#pragma unroll
            for (int i = 0; i < 16; ++i) y[i] = y[i] * rstd * a.q_norm_g[seg * 16 + i];
#pragma unroll
            for (int i = 0; i < 16; ++i) { const float o = __shfl_xor(y[i], 1); const float2 cs = RA[t * 16 + i];
                if (seg == 0) y[i] = y[i] * cs.x - o * cs.y; else if (seg == 1) y[i] = y[i] * cs.x + o * cs.y; }
            v4u o0, o1; o0.x = pk2(y[0], y[1]); o0.y = pk2(y[2], y[3]); o0.z = pk2(y[4], y[5]); o0.w = pk2(y[6], y[7]);
            o1.x = pk2(y[8], y[9]); o1.y = pk2(y[10], y[11]); o1.z = pk2(y[12], y[13]); o1.w = pk2(y[14], y[15]);
            *(v4u*)p = o0; *(v4u*)(p + 8) = o1;
        }
        {
            const int sl = lane & 31; bf16* p = AKV + (size_t)m * 512 + (lane >> 5) * 128 + sl * 4;
            const v2u w = *(const v2u*)p; float y[4] = {bflo(w.x), bfhi(w.x), bflo(w.y), bfhi(w.y)};
            float ss = y[0] * y[0] + y[1] * y[1] + y[2] * y[2] + y[3] * y[3];
            ss += __shfl_xor(ss, 1); ss += __shfl_xor(ss, 2); ss += __shfl_xor(ss, 4); ss += __shfl_xor(ss, 8); ss += __shfl_xor(ss, 16);
            const float rstd = 1.0f / sqrtf(ss * (1.f / 128.f) + EPSN);
#pragma unroll
            for (int i = 0; i < 4; ++i) y[i] = y[i] * rstd * a.k_norm_g[sl * 4 + i];
#pragma unroll
            for (int i = 0; i < 4; ++i) { const float o = __shfl_xor(y[i], 4); const float2 cs = RA[t * 16 + ((sl & 3) * 4 + i)];
                if (sl < 4) y[i] = y[i] * cs.x - o * cs.y; else if (sl < 8) y[i] = y[i] * cs.x + o * cs.y; }
            v2u o; o.x = pk2(y[0], y[1]); o.y = pk2(y[2], y[3]); *(v2u*)p = o;
        }
        {
            const int seg = lane & 7; bf16* p = IQ + (size_t)m * 512 + (lane >> 3) * 64 + seg * 8;
            const v4u w = *(const v4u*)p; float y[8] = {bflo(w.x), bfhi(w.x), bflo(w.y), bfhi(w.y), bflo(w.z), bfhi(w.z), bflo(w.w), bfhi(w.w)};
#pragma unroll
            for (int i = 0; i < 8; ++i) { const float o = __shfl_xor(y[i], 1); const float2 cs = RI[t * 8 + i];
                if (seg == 0) y[i] = y[i] * cs.x - o * cs.y; else if (seg == 1) y[i] = y[i] * cs.x + o * cs.y; }
            v4u o; o.x = pk2(y[0], y[1]); o.y = pk2(y[2], y[3]); o.z = pk2(y[4], y[5]); o.w = pk2(y[6], y[7]); *(v4u*)p = o;
        }
        {
            bf16* p = IK + (size_t)m * 64 + lane; float y = bf2f(*p); const float o = __shfl_xor(y, 8); const float2 cs = RI[t * 8 + (lane & 7)];
            if (lane < 8) y = y * cs.x - o * cs.y; else if (lane < 16) y = y * cs.x + o * cs.y;
            *p = (bf16)f2bf(y);
        }
    }
}
typedef float f32x16 __attribute__((ext_vector_type(16)));
typedef short bf16x8 __attribute__((ext_vector_type(8)));
typedef float f32x2_ __attribute__((ext_vector_type(2)));
typedef __bf16 bf16x2_ __attribute__((ext_vector_type(2)));
__device__ __forceinline__ unsigned pkbf(float a, float b) { const f32x2_ v = {a, b}; return __builtin_bit_cast(unsigned, __builtin_convertvector(v, bf16x2_)); }
__device__ __forceinline__ int crow16(int reg, int h) { return (reg & 3) + 8 * (reg >> 2) + 4 * h; }
__device__ __forceinline__ int p16pos(int o) { return (o & ~12) | ((o & 4) << 1) | ((o & 8) >> 1); }
#define MFMA32(a, b, c) __builtin_amdgcn_mfma_f32_32x32x16_bf16((a), (b), (c), 0, 0, 0)
#define WG_BAR() do { asm volatile("s_waitcnt lgkmcnt(0)" ::: "memory"); __builtin_amdgcn_s_barrier(); asm volatile("" ::: "memory"); } while (0)

constexpr size_t WS_QKP = 458 * MiB;
constexpr size_t WS_GCUM = 490 * MiB;

__device__ __forceinline__ void phase_gdn_prep(const Args& a, LAS unsigned char* lds, int bx, int G, int tid, int wave, int lane) {
    bf16* QKV = (bf16*)(a.ws + WS_QKV); const bf16* HALO = (const bf16*)(a.ws + WS_HALO); const float* SM = (const float*)(a.ws + WS_SM);
    bf16* WGB = (bf16*)a.out + (size_t)MROWS * DM; bf16* QKP = (bf16*)(a.ws + WS_QKP); float* GCUM = (float*)(a.ws + WS_GCUM);
    LAS unsigned char* KS = lds; LAS unsigned char* QS = lds + 17408; LAS float* K32 = (LAS float*)(lds + 34816); LAS float* V32 = (LAS float*)(lds + 67584);
    LAS float* A32 = (LAS float*)(lds + 100352); LAS bf16* QKO = (LAS bf16*)(lds + 116736); LAS float* GC = (LAS float*)(lds + 124928); LAS float* BETA = (LAS float*)(lds + 125184); LAS float* BETAW = (LAS float*)(lds + 125440);
    const int lr = lane & 31, lh = lane >> 5;
    for (int item = bx; item < 4096; item += G) {
        const int b = item >> 10, n = (item >> 3) & 127, h = item & 7; const int row0 = b * SEQ + n * 64; const int ch = (b * 8 + h) * 128 + n;
        if (wave == 0) {
            const size_t row = (size_t)row0 + lane; const float ga = SM[row * 32 + h], gb = SM[row * 32 + 8 + h];
            float g = -__expf(a.a_log[h]) * softplusf_(ga + a.dt_bias[h]);
#pragma unroll
            for (int o = 1; o < 64; o <<= 1) { const float t = __shfl_up(g, o); if (lane >= o) g += t; }
            const float bt = sigm_(gb); GC[lane] = g; BETA[lane] = bt; BETAW[lane] = bt * __expf(g); GCUM[row * 8 + h] = g;
        }
        unsigned qpk[2][4], kpk[2][4];
        {
            const int c = tid & 15, pp = tid >> 4;
#pragma unroll
            for (int pass = 0; pass < 2; ++pass) { const int p = pp + 32 * pass;
#pragma unroll
                for (int m = 0; m < 3; ++m) { const int col = m * 1024 + h * 128 + c * 8; float y[8];
#pragma unroll
                    for (int e = 0; e < 8; ++e) y[e] = 0.f;
#pragma unroll
                    for (int j = 0; j < 4; ++j) { const int r = p - 3 + j; v4u w = {0u, 0u, 0u, 0u};
                        if (r >= 0) w = *(const v4u*)(QKV + (size_t)(row0 + r) * 3072 + col);
                        else if (n > 0) w = *(const v4u*)(HALO + ((size_t)((row0 >> 6) - 1) * 3 + (r + 3)) * 3072 + col);
                        const f32x4 c0 = *(const f32x4*)(a.conv_w + j * 3072 + col), c1 = *(const f32x4*)(a.conv_w + j * 3072 + col + 4);
                        y[0] += c0.x * bflo(w.x); y[1] += c0.y * bfhi(w.x); y[2] += c0.z * bflo(w.y); y[3] += c0.w * bfhi(w.y);
                        y[4] += c1.x * bflo(w.z); y[5] += c1.y * bfhi(w.z); y[6] += c1.z * bflo(w.w); y[7] += c1.w * bfhi(w.w); }
#pragma unroll
                    for (int e = 0; e < 8; ++e) y[e] = siluf_(y[e]);
                    if (m < 2) { float ss = 0.f;
#pragma unroll
                        for (int e = 0; e < 8; ++e) ss += y[e] * y[e];
                        ss += __shfl_xor(ss, 1); ss += __shfl_xor(ss, 2); ss += __shfl_xor(ss, 4); ss += __shfl_xor(ss, 8);
                        float sc = 1.0f / sqrtf(ss + EPSN); if (m == 0) sc *= 0.08838834764831845f;
#pragma unroll
                        for (int e = 0; e < 8; ++e) y[e] *= sc;
                        v4u o; o.x = pkbf(y[0], y[1]); o.y = pkbf(y[2], y[3]); o.z = pkbf(y[4], y[5]); o.w = pkbf(y[6], y[7]);
                        if (m == 0) { qpk[pass][0] = o.x; qpk[pass][1] = o.y; qpk[pass][2] = o.z; qpk[pass][3] = o.w; *(LAS v4u*)(QS + p * 272 + c * 16) = o; }
                        else { kpk[pass][0] = o.x; kpk[pass][1] = o.y; kpk[pass][2] = o.z; kpk[pass][3] = o.w; *(LAS v4u*)(KS + p * 272 + c * 16) = o;
                            *(LAS f32x4*)(K32 + p * 128 + c * 8) = (f32x4){y[0], y[1], y[2], y[3]}; *(LAS f32x4*)(K32 + p * 128 + c * 8 + 4) = (f32x4){y[4], y[5], y[6], y[7]}; }
                    } else { *(LAS f32x4*)(V32 + p * 128 + c * 8) = (f32x4){y[0], y[1], y[2], y[3]}; *(LAS f32x4*)(V32 + p * 128 + c * 8 + 4) = (f32x4){y[4], y[5], y[6], y[7]}; }
                } }
        }
        __syncthreads();
        {
            const int c = tid & 15, pp = tid >> 4;
#pragma unroll
            for (int pass = 0; pass < 2; ++pass) { const int p = pp + 32 * pass; bf16* rp = QKV + (size_t)(row0 + p) * 3072 + h * 128 + c * 8;
                *(v4u*)rp = (v4u){qpk[pass][0], qpk[pass][1], qpk[pass][2], qpk[pass][3]}; *(v4u*)(rp + 1024) = (v4u){kpk[pass][0], kpk[pass][1], kpk[pass][2], kpk[pass][3]}; }
        }
        {
            const int wsub = wave & 3, ti = wsub >> 1, tj = wsub & 1; const bool isqk = wave >= 4;
            f32x16 acc;
#pragma unroll
            for (int i = 0; i < 16; ++i) acc[i] = 0.f;
            if (!(ti == 0 && tj == 1)) {
                const LAS unsigned char* XS = isqk ? QS : KS;
#pragma unroll
                for (int s = 0; s < 8; ++s) { const bf16x8 av = *(const LAS bf16x8*)(XS + (32 * ti + lr) * 272 + (16 * s + 8 * lh) * 2); const bf16x8 bv = *(const LAS bf16x8*)(KS + (32 * tj + lr) * 272 + (16 * s + 8 * lh) * 2);
                    acc = MFMA32(av, bv, acc); }
            }
            const int col = 32 * tj + lr; const float gcol = GC[col];
#pragma unroll
            for (int i = 0; i < 16; ++i) { const int row = 32 * ti + crow16(i, lh); const float dec = __expf(fminf(GC[row] - gcol, 0.f));
                if (!isqk) A32[row * 64 + col] = (row > col) ? acc[i] * BETA[row] * dec : 0.f;
                else QKO[row * 64 + p16pos(col)] = (bf16)((row >= col) ? (pkbf(acc[i] * dec, 0.f) & 0xffffu) : 0u); }
        }
        __syncthreads();
        if (wave < 4) {
            int vz; asm volatile("v_mov_b32 %0, 0" : "=v"(vz));
            const LAS float* A32v = A32 + vz; const LAS float* BMv = (wave >= 2 ? BETAW : BETA) + vz;
            const int cidx = wave * 64 + lane; const bool isw = wave >= 2; const LAS float* R = isw ? (K32 + (cidx - 128)) : (V32 + cidx);
            float t[64];
#pragma unroll
            for (int i = 0; i < 64; ++i) t[i] = 0.f;
#pragma unroll
            for (int i = 0; i < 64; ++i) {
                const float rhs = R[i * 128] * BMv[i];
                float a0 = rhs, a1 = 0.f, a2 = 0.f, a3 = 0.f;
#pragma unroll
                for (int j = 0; j < ((i + 3) & ~3); j += 4) { const f32x4 av = *(const LAS f32x4*)(A32v + i * 64 + j); a0 -= av.x * t[j]; a1 -= av.y * t[j + 1]; a2 -= av.z * t[j + 2]; a3 -= av.w * t[j + 3]; }
                t[i] = (a0 + a1) + (a2 + a3);
                asm volatile("" ::: "memory");
            }
            if (!isw) { bf16* up = QKV + (size_t)row0 * 3072 + 2048 + h * 128 + cidx;
#pragma unroll
                for (int i = 0; i < 64; ++i) up[(size_t)i * 3072] = (bf16)(pkbf(t[i], 0.f) & 0xffffu); }
            else { bf16* wp = WGB + (size_t)row0 * 1024 + h * 128 + (cidx - 128);
#pragma unroll
                for (int i = 0; i < 64; ++i) wp[(size_t)i * 1024] = (bf16)(pkbf(t[i], 0.f) & 0xffffu); }
        } else {
            const int lt = tid - 256; const LAS v4u* src = (const LAS v4u*)QKO; v4u* dst = (v4u*)(QKP + (size_t)ch * 4096);
            dst[lt] = src[lt]; dst[lt + 256] = src[lt + 256];
        }
        __syncthreads();
    }
}
constexpr int SC_WL = 0, SC_QL = 17408, SC_KTL = 34816, SC_QKL = 53248, SC_UL = 62464, SC_BUF = 78848, SC_MISC = 2 * SC_BUF;
__device__ __forceinline__ void phase_scan(const Args& a, LAS unsigned char* lds, int bh, int tid, int wave, int lane) {
    bf16* QKV = (bf16*)(a.ws + WS_QKV); const bf16* WGB = (const bf16*)a.out + (size_t)MROWS * DM; const bf16* QKP = (const bf16*)(a.ws + WS_QKP);
    const float* GCUM = (const float*)(a.ws + WS_GCUM); const bf16* Z = (const bf16*)(a.ws + WS_Z);
    const int b = bh >> 3, h = bh & 7; const int lr = lane & 31, lh = lane >> 5;
    LAS float* GLs = (LAS float*)(lds + SC_MISC);
    if (wave < 4) {
        const int jb = wave;
        f32x16 Sacc[4]; bf16x8 Sf[4][2];
#pragma unroll
        for (int r = 0; r < 4; ++r) {
#pragma unroll
            for (int i = 0; i < 16; ++i) Sacc[r][i] = 0.f;
#pragma unroll
            for (int s = 0; s < 2; ++s)
#pragma unroll
                for (int e = 0; e < 8; ++e) Sf[r][s][e] = 0; }
        WG_BAR();
        for (int n = 0; n < 128; ++n) {
            LAS unsigned char* B = lds + (n & 1) * SC_BUF;
            f32x16 ws_[2];
#pragma unroll
            for (int rt = 0; rt < 2; ++rt) {
#pragma unroll
                for (int i = 0; i < 16; ++i) ws_[rt][i] = 0.f; }
#pragma unroll
            for (int ks = 0; ks < 8; ++ks) {
#pragma unroll
                for (int rt = 0; rt < 2; ++rt) {
                    const bf16x8 aw = *(const LAS bf16x8*)(B + SC_WL + (32 * rt + lr) * 272 + ks * 32 + lh * 16);
                    ws_[rt] = MFMA32(aw, Sf[ks >> 1][ks & 1], ws_[rt]); } }
            bf16x8 vf[2][2];
#pragma unroll
            for (int rt = 0; rt < 2; ++rt) {
                float vn[16];
#pragma unroll
                for (int i = 0; i < 16; ++i) { const int row = 32 * rt + crow16(i, lh); vn[i] = bf2f(*(const LAS bf16*)(B + SC_UL + row * 256 + (32 * jb + lr) * 2)) - ws_[rt][i]; }
#pragma unroll
                for (int s = 0; s < 2; ++s) { v4u p; p.x = pkbf(vn[8 * s], vn[8 * s + 1]); p.y = pkbf(vn[8 * s + 2], vn[8 * s + 3]); p.z = pkbf(vn[8 * s + 4], vn[8 * s + 5]); p.w = pkbf(vn[8 * s + 6], vn[8 * s + 7]);
                    vf[rt][s] = __builtin_bit_cast(bf16x8, p); } }
#pragma unroll
            for (int rt = 0; rt < 2; ++rt) {
                f32x16 qs_;
#pragma unroll
                for (int i = 0; i < 16; ++i) qs_[i] = 0.f;
#pragma unroll
                for (int ks = 0; ks < 8; ++ks) { const bf16x8 aq = *(const LAS bf16x8*)(B + SC_QL + (32 * rt + lr) * 272 + ks * 32 + lh * 16); qs_ = MFMA32(aq, Sf[ks >> 1][ks & 1], qs_); }
#pragma unroll
                for (int jt = 0; jt <= rt; ++jt)
#pragma unroll
                    for (int s = 0; s < 2; ++s) { const bf16x8 am = *(const LAS bf16x8*)(B + SC_QKL + (32 * rt + lr) * 144 + (jt * 2 + s) * 32 + lh * 16); qs_ = MFMA32(am, vf[jt][s], qs_); }
#pragma unroll
                for (int i = 0; i < 16; ++i) { const int row = 32 * rt + crow16(i, lh); *(LAS bf16*)(B + SC_UL + row * 256 + (32 * jb + lr) * 2) = (bf16)(pkbf(qs_[i], 0.f) & 0xffffu); }
            }
            const float gl = GLs[n & 1];
#pragma unroll
            for (int r = 0; r < 4; ++r) {
#pragma unroll
                for (int i = 0; i < 16; ++i) Sacc[r][i] *= gl;
#pragma unroll
                for (int ks = 0; ks < 4; ++ks) { const bf16x8 ak = *(const LAS bf16x8*)(B + SC_KTL + (32 * r + lr) * 144 + ks * 32 + lh * 16); Sacc[r] = MFMA32(ak, vf[ks >> 1][ks & 1], Sacc[r]); }
#pragma unroll
                for (int s = 0; s < 2; ++s) { v4u p; p.x = pkbf(Sacc[r][8 * s], Sacc[r][8 * s + 1]); p.y = pkbf(Sacc[r][8 * s + 2], Sacc[r][8 * s + 3]); p.z = pkbf(Sacc[r][8 * s + 4], Sacc[r][8 * s + 5]); p.w = pkbf(Sacc[r][8 * s + 6], Sacc[r][8 * s + 7]);
                    Sf[r][s] = __builtin_bit_cast(bf16x8, p); } }
            WG_BAR();
        }
    } else {
        const int lt = tid - 256; const int up = lt >> 2, uq = lt & 3;
        v4u rw[4], rq[4], rk[4], ru[4], rm[2], rz[4]; float gq[4], glast = 0.f;
        auto issue = [&](int m) {
            const size_t row0 = (size_t)b * SEQ + (size_t)m * 64; const size_t ch = (size_t)bh * 128 + m;
#pragma unroll
            for (int i = 0; i < 4; ++i) { const int idx = lt + 256 * i, p = idx >> 4, c = idx & 15;
                rw[i] = *(const v4u*)(WGB + (row0 + p) * 1024 + h * 128 + c * 8);
                rq[i] = *(const v4u*)(QKV + (row0 + p) * 3072 + h * 128 + c * 8);
                rk[i] = *(const v4u*)(QKV + (row0 + p) * 3072 + 1024 + h * 128 + c * 8);
                ru[i] = *(const v4u*)(QKV + (row0 + up) * 3072 + 2048 + h * 128 + uq * 32 + i * 8);
                gq[i] = GCUM[(row0 + p) * 8 + h]; }
#pragma unroll
            for (int i = 0; i < 2; ++i) rm[i] = *(const v4u*)(QKP + ch * 4096 + (size_t)(lt + 256 * i) * 8);
            glast = GCUM[(row0 + 63) * 8 + h];
        };
        auto stage = [&](int bb) {
            LAS unsigned char* B = lds + bb * SC_BUF;
#pragma unroll
            for (int i = 0; i < 4; ++i) { const int idx = lt + 256 * i, p = idx >> 4, c = idx & 15; const int g16 = c >> 1, o8 = (c & 1) * 8;
                LAS unsigned char* wd = B + SC_WL + p * 272 + g16 * 32 + o8;
                *(LAS v2u*)wd = (v2u){rw[i].x, rw[i].y}; *(LAS v2u*)(wd + 16) = (v2u){rw[i].z, rw[i].w};
                const float eq = __expf(gq[i]); v4u q = rq[i];
                q.x = pkbf(bflo(q.x) * eq, bfhi(q.x) * eq); q.y = pkbf(bflo(q.y) * eq, bfhi(q.y) * eq); q.z = pkbf(bflo(q.z) * eq, bfhi(q.z) * eq); q.w = pkbf(bflo(q.w) * eq, bfhi(q.w) * eq);
                LAS unsigned char* qd = B + SC_QL + p * 272 + g16 * 32 + o8;
                *(LAS v2u*)qd = (v2u){q.x, q.y}; *(LAS v2u*)(qd + 16) = (v2u){q.z, q.w};
                const float ek = __expf(glast - gq[i]); const v4u k = rk[i]; const int pc = p16pos(p);
                LAS unsigned char* kd = B + SC_KTL + (c * 8) * 144 + pc * 2;
                *(LAS bf16*)(kd + 0 * 144) = (bf16)(pkbf(bflo(k.x) * ek, 0.f) & 0xffffu); *(LAS bf16*)(kd + 1 * 144) = (bf16)(pkbf(bfhi(k.x) * ek, 0.f) & 0xffffu);
                *(LAS bf16*)(kd + 2 * 144) = (bf16)(pkbf(bflo(k.y) * ek, 0.f) & 0xffffu); *(LAS bf16*)(kd + 3 * 144) = (bf16)(pkbf(bfhi(k.y) * ek, 0.f) & 0xffffu);
                *(LAS bf16*)(kd + 4 * 144) = (bf16)(pkbf(bflo(k.z) * ek, 0.f) & 0xffffu); *(LAS bf16*)(kd + 5 * 144) = (bf16)(pkbf(bfhi(k.z) * ek, 0.f) & 0xffffu);
                *(LAS bf16*)(kd + 6 * 144) = (bf16)(pkbf(bflo(k.w) * ek, 0.f) & 0xffffu); *(LAS bf16*)(kd + 7 * 144) = (bf16)(pkbf(bfhi(k.w) * ek, 0.f) & 0xffffu);
                *(LAS v4u*)(B + SC_UL + up * 256 + (uq * 32 + i * 8) * 2) = ru[i]; }
#pragma unroll
            for (int i = 0; i < 2; ++i) { const int idx = lt + 256 * i; *(LAS v4u*)(B + SC_QKL + (idx >> 3) * 144 + (idx & 7) * 16) = rm[i]; }
            if (lt == 0) GLs[bb] = __expf(glast);
        };
        auto issue_z = [&](int m) { const size_t row = (size_t)b * SEQ + (size_t)m * 64 + up;
#pragma unroll
            for (int i = 0; i < 4; ++i) rz[i] = *(const v4u*)(Z + row * 1024 + h * 128 + uq * 32 + i * 8); };
        auto finish = [&](int m, int bb, bool do_store) {
            const LAS unsigned char* B = lds + bb * SC_BUF; float o[32]; float ss = 0.f;
#pragma unroll
            for (int i = 0; i < 4; ++i) { const v4u w = *(const LAS v4u*)(B + SC_UL + up * 256 + (uq * 32 + i * 8) * 2);
                o[8 * i] = bflo(w.x); o[8 * i + 1] = bfhi(w.x); o[8 * i + 2] = bflo(w.y); o[8 * i + 3] = bfhi(w.y); o[8 * i + 4] = bflo(w.z); o[8 * i + 5] = bfhi(w.z); o[8 * i + 6] = bflo(w.w); o[8 * i + 7] = bfhi(w.w); }
#pragma unroll
            for (int e = 0; e < 32; ++e) ss += o[e] * o[e];
            ss += __shfl_xor(ss, 1); ss += __shfl_xor(ss, 2);
            const float rstd = 1.0f / sqrtf(ss * (1.f / 128.f) + EPSN);
            bf16* op = QKV + ((size_t)b * SEQ + (size_t)m * 64 + up) * 3072 + h * 128 + uq * 32;
#pragma unroll
            for (int i = 0; i < 4; ++i) { const v4u zz = rz[i]; const float* gp = a.gdn_norm_g + uq * 32 + i * 8; const f32x4 g0 = *(const f32x4*)gp, g1 = *(const f32x4*)(gp + 4);
                v4u w; w.x = pkbf(o[8 * i] * rstd * g0.x * siluf_(bflo(zz.x)), o[8 * i + 1] * rstd * g0.y * siluf_(bfhi(zz.x)));
                w.y = pkbf(o[8 * i + 2] * rstd * g0.z * siluf_(bflo(zz.y)), o[8 * i + 3] * rstd * g0.w * siluf_(bfhi(zz.y)));
                w.z = pkbf(o[8 * i + 4] * rstd * g1.x * siluf_(bflo(zz.z)), o[8 * i + 5] * rstd * g1.y * siluf_(bfhi(zz.z)));
                w.w = pkbf(o[8 * i + 6] * rstd * g1.z * siluf_(bflo(zz.w)), o[8 * i + 7] * rstd * g1.w * siluf_(bfhi(zz.w)));
                if (do_store) *(v4u*)(op + i * 8) = w; }
        };
        issue(0); stage(0); issue(1);
        WG_BAR();
        for (int n = 0; n < 128; ++n) {
            finish(n - 1, (n - 1) & 1, n >= 1);
            asm volatile("" ::: "memory");
            stage((n + 1) & 1);
            asm volatile("" ::: "memory");
            issue(n + 2 < 128 ? n + 2 : 127);
            issue_z(n);
            WG_BAR();
        }
        finish(127, 1, true);
    }
}
constexpr int TK_CAP = 512;
__device__ __forceinline__ int tk_bin(unsigned u) { const int t = (int)((u & 0x7fffffffu) >> 17) - 7232; const int mag = min(max(t, 0), 2047); return (u & 0x80000000u) ? 2047 - mag : 2048 + mag; }
__device__ __forceinline__ void phase_topk(const Args& a, LAS unsigned char* lds, int bx, int G, int tid, int wave, int lane) {
    const bf16* IQ = (const bf16*)(a.ws + WS_IQ); const bf16* IK = (const bf16*)(a.ws + WS_IK); const float* SM = (const float*)(a.ws + WS_SM); unsigned short* TOPK = (unsigned short*)(a.ws + WS_TOPK);
    LAS unsigned* HIST = (LAS unsigned*)lds; LAS unsigned short* OUT = (LAS unsigned short*)lds; LAS unsigned long long* CAND = (LAS unsigned long long*)(lds + 8192);
    LAS unsigned* META = (LAS unsigned*)(lds + 131072);
    const int lr = lane & 31, lh = lane >> 5;
    for (int it = bx; it < 2048; it += G) {
        const int qb = 511 - (it >> 2), b = it & 3; const int t0 = qb * 16; const size_t rowq0 = (size_t)b * SEQ + t0;
        if (t0 < 256) { for (int e = tid; e < 4096; e += 512) { const int q = e >> 8, j = e & 255; TOPK[(rowq0 + q) * 256 + j] = (j <= t0 + q) ? (unsigned short)j : (unsigned short)0xFFFF; } continue; }
        bf16x8 af[4][4]; LAS float* WL = (LAS float*)(lds + 131072 + 256);
        { const int hA = (lr & 3) | (((lr >> 3) & 1) << 2), tqA = ((lr >> 2) & 1) | (((lr >> 4) & 1) << 1);
#pragma unroll
          for (int rt = 0; rt < 4; ++rt) {
#pragma unroll
            for (int ks = 0; ks < 4; ++ks) af[rt][ks] = *(const bf16x8*)(IQ + (rowq0 + rt * 4 + tqA) * 512 + hA * 64 + 16 * ks + 8 * lh);
          }
          if (tid < 128) WL[tid] = SM[(rowq0 + (tid >> 3)) * 32 + 16 + (tid & 7)] * (0.35355339059327373f * 0.125f); }
        for (int e = tid; e < 8192; e += 512) ((LAS v4u*)HIST)[e] = (v4u){0u, 0u, 0u, 0u};
        if (tid < 64) META[tid] = 0u;
        __syncthreads();
        const int nt = (t0 + 15) / 32 + 1;
        for (int pass = 0; pass < 2; ++pass) {
            for (int kt = wave; kt < nt; kt += 8) {
                const int s = kt * 32 + lr; const bf16* kp = IK + ((size_t)b * SEQ + s) * 64 + 8 * lh;
                bf16x8 bfr[4];
#pragma unroll
                for (int ks = 0; ks < 4; ++ks) bfr[ks] = *(const bf16x8*)(kp + 16 * ks);
#pragma unroll
                for (int rt = 0; rt < 4; ++rt) {
                    f32x16 acc;
#pragma unroll
                    for (int i = 0; i < 16; ++i) acc[i] = 0.f;
#pragma unroll
                    for (int ks = 0; ks < 4; ++ks) acc = MFMA32(af[rt][ks], bfr[ks], acc);
                    float sa = 0.f, sb = 0.f;
                    { const LAS f32x4* wa = (const LAS f32x4*)(WL + (rt * 4 + lh) * 8); const f32x4 w0 = wa[0], w1 = wa[1], w2 = wa[4], w3 = wa[5];
                      sa = w0.x * fmaxf(acc[0], 0.f) + w0.y * fmaxf(acc[1], 0.f) + w0.z * fmaxf(acc[2], 0.f) + w0.w * fmaxf(acc[3], 0.f) + w1.x * fmaxf(acc[4], 0.f) + w1.y * fmaxf(acc[5], 0.f) + w1.z * fmaxf(acc[6], 0.f) + w1.w * fmaxf(acc[7], 0.f);
                      sb = w2.x * fmaxf(acc[8], 0.f) + w2.y * fmaxf(acc[9], 0.f) + w2.z * fmaxf(acc[10], 0.f) + w2.w * fmaxf(acc[11], 0.f) + w3.x * fmaxf(acc[12], 0.f) + w3.y * fmaxf(acc[13], 0.f) + w3.z * fmaxf(acc[14], 0.f) + w3.w * fmaxf(acc[15], 0.f); }
#pragma unroll
                    for (int hsel = 0; hsel < 2; ++hsel) { const int q = rt * 4 + lh + 2 * hsel; float sc = hsel ? sb : sa; if (sc == 0.f) sc = 0.f;
                        const bool valid = s <= t0 + q; const unsigned u = __builtin_bit_cast(unsigned, sc); const int bin = tk_bin(u);
                        if (pass == 0) { if (valid) atomicAdd((unsigned*)&HIST[q * 2048 + (bin >> 1)], (bin & 1) ? 65536u : 1u); }
                        else if (valid) { const int thr = (int)META[q];
                            if (bin > thr) { const unsigned pos = atomicAdd((unsigned*)&META[32 + q], 1u); if (pos < 256u) OUT[q * 256 + pos] = (unsigned short)s; }
                            else if (bin == thr) { const unsigned pos = atomicAdd((unsigned*)&META[48 + q], 1u);
                                if (pos < (unsigned)TK_CAP) { const unsigned key = (u & 0x80000000u) ? ~u : (u | 0x80000000u); CAND[q * TK_CAP + pos] = ((unsigned long long)key << 32) | (unsigned long long)(65535 - s); } } }
                    }
                }
            }
            __syncthreads();
            if (pass == 0) {
                unsigned thr_[2], nab_[2];
#pragma unroll
                for (int qq = 0; qq < 2; ++qq) { const int q = wave * 2 + qq; const LAS unsigned* hp = HIST + q * 2048 + 32 * lane; unsigned own = 0u;
#pragma unroll
                    for (int w8 = 0; w8 < 8; ++w8) { const v4u x = *(const LAS v4u*)(hp + 4 * w8); own += (x.x & 0xffffu) + (x.x >> 16) + (x.y & 0xffffu) + (x.y >> 16) + (x.z & 0xffffu) + (x.z >> 16) + (x.w & 0xffffu) + (x.w >> 16); }
                    unsigned v = own;
#pragma unroll
                    for (int o = 1; o < 64; o <<= 1) { const unsigned tt = __shfl_down(v, o); if (lane + o < 64) v += tt; }
                    const unsigned long long mk = __ballot(v >= 256u); const int L = 63 - __builtin_clzll(mk);
                    unsigned thr = 0u, nab = 0u;
                    if (lane == L) { unsigned cum = v - own; bool found = false;
                        for (int w = 31; w >= 0 && !found; --w) { const unsigned x = hp[w]; const unsigned hi = x >> 16, lo = x & 0xffffu;
                            if (cum + hi >= 256u) { thr = 64 * L + 2 * w + 1; nab = cum; found = true; }
                            else { cum += hi; if (cum + lo >= 256u) { thr = 64 * L + 2 * w; nab = cum; found = true; } else cum += lo; } } }
                    thr_[qq] = __shfl(thr, L); nab_[qq] = __shfl(nab, L); }
                __syncthreads();
                if (lane == 0) { META[wave * 2] = thr_[0]; META[wave * 2 + 1] = thr_[1]; META[16 + wave * 2] = nab_[0]; META[16 + wave * 2 + 1] = nab_[1]; }
                __syncthreads();
            }
        }
#pragma unroll 1
        for (int qq = 0; qq < 2; ++qq) { const int q = wave * 2 + qq; const unsigned nab = META[16 + q]; const int c2 = min((int)META[48 + q], TK_CAP); const int need = 256 - (int)nab;
            const LAS unsigned long long* cp = CAND + q * TK_CAP;
            for (int i = lane; i < c2; i += 64) { const unsigned long long ci = cp[i]; int rank = 0;
                for (int j = 0; j < c2; ++j) rank += (cp[j] > ci) ? 1 : 0;
                if (rank < need) OUT[q * 256 + nab + rank] = (unsigned short)(65535 - (int)(ci & 0xffffu)); } }
        __syncthreads();
        { const v4u* src = nullptr; (void)src; ((v4u*)(TOPK + rowq0 * 256))[tid] = ((const LAS v4u*)OUT)[tid]; }
        __syncthreads();
    }
}
typedef float f32x4_ __attribute__((ext_vector_type(4)));
constexpr int CW_ATTNQ = 8192;
__device__ __forceinline__ void attn_item(bf16* AQ, const bf16* AKV, const unsigned short* TOPK, LAS unsigned short* IDX, LAS float* PL, int b, int c, int t, int lane) {
    const int col = lane & 15, g = lane >> 4; const size_t row = (size_t)b * SEQ + t;
    *(LAS v2u*)(IDX + 4 * lane) = *(const v2u*)(TOPK + row * 256 + 4 * lane);
    bf16x8 bq[4];
#pragma unroll
    for (int ks = 0; ks < 4; ++ks) { v4u w = {0u, 0u, 0u, 0u}; if (col < 4) w = *(const v4u*)(AQ + row * 1024 + (4 * c + col) * 128 + 32 * ks + 8 * g); bq[ks] = __builtin_bit_cast(bf16x8, w); }
    const bf16* kbase = AKV + (size_t)b * SEQ * 512 + c * 128 + 8 * g;
    float lg[16][4];
#pragma unroll
    for (int T = 0; T < 16; ++T) {
        const unsigned id = IDX[16 * T + col]; const unsigned kid = (id == 0xFFFFu) ? 0u : id; const bf16* kp = kbase + (size_t)kid * 512;
        f32x4_ acc = {0.f, 0.f, 0.f, 0.f};
#pragma unroll
        for (int ks = 0; ks < 4; ++ks) { const bf16x8 ak = *(const bf16x8*)(kp + 32 * ks); acc = __builtin_amdgcn_mfma_f32_16x16x32_bf16(ak, bq[ks], acc, 0, 0, 0); }
        const v2u vv = *(const LAS v2u*)(IDX + 16 * T + 4 * g);
        lg[T][0] = ((vv.x & 0xffffu) == 0xffffu) ? -INFINITY : acc[0] * 0.08838834764831845f; lg[T][1] = ((vv.x >> 16) == 0xffffu) ? -INFINITY : acc[1] * 0.08838834764831845f;
        lg[T][2] = ((vv.y & 0xffffu) == 0xffffu) ? -INFINITY : acc[2] * 0.08838834764831845f; lg[T][3] = ((vv.y >> 16) == 0xffffu) ? -INFINITY : acc[3] * 0.08838834764831845f;
    }
    float m = -INFINITY;
#pragma unroll
    for (int T = 0; T < 16; ++T) m = fmaxf(fmaxf(m, fmaxf(lg[T][0], lg[T][1])), fmaxf(lg[T][2], lg[T][3]));
    m = fmaxf(m, __shfl_xor(m, 16)); m = fmaxf(m, __shfl_xor(m, 32));
    float sum = 0.f;
#pragma unroll
    for (int T = 0; T < 16; ++T)
#pragma unroll
        for (int r = 0; r < 4; ++r) { lg[T][r] = __expf(lg[T][r] - m); sum += lg[T][r]; }
    sum += __shfl_xor(sum, 16); sum += __shfl_xor(sum, 32);
    const float inv = 1.0f / sum;
    if (col < 4) {
#pragma unroll
        for (int T = 0; T < 16; ++T)
#pragma unroll
            for (int r = 0; r < 4; ++r) PL[(16 * T + 4 * g + r) * 4 + col] = lg[T][r] * inv;
    }
    const bf16* vbase = AKV + (size_t)b * SEQ * 512 + 256 + c * 128 + 2 * lane;
    float o[4][2];
#pragma unroll
    for (int h = 0; h < 4; ++h) { o[h][0] = 0.f; o[h][1] = 0.f; }
#pragma unroll 8
    for (int s = 0; s < 256; ++s) {
        const unsigned id = IDX[s]; const unsigned kid = (id == 0xFFFFu) ? 0u : id;
        const unsigned vw = *(const unsigned*)(vbase + (size_t)kid * 512); const f32x4_ p4 = *(const LAS f32x4_*)(PL + 4 * s);
        const float v0 = bflo(vw), v1 = bfhi(vw);
        o[0][0] += p4.x * v0; o[0][1] += p4.x * v1; o[1][0] += p4.y * v0; o[1][1] += p4.y * v1; o[2][0] += p4.z * v0; o[2][1] += p4.z * v1; o[3][0] += p4.w * v0; o[3][1] += p4.w * v1;
    }
#pragma unroll
    for (int h = 0; h < 4; ++h) *(unsigned*)(AQ + row * 1024 + (4 * c + h) * 128 + 2 * lane) = pkbf(o[h][0], o[h][1]);
}
__device__ __forceinline__ void phase_attn(const Args& a, LAS unsigned char* lds, int wave, int lane) {
    bf16* AQ = (bf16*)(a.ws + WS_AQ); const bf16* AKV = (const bf16*)(a.ws + WS_AKV); const unsigned short* TOPK = (const unsigned short*)(a.ws + WS_TOPK);
    unsigned* QH = (unsigned*)(a.ws + WS_CTL) + CW_ATTNQ;
    LAS unsigned short* IDX = (LAS unsigned short*)(lds + wave * 5120); LAS float* PL = (LAS float*)(lds + wave * 5120 + 512);
    const unsigned xcc = (unsigned)__builtin_amdgcn_s_getreg((3 << 11) | 20) & 7u;
    for (int qi = 0; qi < 8; ++qi) {
        const int queue = (int)((xcc + qi) & 7u); const int b = queue >> 1, c = queue & 1;
        for (;;) {
            unsigned base = 0u; if (lane == 0) base = __hip_atomic_fetch_add(QH + queue * 64, 8u, __ATOMIC_RELAXED, __HIP_MEMORY_SCOPE_AGENT);
            base = (unsigned)__builtin_amdgcn_readfirstlane((int)base);
            if (base >= (unsigned)SEQ) break;
            for (int t = (int)base; t < (int)base + 8; ++t) attn_item(AQ, AKV, TOPK, IDX, PL, b, c, t, lane);
        }
    }
}
__device__ __forceinline__ void phase_p4b(const Args& a, int gw, int NGW, int lane) {
    bf16* H2 = (bf16*)(a.ws + WS_AQ);
    for (int m = gw; m < MROWS; m += NGW) rms_row_to_bf16(a.out + (size_t)m * DM, a.norm_mlp_g, H2 + (size_t)m * DM, lane);
}

__device__ __forceinline__ void gdn_naive_dev(int chain, int tid, LAS unsigned char* lb, const bf16* QKV, const bf16* Z, const float* SM, const float* conv_w, const float* a_log, const float* dt_bias,
                                              const float* gnorm_g, bf16* OG) {
    const int b = chain >> 3, h = chain & 7, lane = tid & 63, wave = tid >> 6;
    typedef float row128[128];
    LAS row128* sq = (LAS row128*)lb; LAS row128* sk = sq + 32; LAS row128* sv = sk + 32; LAS row128* so = sv + 32;
    LAS float* sdec = (LAS float*)(so + 32); LAS float* sbeta = sdec + 32;
    LAS row128* redA = (LAS row128*)(sbeta + 32); LAS row128* redB = redA + 2;
    float S[64];
#pragma unroll
    for (int i = 0; i < 64; ++i) S[i] = 0.f;
    const int col = tid & 127, half = tid >> 7;
    const float aexp = __expf(a_log[h]), dtb = dt_bias[h];
    for (int t0 = 0; t0 < SEQ; t0 += 32) {
        for (int e = tid; e < 32 * 384; e += 256) {
            const int tok = e / 384, cch = e % 384, which = cch >> 7, d = cch & 127, ch = which * 1024 + h * 128 + d, t = t0 + tok;
            float y = 0.f;
#pragma unroll
            for (int j = 0; j < 4; ++j) { const int tt = t - 3 + j; if (tt >= 0) y += conv_w[j * 3072 + ch] * bf2f(QKV[((size_t)b * SEQ + tt) * 3072 + ch]); }
            y = siluf_(y);
            if (which == 0) sq[tok][d] = y; else if (which == 1) sk[tok][d] = y; else sv[tok][d] = y;
        }
        __syncthreads();
        for (int vi = wave; vi < 64; vi += 4) { const int tok = vi >> 1; LAS float* p = (vi & 1) ? sk[tok] : sq[tok];
            const float x0 = p[lane], x1 = p[lane + 64]; const float ss = wave_sum(x0 * x0 + x1 * x1);
            float sc = 1.0f / sqrtf(ss + EPSN); if (!(vi & 1)) sc *= 0.08838834764831845f;
            p[lane] = x0 * sc; p[lane + 64] = x1 * sc; }
        if (tid < 32) { const size_t row = (size_t)b * SEQ + t0 + tid; const float ga = SM[row * 32 + h], gb = SM[row * 32 + 8 + h];
            sbeta[tid] = sigm_(gb); sdec[tid] = __expf(-aexp * softplusf_(ga + dtb)); }
        __syncthreads();
        for (int tok = 0; tok < 32; ++tok) {
            const float decay = sdec[tok]; const LAS float* kk = sk[tok] + half * 64; const LAS float* qq = sq[tok] + half * 64;
            float p = 0.f;
#pragma unroll
            for (int i = 0; i < 64; ++i) p += S[i] * kk[i];
            redA[half][col] = p; __syncthreads();
            const float kv = (redA[0][col] + redA[1][col]) * decay;
            const float delta = sbeta[tok] * (sv[tok][col] - kv);
            float po = 0.f;
#pragma unroll
            for (int i = 0; i < 64; ++i) { S[i] = decay * S[i] + kk[i] * delta; po += S[i] * qq[i]; }
            redB[half][col] = po; __syncthreads();
            if (half == 0) so[tok][col] = redB[0][col] + redB[1][col];
        }
        __syncthreads();
        for (int tok = wave; tok < 32; tok += 4) { const size_t row = (size_t)b * SEQ + t0 + tok;
            const float o0 = so[tok][lane], o1 = so[tok][lane + 64]; const float ss = wave_sum(o0 * o0 + o1 * o1);
            const float rstd = 1.0f / sqrtf(ss * (1.f / 128.f) + EPSN);
            const float z0 = bf2f(Z[row * 1024 + h * 128 + lane]), z1 = bf2f(Z[row * 1024 + h * 128 + lane + 64]);
            OG[row * 1024 + h * 128 + lane] = (bf16)f2bf(o0 * rstd * gnorm_g[lane] * siluf_(z0));
            OG[row * 1024 + h * 128 + lane + 64] = (bf16)f2bf(o1 * rstd * gnorm_g[lane + 64] * siluf_(z1)); }
        __syncthreads();
    }
}

__device__ __forceinline__ unsigned f2ord(float f) { if (f == 0.f) f = 0.f; const unsigned u = __builtin_bit_cast(unsigned, f); return (u & 0x80000000u) ? ~u : (u | 0x80000000u); }

__device__ __forceinline__ void topk_naive_dev(int bx, int G, int hf, int tid, LAS unsigned char* lb, const bf16* IQ, const bf16* IK, const float* SM, unsigned short* TOPK) {
    LAS float* sq = (LAS float*)lb; LAS float* sw = sq + 512; LAS unsigned* skey = (LAS unsigned*)(sw + 8); LAS unsigned* hist = skey + SEQ; LAS unsigned* smisc = hist + 256; LAS unsigned* scnt = smisc + 4;
    for (int pair = bx; pair < MROWS / 2; pair += G) {
        const int row = pair * 2 + hf, b = row >> 13, t = row & (SEQ - 1);
        unsigned short* outp = TOPK + (size_t)row * 256;
        if (t < 256) { outp[tid] = tid <= t ? (unsigned short)tid : (unsigned short)0xFFFF; continue; }
        sq[tid] = bf2f(IQ[(size_t)row * 512 + tid]); sq[tid + 256] = bf2f(IQ[(size_t)row * 512 + tid + 256]);
        if (tid < 8) sw[tid] = SM[(size_t)row * 32 + 16 + tid] * (0.35355339059327373f * 0.125f);
        if (tid == 0) smisc[2] = 0u;
        __syncthreads();
        const int n = t + 1;
        for (int s = tid; s < n; s += 256) {
            const v4u* kp = (const v4u*)(IK + ((size_t)b * SEQ + s) * 64); float k[64];
#pragma unroll
            for (int i = 0; i < 8; ++i) { const v4u w = kp[i]; k[8 * i] = bflo(w.x); k[8 * i + 1] = bfhi(w.x); k[8 * i + 2] = bflo(w.y); k[8 * i + 3] = bfhi(w.y); k[8 * i + 4] = bflo(w.z); k[8 * i + 5] = bfhi(w.z); k[8 * i + 6] = bflo(w.w); k[8 * i + 7] = bfhi(w.w); }
            float sc = 0.f;
#pragma unroll 1
            for (int hh = 0; hh < 8; ++hh) { float d = 0.f;
#pragma unroll
                for (int i = 0; i < 64; ++i) d += sq[hh * 64 + i] * k[i];
                sc += sw[hh] * fmaxf(d, 0.f); }
            skey[s] = f2ord(sc);
        }
        __syncthreads();
        unsigned prefix = 0u, mask = 0u, need = 256u;
        for (int pass = 0; pass < 4; ++pass) { const int shift = 24 - 8 * pass;
            hist[tid] = 0u; __syncthreads();
            for (int s = tid; s < n; s += 256) { const unsigned k = skey[s]; if ((k & mask) == prefix) atomicAdd((unsigned*)&hist[(k >> shift) & 255u], 1u); }
            __syncthreads();
            if (tid == 0) { unsigned cum = 0u; int d = 255; for (; d > 0; --d) { const unsigned c = hist[d]; if (cum + c >= need) break; cum += c; } smisc[0] = (unsigned)d; smisc[1] = need - cum; }
            __syncthreads();
            prefix |= smisc[0] << shift; mask |= 0xFFu << shift; need = smisc[1];
            __syncthreads();
        }
        const int per = (n + 255) / 256; const int s0 = tid * per, s1 = min(n, s0 + per);
        unsigned ceq = 0u;
        for (int s = s0; s < s1; ++s) { const unsigned k = skey[s]; if (k > prefix) { const unsigned pos = atomicAdd((unsigned*)&smisc[2], 1u); outp[pos] = (unsigned short)s; } else if (k == prefix) ++ceq; }
        scnt[tid] = ceq; __syncthreads();
        if (tid == 0) { unsigned run = 0u; for (int i = 0; i < 256; ++i) { const unsigned c = scnt[i]; scnt[i] = run; run += c; } }
        __syncthreads();
        const unsigned ngt = smisc[2]; unsigned rk = scnt[tid];
        for (int s = s0; s < s1; ++s) { if (skey[s] == prefix) { if (rk < need) outp[ngt + rk] = (unsigned short)s; ++rk; } }
        __syncthreads();
    }
}

__device__ __forceinline__ void attn_simple_dev(int bx, int G, int hf, int tid, LAS unsigned char* lb, bf16* AQ, const bf16* AKV, const unsigned short* TOPK) {
    const int lane = tid & 63, wave = tid >> 6;
    typedef float row256[256];
    LAS float* sq = (LAS float*)lb; LAS row256* sp = (LAS row256*)(sq + 1024); LAS int* sidx = (LAS int*)(sp + 8); LAS float* sred = (LAS float*)(sidx + 256);
    for (int pair = bx; pair < MROWS / 2; pair += G) {
        const int row = pair * 2 + hf, b = row >> 13;
        { const v2u w = *(const v2u*)(AQ + (size_t)row * 1024 + tid * 4); sq[tid * 4] = bflo(w.x); sq[tid * 4 + 1] = bfhi(w.x); sq[tid * 4 + 2] = bflo(w.y); sq[tid * 4 + 3] = bfhi(w.y); }
        const int idx = TOPK[(size_t)row * 256 + tid]; const bool valid = idx != 0xFFFF; sidx[tid] = valid ? idx : -1;
        __syncthreads();
        float lg[8];
        if (valid) { const bf16* kr = AKV + ((size_t)b * SEQ + idx) * 512;
#pragma unroll
            for (int c = 0; c < 2; ++c) { float acc4[4] = {0.f, 0.f, 0.f, 0.f};
                for (int i = 0; i < 16; ++i) { const v4u w = *(const v4u*)(kr + c * 128 + i * 8); const float kf[8] = {bflo(w.x), bfhi(w.x), bflo(w.y), bfhi(w.y), bflo(w.z), bfhi(w.z), bflo(w.w), bfhi(w.w)};
#pragma unroll
                    for (int g = 0; g < 4; ++g) { const LAS float* q = sq + (c * 4 + g) * 128 + i * 8;
#pragma unroll
                        for (int j = 0; j < 8; ++j) acc4[g] += q[j] * kf[j]; } }
#pragma unroll
                for (int g = 0; g < 4; ++g) lg[c * 4 + g] = acc4[g] * 0.08838834764831845f; }
        } else {
#pragma unroll
            for (int hh = 0; hh < 8; ++hh) lg[hh] = -INFINITY;
        }
#pragma unroll
        for (int hh = 0; hh < 8; ++hh) { float m = lg[hh];
#pragma unroll
            for (int o = 1; o < 64; o <<= 1) m = fmaxf(m, __shfl_xor(m, o));
            if (lane == 0) sred[hh * 4 + wave] = m; }
        __syncthreads();
        float ex[8];
#pragma unroll
        for (int hh = 0; hh < 8; ++hh) { const float m = fmaxf(fmaxf(sred[hh * 4], sred[hh * 4 + 1]), fmaxf(sred[hh * 4 + 2], sred[hh * 4 + 3])); ex[hh] = valid ? __expf(lg[hh] - m) : 0.f; }
        __syncthreads();
#pragma unroll
        for (int hh = 0; hh < 8; ++hh) { const float s = wave_sum(ex[hh]); if (lane == 0) sred[hh * 4 + wave] = s; }
        __syncthreads();
#pragma unroll
        for (int hh = 0; hh < 8; ++hh) { const float s = (sred[hh * 4] + sred[hh * 4 + 1]) + (sred[hh * 4 + 2] + sred[hh * 4 + 3]); sp[hh][tid] = ex[hh] / s; }
        __syncthreads();
        const int hh = tid >> 5, d0 = (tid & 31) * 4, c = hh >> 2; float o4[4] = {0.f, 0.f, 0.f, 0.f};
        for (int nn = 0; nn < 256; ++nn) { const int id = sidx[nn]; if (id < 0) continue; const float p = sp[hh][nn];
            const v2u w = *(const v2u*)(AKV + ((size_t)b * SEQ + id) * 512 + 256 + c * 128 + d0);
            o4[0] += p * bflo(w.x); o4[1] += p * bfhi(w.x); o4[2] += p * bflo(w.y); o4[3] += p * bfhi(w.y); }
        v2u o; o.x = pk2(o4[0], o4[1]); o.y = pk2(o4[2], o4[3]); *(v2u*)(AQ + (size_t)row * 1024 + tid * 4) = o;
        __syncthreads();
    }
}

typedef GAS unsigned gu32;
#define RLX_AGENT __ATOMIC_RELAXED, __HIP_MEMORY_SCOPE_AGENT
constexpr int CW_BAR = 4096;
constexpr int LDS_MISC_OFF = 163840 - 64;
#define XB_TMO      128
#define XB_XCNT(j)  (256  + 64 * (j))
#define XB_XSUB(j)  (1280 + 64 * (j))
#define XB_XGEN(j)  (2304 + 64 * (j))
#define XB_TOP      3328
#define XB_TOPGEN   3392
#define XCD_BAR_WORDS 3456
#define XB_SPIN_CAP (1u << 18)

__device__ __forceinline__ unsigned xb_ld(unsigned* p)              { return __hip_atomic_load(p, __ATOMIC_RELAXED, __HIP_MEMORY_SCOPE_AGENT); }
__device__ __forceinline__ unsigned xb_add(unsigned* p, unsigned v) { return __hip_atomic_fetch_add(p, v, __ATOMIC_RELAXED, __HIP_MEMORY_SCOPE_AGENT); }
__device__ __forceinline__ unsigned xb_xcc_id() { return (unsigned)__builtin_amdgcn_s_getreg((3 << 11) | 20) & 0xFu; }
#define XB_SPIN(cond, bar) do { unsigned _sp = 0; while (cond) { __builtin_amdgcn_s_sleep(1); \
    if ((++_sp & 255u) == 0u) { if (xb_ld(&(bar)[XB_TMO])) break; if (_sp > XB_SPIN_CAP) { atomicAdd(&(bar)[XB_TMO], 1u); break; } } } } while (0)

struct XcdBarrier {
    unsigned* bar; unsigned x;
    volatile LAS unsigned* st;
};

__device__ __forceinline__ XcdBarrier xcd_barrier_post(unsigned* bar, volatile LAS unsigned* st) {
    XcdBarrier b; b.bar = bar; b.x = xb_xcc_id(); b.st = st;
    if (threadIdx.x == 0) (void)xb_add(&bar[XB_XCNT(b.x)], 1u);
    return b;
}
__device__ __forceinline__ void xcd_barrier_complete(unsigned* bar, unsigned x, unsigned& nloc, unsigned& nx) {
    const unsigned G = gridDim.x * gridDim.y * gridDim.z;
    unsigned sum, cnt, mine, sp = 0u;
    for (;;) {
        sum = 0u; cnt = 0u; mine = 0u;
#pragma unroll
        for (unsigned j = 0; j < 16; ++j) { const unsigned c = xb_ld(&bar[XB_XCNT(j)]); sum += c; cnt += (c > 0u) ? 1u : 0u; mine = (j == x) ? c : mine; }
        if (sum == G) break;
        __builtin_amdgcn_s_sleep(1);
        if ((++sp & 255u) == 0u) { if (xb_ld(&bar[XB_TMO])) break; if (sp > XB_SPIN_CAP) { atomicAdd(&bar[XB_TMO], 1u); break; } }
    }
    nloc = mine > 0u ? mine : 1u; nx = cnt > 0u ? cnt : 1u;
}

__device__ __forceinline__ void xcd_barrier(const XcdBarrier& b) {
    asm volatile("s_waitcnt vmcnt(0)" ::: "memory");
    __syncthreads();
    if (threadIdx.x == 0) {
        unsigned* bar = b.bar;
        __builtin_amdgcn_s_waitcnt(0);
        unsigned nloc = b.st[0], nx = b.st[1];
        if (nloc == 0u) { xcd_barrier_complete(bar, b.x, nloc, nx); b.st[0] = nloc; b.st[1] = nx; }
        const unsigned old = xb_add(&bar[XB_XSUB(b.x)], 1u);
        const unsigned gen = old / nloc;
        if (old + 1u == (gen + 1u) * nloc) {
            __builtin_amdgcn_fence(__ATOMIC_RELEASE, "agent");
            asm volatile("s_waitcnt vmcnt(0)" ::: "memory");
            const unsigned og = xb_add(&bar[XB_TOP], 1u);
            const unsigned tg = og / nx;
            if (og + 1u == (tg + 1u) * nx) xb_add(&bar[XB_TOPGEN], 1u);
            else XB_SPIN(xb_ld(&bar[XB_TOPGEN]) == tg, bar);
            __builtin_amdgcn_fence(__ATOMIC_ACQUIRE, "agent");
            xb_add(&bar[XB_XGEN(b.x)], 1u);
            asm volatile("s_waitcnt vmcnt(0)" ::: "memory");
        } else {
            XB_SPIN(xb_ld(&bar[XB_XGEN(b.x)]) == gen, bar);
            __builtin_amdgcn_fence(__ATOMIC_ACQUIRE, "agent");
            asm volatile("s_waitcnt vmcnt(0)" ::: "memory");
        }
    }
    __syncthreads();
}

namespace cg = cooperative_groups;
constexpr int NPHASE = 11;
__global__ void __launch_bounds__(NWAVES * 64, 2) fwd(Args a) {
    extern __shared__ __attribute__((aligned(16))) unsigned char lds_raw[];
    LAS unsigned char* lds = (LAS unsigned char*)lds_raw;
    const int wave = __builtin_amdgcn_readfirstlane((int)threadIdx.x >> 6);
    const int G = gridDim.x, bx = blockIdx.x; const int vcu = (G % 8 == 0) ? (bx % 8) * (G / 8) + bx / 8 : bx;
    const int gw = vcu * NWAVES + wave, NGW = G * NWAVES;
    unsigned char* ws = a.ws;
    bf16* H = (bf16*)a.out; bf16* OG = (bf16*)a.out + (size_t)MROWS * DM;
    bf16* WinT = (bf16*)(ws + WS_WINT);
    const int lo = a.ph_lo, hi = a.ph_hi;
    if (threadIdx.x < 16) ((LAS unsigned*)(lds + LDS_MISC_OFF))[threadIdx.x] = 0u;
    __syncthreads();
    XcdBarrier bar = xcd_barrier_post((unsigned*)(ws + WS_CTL) + CW_BAR, (volatile LAS unsigned*)(lds + LDS_MISC_OFF));
#define IN(k) (lo <= (k) && (k) < hi)
#define SEAM(k) do { if (IN(k) && IN((k) + 1)) { if ((k) == 0) cg::this_grid().sync(); else xcd_barrier(bar); } } while (0)
    if (IN(0)) phase_p0(a, lds, gw, NGW, wave, (int)(threadIdx.x & 63));
    SEAM(0);
    if (IN(1)) {
        pg8::Gemm g{H, WinT, MROWS, N_IN1, DM}; pg8::StaticOrder S; S.init(MROWS, N_IN1, G, bx);
        pg8::EpiInProj E{(bf16*)(ws + WS_QKV), (bf16*)(ws + WS_Z), (bf16*)(ws + WS_AQ), (bf16*)(ws + WS_AKV), (bf16*)(ws + WS_IQ), (bf16*)(ws + WS_IK), (bf16*)(ws + WS_HALO), (float*)(ws + WS_SM)};
        pg8::gemm_phase<pg8::EpiInProj, pg8::StaticOrder, PG8_ALIGN, PG8_SP2>(lds, g, S, E);
    }
    SEAM(1);
    if (IN(2)) phase_p1b(a, gw, NGW, (int)(threadIdx.x & 63));
    SEAM(2);
    if (IN(3)) { phase_gdn_prep(a, lds, bx, G, (int)threadIdx.x, wave, (int)(threadIdx.x & 63)); phase_topk(a, lds, bx, G, (int)threadIdx.x, wave, (int)(threadIdx.x & 63)); }
    SEAM(3);
    if (IN(4)) { if (bx < 32) { phase_scan(a, lds, bx, (int)threadIdx.x, wave, (int)(threadIdx.x & 63)); __syncthreads(); } phase_attn(a, lds, wave, (int)(threadIdx.x & 63)); }
    if (IN(4) && IN(6)) xcd_barrier(bar);
    if (IN(6)) {
        pg8::Gemm g{H, WinT + (size_t)N_IN1 * DM, MROWS, 2048, DM}; pg8::StaticOrder S; S.init(MROWS, 2048, G, bx);
        pg8::EpiGate E{(const bf16*)(ws + WS_QKV), 3072, (const bf16*)(ws + WS_AQ), 1024, (bf16*)(ws + WS_Z)};
        pg8::gemm_phase<pg8::EpiGate, pg8::StaticOrder, PG8_ALIGN, PG8_SP2>(lds, g, S, E);
    }
    SEAM(6);
    if (IN(7)) {
        pg8::Gemm g{(const bf16*)(ws + WS_Z), (const bf16*)(ws + WS_WOT), MROWS, DM, DM}; pg8::StaticOrder S; S.init(MROWS, DM, G, bx);
        pg8::EpiResF32 E{a.x, a.out};
        pg8::gemm_phase<pg8::EpiResF32, pg8::StaticOrder, PG8_ALIGN, PG8_SP2>(lds, g, S, E);
    }
    SEAM(7);
    if (IN(8)) phase_p4b(a, gw, NGW, (int)(threadIdx.x & 63));
    SEAM(8);
    if (IN(9)) {
        pg8::Gemm g{(const bf16*)(ws + WS_AQ), (const bf16*)(ws + WS_WUT), MROWS, DFF, DM}; pg8::StaticOrder S; S.init(MROWS, DFF, G, bx);
        pg8::EpiRelu2 E{(bf16*)(ws + WS_HID), DFF};
        pg8::gemm_phase<pg8::EpiRelu2, pg8::StaticOrder, PG8_ALIGN, PG8_SP2>(lds, g, S, E);
    }
    SEAM(9);
    if (IN(10)) {
        pg8::Gemm g{(const bf16*)(ws + WS_HID), (const bf16*)(ws + WS_WDT), MROWS, DM, DFF}; pg8::StaticOrder S; S.init(MROWS, DM, G, bx);
        pg8::EpiResF32 E{a.out, a.out};
        pg8::gemm_phase<pg8::EpiResF32, pg8::StaticOrder, PG8_ALIGN, PG8_SP2>(lds, g, S, E);
    }
}

#ifndef MK_ONE_LAUNCH
#define MK_ONE_LAUNCH 1
#endif
extern "C" void kernel_launch(void* const* d_in, const int* in_sizes, int n_in, void* d_out, int out_size, void* d_ws, size_t ws_size, hipStream_t stream) {
    static int grid = 0;
    if (grid == 0) {
        if (n_in != 13 || in_sizes[0] != MROWS * DM || out_size != MROWS * DM || ws_size < WS_NEED) { fprintf(stderr, "kernel_launch: unexpected shapes/workspace (%d inputs, ws %zu)\n", n_in, ws_size); grid = -1; return; }
        if (hipFuncSetAttribute((const void*)fwd, hipFuncAttributeMaxDynamicSharedMemorySize, LDS_BYTES) != hipSuccess) { fprintf(stderr, "kernel_launch: hipFuncSetAttribute failed\n"); grid = -1; return; }
        int dev = 0, cus = 0, per_cu = 0;
        hipGetDevice(&dev); hipDeviceGetAttribute(&cus, hipDeviceAttributeMultiprocessorCount, dev);
        hipOccupancyMaxActiveBlocksPerMultiprocessor(&per_cu, (const void*)fwd, NWAVES * 64, LDS_BYTES);
        if (per_cu < 1 || cus < 1) { fprintf(stderr, "kernel_launch: occupancy query says %d blocks/CU on %d CUs\n", per_cu, cus); grid = -1; return; }
        grid = cus;
    }
    if (grid < 0) return;
    if (hipMemsetAsync((char*)d_ws + WS_CTL, 0, CTL_ZERO_BYTES, stream) != hipSuccess) { fprintf(stderr, "kernel_launch: memset failed\n"); return; }
    Args a{};
    a.x = (const float*)d_in[0]; a.norm_mix_g = (const float*)d_in[1]; a.w_in = (const float*)d_in[2]; a.conv_w = (const float*)d_in[3]; a.a_log = (const float*)d_in[4];
    a.dt_bias = (const float*)d_in[5]; a.gdn_norm_g = (const float*)d_in[6]; a.q_norm_g = (const float*)d_in[7]; a.k_norm_g = (const float*)d_in[8]; a.w_out = (const float*)d_in[9];
    a.norm_mlp_g = (const float*)d_in[10]; a.w_up = (const float*)d_in[11]; a.w_down = (const float*)d_in[12];
    a.out = (float*)d_out; a.ws = (unsigned char*)d_ws;
#if MK_ONE_LAUNCH
    a.ph_lo = 0; a.ph_hi = NPHASE;
    void* args[] = {&a};
    hipError_t e = hipLaunchCooperativeKernel((const void*)fwd, dim3(grid), dim3(NWAVES * 64), args, LDS_BYTES, stream);
    if (e != hipSuccess) fprintf(stderr, "cooperative launch failed: %s (grid %d)\n", hipGetErrorString(e), grid);
#else
    for (int p = 0; p < NPHASE; ++p) { a.ph_lo = p; a.ph_hi = p + 1; hipLaunchKernelGGL(fwd, dim3(grid), dim3(NWAVES * 64), LDS_BYTES, stream, a); }
#endif
}
```

```cpp
#include <hip/hip_runtime.h>
#include <hip/hip_cooperative_groups.h>
#include <cstdio>
#include <cstdint>
#ifndef PROBE_TSA
#define PROBE_TSA -1
#endif
#ifndef PROBE_TSB
#define PROBE_TSB -1
#endif
#ifndef PROBE_DUP
#define PROBE_DUP 0
#endif
#ifndef PROBE_ATT
#define PROBE_ATT 0
#endif
namespace pg8 {
#define PG8_LAS __attribute__((address_space(3)))
typedef unsigned short bf16_t;
typedef short bf16x8 __attribute__((ext_vector_type(8)));
typedef float f32x4 __attribute__((ext_vector_type(4)));
typedef unsigned u32x4 __attribute__((ext_vector_type(4)));
constexpr int BM = 256, BK = 64, HALF = 128, HTB = HALF * BK * 2  , STAGE_BYTES = 8 * HTB, NXCD = 8, WGM = 8;

__host__ __device__ __forceinline__ int lds_byte(int r, int c) { const int st = (r >> 4) * 2 + (c >> 5), rr = r & 15, cc = c & 31, ob = rr * 64 + cc * 2; return st * 1024 + (ob ^ (((ob >> 9) & 1) << 5)); }
__host__ __device__ __forceinline__ void stage_rc(int b, int& R, int& C) { const int st = b / 1024, sb = b % 1024, swz = sb ^ (((sb >> 9) & 1) << 5); R = (st >> 1) * 16 + swz / 64; C = (st & 1) * 32 + (swz % 64) / 2; }
__host__ __device__ __forceinline__ int perm32(int rho) { const int n = rho >> 4, i = rho & 15; return 8 * (i >> 2) + 4 * n + (i & 3); }

struct Unit { int pm, pn; };
struct Gemm { const bf16_t* A; const bf16_t* Bt; int M, N, K; };

struct StaticOrder {
    int nM, nN, nwg, G, c;
    __host__ __device__ void init(int M, int N, int G_, int c_) { nM = M / BM; nN = N / BM; nwg = nM * nN; G = G_; c = c_; }
    __host__ __device__ bool next(int i, Unit& u) const {
        const long L = (long)i * G + c; if (L >= nwg) return false;
        int wgid = (int)L; { const int q = nwg / NXCD, r = nwg % NXCD, xcd = wgid % NXCD, off = wgid / NXCD; wgid = (xcd < r ? xcd * (q + 1) : r * (q + 1) + (xcd - r) * q) + off; }
        const int nig = WGM * nN, gid = wgid / nig, fm = gid * WGM, gsz = (nM - fm) < WGM ? (nM - fm) : WGM;
        u.pm = fm + ((wgid % nig) % gsz); u.pn = (wgid % nig) / gsz; return true;
    }
    __device__ __forceinline__ void a_ready(const Unit&) const {}
    __device__ __forceinline__ void done(const Unit&) const {}
};

__device__ __forceinline__ unsigned cvt_pk_bf16(float lo, float hi) { unsigned r; asm volatile("v_cvt_pk_bf16_f32 %0, %1, %2" : "=v"(r) : "v"(lo), "v"(hi)); return r; }
typedef unsigned u32x2 __attribute__((ext_vector_type(2)));
__device__ __forceinline__ float bf_lo(unsigned w) { return __builtin_bit_cast(float, w << 16); }
__device__ __forceinline__ float bf_hi(unsigned w) { return __builtin_bit_cast(float, w & 0xffff0000u); }
__device__ __forceinline__ float sigmoidf_(float x) { return __builtin_amdgcn_rcpf(1.0f + __expf(-x)); }

struct EpiInProj {
    static constexpr bool PERM = true, AFTER_DRAIN = false;
    bf16_t *QKV, *Z, *AQ, *AKV, *IQ, *IK, *HALO; float* SM;
    __device__ __forceinline__ void operator()(const f32x4 (&acc)[2][2][4][2], const Unit& u, int wr, int wc, int fr, int fq) const {
        const int pn = u.pn; const int row0 = u.pm * BM + wr * 64 + fr;
        if (pn < 24) {
            bf16_t* base; int ldc, colt;
            if (pn < 12) { base = QKV; ldc = 3072; colt = pn * 256; }
            else if (pn < 16) { base = Z; ldc = 1024; colt = (pn - 12) * 256; }
            else if (pn < 20) { base = AQ; ldc = 1024; colt = (pn - 16) * 256; }
            else if (pn < 22) { base = AKV; ldc = 512; colt = (pn - 20) * 256; }
            else { base = IQ; ldc = 512; colt = (pn - 22) * 256; }
            const int col0 = colt + wc * 32 + 8 * fq;
#pragma unroll
            for (int ai = 0; ai < 2; ++ai)
#pragma unroll
                for (int m = 0; m < 4; ++m) { const int row = row0 + ai * HALF + m * 16; bf16_t* rowp = base + (size_t)row * ldc + col0;
#pragma unroll
                    for (int bj = 0; bj < 2; ++bj) { const f32x4 v0 = acc[ai][bj][m][0], v1 = acc[ai][bj][m][1];
                        u32x4 w; w.x = cvt_pk_bf16(v0[0], v0[1]); w.y = cvt_pk_bf16(v0[2], v0[3]); w.z = cvt_pk_bf16(v1[0], v1[1]); w.w = cvt_pk_bf16(v1[2], v1[3]);
                        *(u32x4*)(rowp + bj * HALF) = w;
                        if (pn < 12 && m == 3 && fr >= 13) *(u32x4*)(HALO + ((size_t)(row >> 6) * 3 + (fr - 13)) * 3072 + col0 + bj * HALF) = w; } }
        } else {
#pragma unroll
            for (int ai = 0; ai < 2; ++ai)
#pragma unroll
                for (int m = 0; m < 4; ++m) { const int row = row0 + ai * HALF + m * 16; const f32x4 v0 = acc[ai][0][m][0], v1 = acc[ai][0][m][1];
                    if (wc < 2) { u32x4 w; w.x = cvt_pk_bf16(v0[0], v0[1]); w.y = cvt_pk_bf16(v0[2], v0[3]); w.z = cvt_pk_bf16(v1[0], v1[1]); w.w = cvt_pk_bf16(v1[2], v1[3]);
                        *(u32x4*)(IK + (size_t)row * 64 + wc * 32 + 8 * fq) = w; }
                    else if (wc == 2 && fq < 3) { float* p = SM + (size_t)row * 32 + 8 * fq; *(f32x4*)p = v0; *(f32x4*)(p + 4) = v1; } }
        }
    }
};
struct EpiGate {
    static constexpr bool PERM = true, AFTER_DRAIN = false;
    const bf16_t* OG; int ldog; const bf16_t* OA; int ldoa; bf16_t* ZM; const float* RSTD; const float* GN;
    __device__ __forceinline__ void operator()(const f32x4 (&acc)[2][2][4][2], const Unit& u, int wr, int wc, int fr, int fq) const {
        const int row0 = u.pm * BM + wr * 64 + fr; const int d0 = wc * 32 + 8 * fq; const int ch0 = u.pn * 128 + d0;
        const f32x4 g0 = *(const f32x4*)(GN + d0), g1 = *(const f32x4*)(GN + d0 + 4);
#pragma unroll
        for (int ai = 0; ai < 2; ++ai) {
            u32x4 ogv[4], oav[4], zzv[4]; float rsv[4];
#pragma unroll
            for (int m = 0; m < 4; ++m) { const int row = row0 + ai * HALF + m * 16;
                ogv[m] = *(const u32x4*)(OG + (size_t)row * ldog + ch0); oav[m] = *(const u32x4*)(OA + (size_t)row * ldoa + ch0); zzv[m] = *(const u32x4*)(ZM + (size_t)row * 1024 + ch0); rsv[m] = RSTD[(size_t)row * 8 + u.pn]; }
#pragma unroll
            for (int m = 0; m < 4; ++m) { const int row = row0 + ai * HALF + m * 16;
                const u32x4 og = ogv[m], oa = oav[m], zz = zzv[m]; const float rs = rsv[m];
                const f32x4 a0 = acc[ai][0][m][0], a1 = acc[ai][0][m][1], b0 = acc[ai][1][m][0], b1 = acc[ai][1][m][1];
                float r[8];
#define GATE1(i_, av_, bv_, ogv_, oav_, zv_, gv_) { const float z_ = (zv_); const float sz_ = z_ * __builtin_amdgcn_rcpf(1.0f + __expf(-z_)); r[i_] = sigmoidf_(av_) * ((ogv_) * rs * (gv_) * sz_) + sigmoidf_(bv_) * (oav_); }
                GATE1(0, a0[0], b0[0], bf_lo(og.x), bf_lo(oa.x), bf_lo(zz.x), g0.x) GATE1(1, a0[1], b0[1], bf_hi(og.x), bf_hi(oa.x), bf_hi(zz.x), g0.y)
                GATE1(2, a0[2], b0[2], bf_lo(og.y), bf_lo(oa.y), bf_lo(zz.y), g0.z) GATE1(3, a0[3], b0[3], bf_hi(og.y), bf_hi(oa.y), bf_hi(zz.y), g0.w)
                GATE1(4, a1[0], b1[0], bf_lo(og.z), bf_lo(oa.z), bf_lo(zz.z), g1.x) GATE1(5, a1[1], b1[1], bf_hi(og.z), bf_hi(oa.z), bf_hi(zz.z), g1.y)
                GATE1(6, a1[2], b1[2], bf_lo(og.w), bf_lo(oa.w), bf_lo(zz.w), g1.z) GATE1(7, a1[3], b1[3], bf_hi(og.w), bf_hi(oa.w), bf_hi(zz.w), g1.w)
#undef GATE1
                u32x4 w; w.x = cvt_pk_bf16(r[0], r[1]); w.y = cvt_pk_bf16(r[2], r[3]); w.z = cvt_pk_bf16(r[4], r[5]); w.w = cvt_pk_bf16(r[6], r[7]);
                *(u32x4*)(ZM + (size_t)row * 1024 + ch0) = w; }
            asm volatile("" ::: "memory");
        }
    }
};
struct EpiResF32 {
    static constexpr bool PERM = false, AFTER_DRAIN = false;
    const float* base; float* out;
    __device__ __forceinline__ void operator()(const f32x4 (&acc)[2][2][4][2], const Unit& u, int wr, int wc, int fr, int fq) const {
        const int col0 = u.pn * BM + wc * 32 + 4 * fq;
#pragma unroll
        for (int ai = 0; ai < 2; ++ai)
#pragma unroll
            for (int m = 0; m < 4; ++m) { const size_t off = (size_t)(u.pm * BM + ai * HALF + wr * 64 + m * 16 + fr) * 1024 + col0;
#pragma unroll
                for (int bj = 0; bj < 2; ++bj)
#pragma unroll
                    for (int n = 0; n < 2; ++n) { const f32x4 bs = *(const f32x4*)(base + off + bj * HALF + n * 16); *(f32x4*)(out + off + bj * HALF + n * 16) = bs + acc[ai][bj][m][n]; } }
    }
};
struct EpiResNorm {
    static constexpr bool PERM = false, AFTER_DRAIN = false;
    const float* base; float* out; bf16_t* XB; float* PS;
    __device__ __forceinline__ void operator()(const f32x4 (&acc)[2][2][4][2], const Unit& u, int wr, int wc, int fr, int fq) const {
        const int col0 = u.pn * BM + wc * 32 + 4 * fq;
#pragma unroll
        for (int ai = 0; ai < 2; ++ai)
#pragma unroll
            for (int m = 0; m < 4; ++m) { const int row = u.pm * BM + ai * HALF + wr * 64 + m * 16 + fr; const size_t off = (size_t)row * 1024 + col0; float ss = 0.f;
#pragma unroll
                for (int bj = 0; bj < 2; ++bj)
#pragma unroll
                    for (int n = 0; n < 2; ++n) { const f32x4 bs = *(const f32x4*)(base + off + bj * HALF + n * 16); const f32x4 v = bs + acc[ai][bj][m][n]; *(f32x4*)(out + off + bj * HALF + n * 16) = v;
                        ss += v[0] * v[0] + v[1] * v[1] + v[2] * v[2] + v[3] * v[3];
                        u32x2 w; w.x = cvt_pk_bf16(v[0], v[1]); w.y = cvt_pk_bf16(v[2], v[3]); *(u32x2*)(XB + off + bj * HALF + n * 16) = w; }
                ss += __shfl_xor(ss, 16); ss += __shfl_xor(ss, 32);
                if (fq == 0) PS[(size_t)row * 16 + u.pn * 4 + wc] = ss; }
    }
};
struct EpiRelu2N {
    static constexpr bool PERM = true, AFTER_DRAIN = false;
    bf16_t* O; int ldc; const float* PS;
    __device__ __forceinline__ void operator()(const f32x4 (&acc)[2][2][4][2], const Unit& u, int wr, int wc, int fr, int fq) const {
        const int row0 = u.pm * BM + wr * 64 + fr; const int col0 = u.pn * BM + wc * 32 + 8 * fq;
#pragma unroll
        for (int ai = 0; ai < 2; ++ai)
#pragma unroll
            for (int m = 0; m < 4; ++m) { const int row = row0 + ai * HALF + m * 16; bf16_t* rowp = O + (size_t)row * ldc + col0;
                const f32x4* pp = (const f32x4*)(PS + (size_t)row * 16); const f32x4 s4 = (pp[0] + pp[1]) + (pp[2] + pp[3]);
                const float rstd = __builtin_amdgcn_rsqf(((s4[0] + s4[1]) + (s4[2] + s4[3])) * (1.f / 1024.f) + 1e-6f);
#pragma unroll
                for (int bj = 0; bj < 2; ++bj) { f32x4 v0 = acc[ai][bj][m][0], v1 = acc[ai][bj][m][1];
#pragma unroll
                    for (int i = 0; i < 4; ++i) { const float a = fmaxf(v0[i] * rstd, 0.f), b = fmaxf(v1[i] * rstd, 0.f); v0[i] = a * a; v1[i] = b * b; }
                    u32x4 w; w.x = cvt_pk_bf16(v0[0], v0[1]); w.y = cvt_pk_bf16(v0[2], v0[3]); w.z = cvt_pk_bf16(v1[0], v1[1]); w.w = cvt_pk_bf16(v1[2], v1[3]);
                    *(u32x4*)(rowp + bj * HALF) = w; } }
    }
};
struct EpiRelu2 {
    static constexpr bool PERM = true, AFTER_DRAIN = false;
    bf16_t* O; int ldc;
    __device__ __forceinline__ void operator()(const f32x4 (&acc)[2][2][4][2], const Unit& u, int wr, int wc, int fr, int fq) const {
        const int row0 = u.pm * BM + wr * 64 + fr; const int col0 = u.pn * BM + wc * 32 + 8 * fq;
#pragma unroll
        for (int ai = 0; ai < 2; ++ai)
#pragma unroll
            for (int m = 0; m < 4; ++m) { bf16_t* rowp = O + (size_t)(row0 + ai * HALF + m * 16) * ldc + col0;
#pragma unroll
                for (int bj = 0; bj < 2; ++bj) { f32x4 v0 = acc[ai][bj][m][0], v1 = acc[ai][bj][m][1];
#pragma unroll
                    for (int i = 0; i < 4; ++i) { const float a = fmaxf(v0[i], 0.f), b = fmaxf(v1[i], 0.f); v0[i] = a * a; v1[i] = b * b; }
                    u32x4 w; w.x = cvt_pk_bf16(v0[0], v0[1]); w.y = cvt_pk_bf16(v0[2], v0[3]); w.z = cvt_pk_bf16(v1[0], v1[1]); w.w = cvt_pk_bf16(v1[2], v1[3]);
                    *(u32x4*)(rowp + bj * HALF) = w; } }
    }
};
template <class Epi, class Sched, bool ALIGN_EPI = false, bool SP2 = false>
__device__ __forceinline__ void gemm_phase(PG8_LAS unsigned char* lds, const Gemm g, const Sched& S, const Epi& E, const int wid) {
    const int lane = (int)__builtin_amdgcn_mbcnt_hi(~0u, __builtin_amdgcn_mbcnt_lo(~0u, 0u)), tid = wid * 64 + lane, wr = wid >> 2, wc = wid & 3, fr = lane & 15, fq = lane >> 4;
    const int K = g.K, nt = K / BK;
    unsigned voffA[2], voffB[2];
#pragma unroll
    for (int i = 0; i < 2; ++i) { int R, C; stage_rc(tid * 16 + i * 8192, R, C); const int Rb = Epi::PERM ? ((R & ~31) + perm32(R & 31)) : R;
        voffA[i] = (unsigned)(R * K + C) * 2u; voffB[i] = (unsigned)(Rb * K + C) * 2u; }
    const size_t kstep = (size_t)(BK * 2);
    const size_t hstep = (size_t)HALF * K * 2;
    const size_t tstep = 2 * hstep;
    const unsigned ldsw = (unsigned)wid * 1024u;
    const int aoff = lds_byte(wr * 64 + fr, fq * 8), boff = lds_byte(wc * 32 + fr, fq * 8);
#define PG8_SA(b, h) (((b) * 2 + (h)) * HTB)
#define PG8_SB(b, h) ((4 + (b) * 2 + (h)) * HTB)
#define PG8_STAGE(bufoff, gbase, voff) do { _Pragma("unroll") for (int _i = 0; _i < 2; ++_i) \
        __builtin_amdgcn_global_load_lds((const unsigned*)((const char*)(gbase) + (voff)[_i]), (PG8_LAS unsigned*)(lds + (bufoff) + ldsw + _i * 8192), 16, 0, 0); } while (0)
#define PG8_LDA(dst, b, h) do { _Pragma("unroll") for (int m = 0; m < 4; ++m) _Pragma("unroll") for (int k = 0; k < 2; ++k) dst[m][k] = *(const PG8_LAS bf16x8*)(lds + PG8_SA(b, h) + aoff + m * 2048 + k * 1024); } while (0)
#define PG8_LDB(dst, b, h) do { _Pragma("unroll") for (int n = 0; n < 2; ++n) _Pragma("unroll") for (int k = 0; k < 2; ++k) dst[n][k] = *(const PG8_LAS bf16x8*)(lds + PG8_SB(b, h) + boff + n * 2048 + k * 1024); } while (0)
#define PG8_MMA(ai, bj, At, Bt) do { __builtin_amdgcn_s_setprio(1); _Pragma("unroll") for (int m = 0; m < 4; ++m) _Pragma("unroll") for (int n = 0; n < 2; ++n) _Pragma("unroll") for (int k = 0; k < 2; ++k) \
        acc[ai][bj][m][n] = __builtin_amdgcn_mfma_f32_16x16x32_bf16(Bt[n][k], At[m][k], acc[ai][bj][m][n], 0, 0, 0); __builtin_amdgcn_s_setprio(0); } while (0)
#define PG8_WAIT_V(n) asm volatile("s_waitcnt vmcnt(" #n ")" ::: "memory")
#define PG8_WAIT_L(n) asm volatile("s_waitcnt lgkmcnt(" #n ")" ::: "memory")
#define PG8_BAR __builtin_amdgcn_s_barrier()
#define PG8_SCHED __builtin_amdgcn_sched_barrier(0)
    Unit cur, nxt; int ui = 0;
    if (!S.next(0, cur)) return;
    f32x4 acc[2][2][4][2];
#pragma unroll
    for (int a = 0; a < 2; ++a)
#pragma unroll
        for (int b = 0; b < 2; ++b)
#pragma unroll
            for (int m = 0; m < 4; ++m)
#pragma unroll
                for (int n = 0; n < 2; ++n) acc[a][b][m][n] = (f32x4){0.f, 0.f, 0.f, 0.f};
    bf16x8 At[4][2], B0[2][2], B1[2][2];
    const char* cA = (const char*)g.A + (size_t)cur.pm * tstep; const char* cB = (const char*)g.Bt + (size_t)cur.pn * tstep;
    S.a_ready(cur);
    if constexpr (SP2) {
        PG8_STAGE(PG8_SB(0, 0), cB, voffB); PG8_STAGE(PG8_SB(0, 1), cB + hstep, voffB); PG8_STAGE(PG8_SA(0, 0), cA, voffA); PG8_STAGE(PG8_SA(0, 1), cA + hstep, voffA);
        if (wr == 1) PG8_BAR;
        PG8_WAIT_V(2); PG8_BAR;
        PG8_STAGE(PG8_SB(1, 0), cB + kstep, voffB); PG8_STAGE(PG8_SA(1, 0), cA + kstep, voffA); PG8_STAGE(PG8_SB(1, 1), cB + hstep + kstep, voffB);
        PG8_WAIT_V(6); PG8_BAR;
    } else {
        PG8_STAGE(PG8_SB(0, 0), cB, voffB); PG8_STAGE(PG8_SA(0, 0), cA, voffA); PG8_STAGE(PG8_SB(0, 1), cB + hstep, voffB); PG8_STAGE(PG8_SA(0, 1), cA + hstep, voffA);
        if (wr == 1) PG8_BAR;
        PG8_WAIT_V(4); PG8_BAR;
        PG8_STAGE(PG8_SB(1, 0), cB + kstep, voffB); PG8_STAGE(PG8_SA(1, 0), cA + kstep, voffA); PG8_STAGE(PG8_SB(1, 1), cB + hstep + kstep, voffB);
        PG8_WAIT_V(6); PG8_BAR;
    }
    for (;;) {
        const bool has_next = S.next(ui + 1, nxt);
        const char* nA = has_next ? (const char*)g.A + (size_t)nxt.pm * tstep : cA; const char* nB = has_next ? (const char*)g.Bt + (size_t)nxt.pn * tstep : cB;
        for (int t = 0; t < nt; t += 2) {
            const bool last = (t == nt - 2);
            const char* a1 = cA + (size_t)(t + 1) * kstep;
            const char* a2 = last ? nA : cA + (size_t)(t + 2) * kstep; const char* b2 = last ? nB : cB + (size_t)(t + 2) * kstep;
            const char* a3 = a2 + kstep; const char* b3 = b2 + kstep;
            if (last && has_next) S.a_ready(nxt);
            if constexpr (SP2) {
            PG8_LDB(B0, 0, 0); PG8_LDB(B1, 0, 1); PG8_SCHED; PG8_LDA(At, 0, 0); PG8_STAGE(PG8_SA(1, 1), a1 + hstep, voffA);
            PG8_WAIT_V(8); PG8_WAIT_L(0); PG8_BAR; PG8_MMA(0, 0, At, B0); PG8_MMA(0, 1, At, B1); PG8_BAR; PG8_SCHED;
            PG8_LDA(At, 0, 1); PG8_STAGE(PG8_SB(0, 0), b2, voffB); PG8_STAGE(PG8_SB(0, 1), b2 + hstep, voffB); PG8_STAGE(PG8_SA(0, 0), a2, voffA);
            PG8_WAIT_V(8); PG8_WAIT_L(0); PG8_BAR; PG8_MMA(1, 0, At, B0); PG8_MMA(1, 1, At, B1); PG8_BAR; PG8_SCHED;
            PG8_LDB(B0, 1, 0); PG8_LDB(B1, 1, 1); PG8_SCHED; PG8_LDA(At, 1, 0); PG8_STAGE(PG8_SA(0, 1), a2 + hstep, voffA);
            PG8_WAIT_V(8); PG8_WAIT_L(0); PG8_BAR; PG8_MMA(0, 0, At, B0); PG8_MMA(0, 1, At, B1); PG8_BAR; PG8_SCHED;
            PG8_LDA(At, 1, 1); PG8_STAGE(PG8_SB(1, 0), b3, voffB); PG8_STAGE(PG8_SB(1, 1), b3 + hstep, voffB); PG8_STAGE(PG8_SA(1, 0), a3, voffA);
            PG8_WAIT_V(8); PG8_WAIT_L(0); PG8_BAR; PG8_MMA(1, 0, At, B0); PG8_MMA(1, 1, At, B1); PG8_BAR; PG8_SCHED;
            } else {
            PG8_LDB(B0, 0, 0); PG8_SCHED; PG8_LDA(At, 0, 0); PG8_STAGE(PG8_SA(1, 1), a1 + hstep, voffA);
            PG8_WAIT_L(8); PG8_BAR; PG8_WAIT_L(0); PG8_MMA(0, 0, At, B0); PG8_BAR; PG8_SCHED;
            PG8_LDB(B1, 0, 1); PG8_STAGE(PG8_SB(0, 0), b2, voffB);
            PG8_BAR; PG8_WAIT_L(0); PG8_MMA(0, 1, At, B1); PG8_BAR;
            PG8_LDA(At, 0, 1); PG8_STAGE(PG8_SA(0, 0), a2, voffA);
            PG8_BAR; PG8_WAIT_L(0); PG8_MMA(1, 0, At, B0); PG8_BAR; PG8_SCHED;
            PG8_STAGE(PG8_SB(0, 1), b2 + hstep, voffB);
            PG8_WAIT_V(6); PG8_BAR; PG8_MMA(1, 1, At, B1); PG8_BAR;
            PG8_LDB(B0, 1, 0); PG8_SCHED; PG8_LDA(At, 1, 0); PG8_STAGE(PG8_SA(0, 1), a2 + hstep, voffA);
            PG8_WAIT_L(8); PG8_BAR; PG8_WAIT_L(0); PG8_MMA(0, 0, At, B0); PG8_BAR; PG8_SCHED;
            PG8_LDB(B1, 1, 1); PG8_STAGE(PG8_SB(1, 0), b3, voffB);
            PG8_BAR; PG8_WAIT_L(0); PG8_MMA(0, 1, At, B1); PG8_BAR;
            PG8_LDA(At, 1, 1); PG8_STAGE(PG8_SA(1, 0), a3, voffA);
            PG8_BAR; PG8_WAIT_L(0); PG8_MMA(1, 0, At, B0); PG8_BAR; PG8_SCHED;
            PG8_STAGE(PG8_SB(1, 1), b3 + hstep, voffB);
            PG8_WAIT_V(6); PG8_BAR; PG8_MMA(1, 1, At, B1); PG8_BAR;
            }
        }
        if constexpr (ALIGN_EPI) { if (wr == 0) PG8_BAR; }
        if constexpr (!Epi::AFTER_DRAIN) { E(acc, cur, wr, wc, fr, fq); S.done(cur); }
        if (!has_next) break;
#pragma unroll
        for (int a = 0; a < 2; ++a)
#pragma unroll
            for (int b = 0; b < 2; ++b)
#pragma unroll
                for (int m = 0; m < 4; ++m)
#pragma unroll
                    for (int n = 0; n < 2; ++n) acc[a][b][m][n] = (f32x4){0.f, 0.f, 0.f, 0.f};
        cur = nxt; cA = nA; cB = nB; ++ui;
        if constexpr (ALIGN_EPI) { if (wr == 1) PG8_BAR; }
    }
    PG8_WAIT_V(0);
    if constexpr (!ALIGN_EPI) { if (wr == 0) PG8_BAR; }
    PG8_BAR;
    if constexpr (Epi::AFTER_DRAIN) { E.fused(acc, cur, wr, wc, fr, fq, lds, wid, lane); S.done(cur); }
#undef PG8_SA
#undef PG8_SB
#undef PG8_STAGE
#undef PG8_LDA
#undef PG8_LDB
#undef PG8_MMA
#undef PG8_WAIT_V
#undef PG8_WAIT_L
#undef PG8_BAR
#undef PG8_SCHED
}
}

#ifndef PG8_SP2
#define PG8_SP2 true
#endif
#ifndef PG8_ALIGN
#define PG8_ALIGN true
#endif
constexpr int NB = 4, SEQ = 8192, DM = 1024, MROWS = NB * SEQ, DFF = 4096;
constexpr int NWAVES = 8;
constexpr float EPSN = 1e-6f;
constexpr int N_IN1 = 6400;
constexpr int N_INT = 8448;
constexpr size_t MiB = 1u << 20;
constexpr size_t WS_CTL = 0, CTL_ZERO_BYTES = 1 * MiB;
constexpr size_t WS_ROPEI = 1 * MiB;
constexpr size_t WS_ROPEA = 1 * MiB + 512 * 1024;
constexpr size_t WS_WINT = 3 * MiB;
constexpr size_t WS_WOT = 20 * MiB, WS_WUT = 22 * MiB, WS_WDT = 30 * MiB;
constexpr size_t WS_QKV = 40 * MiB;
constexpr size_t WS_Z = 232 * MiB;
constexpr size_t WS_AQ = 296 * MiB;
constexpr size_t WS_AKV = 360 * MiB;
constexpr size_t WS_IQ = 392 * MiB;
constexpr size_t WS_IK = 424 * MiB;
constexpr size_t WS_SM = 428 * MiB;
constexpr size_t WS_HALO = 432 * MiB;
constexpr size_t WS_TOPK = 442 * MiB;
constexpr size_t WS_HID = 40 * MiB;
constexpr size_t WS_KV8 = 492 * MiB;
constexpr size_t WS_NEED = 508 * MiB;

constexpr int LDS_BYTES = 163840;

#define GAS __attribute__((address_space(1)))
#define LAS __attribute__((address_space(3)))
typedef unsigned short bf16;
typedef unsigned v4u __attribute__((ext_vector_type(4)));
typedef unsigned v2u __attribute__((ext_vector_type(2)));
#define LANEID ((int)__builtin_amdgcn_mbcnt_hi(~0u, __builtin_amdgcn_mbcnt_lo(~0u, 0u)))
typedef float f32x4 __attribute__((ext_vector_type(4)));
#define LDS_WAIT() asm volatile("s_waitcnt lgkmcnt(0)" ::: "memory")
__device__ __forceinline__ unsigned f2bf(float f) { unsigned u = __builtin_bit_cast(unsigned, f); return (u + 0x7fffu + ((u >> 16) & 1u)) >> 16; }
__device__ __forceinline__ unsigned pk2(float lo, float hi) { return f2bf(lo) | (f2bf(hi) << 16); }
__device__ __forceinline__ float bflo(unsigned w) { return __builtin_bit_cast(float, w << 16); }
__device__ __forceinline__ float bfhi(unsigned w) { return __builtin_bit_cast(float, w & 0xffff0000u); }
__device__ __forceinline__ float bf2f(bf16 v) { return __builtin_bit_cast(float, ((unsigned)v) << 16); }
__device__ __forceinline__ float wave_sum(float v) {
#pragma unroll
    for (int o = 1; o < 64; o <<= 1) v += __shfl_xor(v, o);
    return v;
}
#define DPPF(x, ctrl) __builtin_bit_cast(float, __builtin_amdgcn_update_dpp(0, __builtin_bit_cast(int, (float)(x)), (ctrl), 0xf, 0xf, true))
__device__ __forceinline__ float dpp_xor1(float x) { return DPPF(x, 0xB1); }
__device__ __forceinline__ float dpp_xor2(float x) { return DPPF(x, 0x4E); }
__device__ __forceinline__ float dpp_xor8(float x) { return DPPF(x, 0x128); }
__device__ __forceinline__ float dpp_xor4(float x, int lane) { const float a = DPPF(x, 0x104), b = DPPF(x, 0x114); return (lane & 4) ? b : a; }
__device__ __forceinline__ float sum4(float x) { x += dpp_xor1(x); x += dpp_xor2(x); return x; }
__device__ __forceinline__ float sum8(float x) { x = sum4(x); x += DPPF(x, 0x141); return x; }
__device__ __forceinline__ float sum16(float x) { x = sum8(x); x += DPPF(x, 0x140); return x; }
__device__ __forceinline__ float siluf_(float x) { return x * __builtin_amdgcn_rcpf(1.0f + __expf(-x)); }
__device__ __forceinline__ float sigm_(float x) { return __builtin_amdgcn_rcpf(1.0f + __expf(-x)); }
__device__ __forceinline__ float softplusf_(float x) { const float y = __expf(x); const float sm = y * (1.0f - y * (0.5f - y * 0.33333334f)); return x > 20.f ? x : (y < 0.01f ? sm : __logf(1.0f + y)); }

struct Args {
    const float* x; const float* norm_mix_g; const float* w_in; const float* conv_w; const float* a_log; const float* dt_bias;
    const float* gdn_norm_g; const float* q_norm_g; const float* k_norm_g; const float* w_out; const float* norm_mlp_g; const float* w_up; const float* w_down;
    float* out; unsigned char* ws; int ph_lo, ph_hi;
};

__device__ __forceinline__ int win_src_col(int n) {
    if (n < 4096) return n;
    if (n < 6208) return n + 16;
    if (n < 6216) return 4096 + (n - 6208);
    if (n < 6224) return 4104 + (n - 6216);
    if (n < 6232) return 6224 + (n - 6224);
    if (n < 6400) return -1;
    const int j = (n - 6400) >> 8, i = (n - 6400) & 255;
    return i < 128 ? 6232 + 128 * j + i : 7256 + 128 * j + (i - 128);
}
template <bool PERMUTE, bool KGAIN = false>
__device__ __forceinline__ void transpose_item(const float* W, int K, int Nsrc, bf16* WT, int n0, int k0, LAS float* scr, int lane, const float* kg = nullptr) {
    const int c0 = PERMUTE ? win_src_col(n0) : n0; const int c31 = PERMUTE ? win_src_col(n0 + 31) : n0 + 31;
    if (c0 >= 0 && c31 == c0 + 31) {
        const int r8 = lane >> 3, c4 = (lane & 7) * 4;
        f32x4 v[8];
#pragma unroll
        for (int i = 0; i < 8; ++i) v[i] = *(const f32x4*)(W + (size_t)(k0 + 8 * i + r8) * Nsrc + c0 + c4);
#pragma unroll
        for (int i = 0; i < 8; ++i) { LAS float* d = scr + (8 * i + r8) * 33 + c4; d[0] = v[i].x; d[1] = v[i].y; d[2] = v[i].z; d[3] = v[i].w; }
    } else {
        const int nd = n0 + (lane & 31); const int sc = PERMUTE ? win_src_col(nd) : nd;
#pragma unroll 8
        for (int i = 0; i < 32; ++i) { const int kk = 2 * i + (lane >> 5); scr[kk * 33 + (lane & 31)] = sc >= 0 ? W[(size_t)(k0 + kk) * Nsrc + sc] : 0.f; }
    }
    LDS_WAIT(); asm volatile("" ::: "memory");
    const int c = lane & 7;
    f32x4 ga = {1.f, 1.f, 1.f, 1.f}, gb = {1.f, 1.f, 1.f, 1.f}; if (KGAIN) { ga = *(const f32x4*)(kg + k0 + 8 * c); gb = *(const f32x4*)(kg + k0 + 8 * c + 4); }
#pragma unroll
    for (int j = 0; j < 4; ++j) { const int n = (lane >> 3) + 8 * j; const LAS float* s = scr + (8 * c) * 33 + n;
        v4u o; o.x = pk2(s[0 * 33] * ga.x, s[1 * 33] * ga.y); o.y = pk2(s[2 * 33] * ga.z, s[3 * 33] * ga.w); o.z = pk2(s[4 * 33] * gb.x, s[5 * 33] * gb.y); o.w = pk2(s[6 * 33] * gb.z, s[7 * 33] * gb.w);
        *(GAS v4u*)(WT + (size_t)(n0 + n) * K + k0 + 8 * c) = o; }
    LDS_WAIT(); asm volatile("" ::: "memory");
}
__device__ __forceinline__ void rms_row_to_bf16(const float* xrow, const float* g, bf16* orow, int lane) {
    const GAS f32x4* xr = (const GAS f32x4*)xrow + lane; const GAS f32x4* gr = (const GAS f32x4*)g + lane;
    f32x4 v[4]; float s = 0.f;
#pragma unroll
    for (int j = 0; j < 4; ++j) { v[j] = xr[64 * j]; s += (v[j].x * v[j].x + v[j].y * v[j].y) + (v[j].z * v[j].z + v[j].w * v[j].w); }
    const float rstd = __builtin_amdgcn_rsqf(wave_sum(s) * (1.f / DM) + EPSN);
    GAS unsigned long long* o8 = (GAS unsigned long long*)orow + lane;
#pragma unroll
    for (int j = 0; j < 4; ++j) { const f32x4 gv = gr[64 * j];
        o8[64 * j] = (unsigned long long)pk2(v[j].x * rstd * gv.x, v[j].y * rstd * gv.y) | ((unsigned long long)pk2(v[j].z * rstd * gv.z, v[j].w * rstd * gv.w) << 32); }
}

__device__ __forceinline__ void rms_rows_to_bf16(const float* X, const float* g, bf16* O, int gw, int NGW, int lane) {
    const GAS f32x4* gr = (const GAS f32x4*)g + lane; f32x4 gv[4];
#pragma unroll
    for (int j = 0; j < 4; ++j) gv[j] = gr[64 * j];
    for (int m0 = gw; m0 < MROWS; m0 += 4 * NGW) {
        f32x4 v[4][4];
#pragma unroll
        for (int r = 0; r < 4; ++r) { const GAS f32x4* xr = (const GAS f32x4*)(X + (size_t)(m0 + r * NGW) * DM) + lane;
#pragma unroll
            for (int j = 0; j < 4; ++j) v[r][j] = xr[64 * j]; }
#pragma unroll
        for (int r = 0; r < 4; ++r) { float s = 0.f;
#pragma unroll
            for (int j = 0; j < 4; ++j) s += (v[r][j].x * v[r][j].x + v[r][j].y * v[r][j].y) + (v[r][j].z * v[r][j].z + v[r][j].w * v[r][j].w);
            const float rstd = __builtin_amdgcn_rsqf(wave_sum(s) * (1.f / DM) + EPSN);
            GAS unsigned long long* o8 = (GAS unsigned long long*)(O + (size_t)(m0 + r * NGW) * DM) + lane;
#pragma unroll
            for (int j = 0; j < 4; ++j) o8[64 * j] = (unsigned long long)pk2(v[r][j].x * rstd * gv[j].x, v[r][j].y * rstd * gv[j].y) | ((unsigned long long)pk2(v[r][j].z * rstd * gv[j].z, v[r][j].w * rstd * gv[j].w) << 32); }
    }
}

__device__ __forceinline__ void phase_p0(const Args& a, LAS unsigned char* lds, int gw, int NGW, int wave, int lane) {
    LAS float* scr = (LAS float*)(lds + wave * 16384);
    bf16* WinT = (bf16*)(a.ws + WS_WINT); bf16* WoT = (bf16*)(a.ws + WS_WOT); bf16* WuT = (bf16*)(a.ws + WS_WUT); bf16* WdT = (bf16*)(a.ws + WS_WDT);
    constexpr int I_IN = (N_INT / 32) * (DM / 64), I_O = (DM / 32) * (DM / 64), I_U = (DFF / 32) * (DM / 64), I_D = (DM / 32) * (DFF / 64);
    constexpr int NITEMS = I_IN + I_O + I_U + I_D;
    for (int it = gw; it < NITEMS; it += NGW) {
        int r = it;
        if (r < I_IN) { const int nb = r % (N_INT / 32), kb = r / (N_INT / 32); transpose_item<true>(a.w_in, DM, 8280, WinT, nb * 32, kb * 64, scr, lane); continue; } r -= I_IN;
        if (r < I_O) { const int nb = r % (DM / 32), kb = r / (DM / 32); transpose_item<false>(a.w_out, DM, DM, WoT, nb * 32, kb * 64, scr, lane); continue; } r -= I_O;
        if (r < I_U) { const int nb = r % (DFF / 32), kb = r / (DFF / 32); transpose_item<false, true>(a.w_up, DM, DFF, WuT, nb * 32, kb * 64, scr, lane, a.norm_mlp_g); continue; } r -= I_U;
        { const int nb = r % (DM / 32), kb = r / (DM / 32); transpose_item<false>(a.w_down, DFF, DM, WdT, nb * 32, kb * 64, scr, lane); }
    }
    float2* RI = (float2*)(a.ws + WS_ROPEI); float2* RA = (float2*)(a.ws + WS_ROPEA);
    for (int e = gw * 64 + lane; e < SEQ * 24; e += NGW * 64) {
        const int t = e / 24, j = e % 24; float inv, sn, cs;
        if (j < 8) { inv = powf(500000.0f, -(float)(2 * j) / 16.0f); const float ang = (float)t * inv; sincosf(ang, &sn, &cs); RI[t * 8 + j] = make_float2(cs, sn); }
        else { const int jj = j - 8; inv = powf(500000.0f, -(float)(2 * jj) / 32.0f); const float ang = (float)t * inv; sincosf(ang, &sn, &cs); RA[t * 16 + jj] = make_float2(cs, sn); }
    }
    bf16* H = (bf16*)a.out;
    rms_rows_to_bf16(a.x, a.norm_mix_g, H, gw, NGW, lane);
}

__device__ __forceinline__ void phase_p1b(const Args& a, int gw, int NGW, int lane) {
    const bf16* AKV = (const bf16*)(a.ws + WS_AKV); bf16* IK = (bf16*)(a.ws + WS_IK); bf16* IQ = (bf16*)(a.ws + WS_IQ); unsigned char* KV8 = a.ws + WS_KV8;
    const float2* RI = (const float2*)(a.ws + WS_ROPEI); const float2* RA = (const float2*)(a.ws + WS_ROPEA);
    const int sl = lane & 31; const f32x4 gk = *(const f32x4*)(a.k_norm_g + sl * 4);
    for (int m0 = gw; m0 < MROWS; m0 += 4 * NGW) {
        v2u ak[4], vv[4]; bf16 ik[4]; f32x4 c0[4], c1[4]; float2 ikc[4];
        const int mq = m0 + (lane >> 4) * NGW; bf16* iqp = IQ + (size_t)mq * 512 + ((lane >> 1) & 7) * 64 + (lane & 1) * 8;
        const v4u iqw = *(const v4u*)iqp; const f32x4* rq = (const f32x4*)(RI + (mq & (SEQ - 1)) * 8);
        const f32x4 q0 = rq[0], q1 = rq[1], q2 = rq[2], q3 = rq[3];
#pragma unroll
        for (int r = 0; r < 4; ++r) { const int m = m0 + r * NGW, t = m & (SEQ - 1);
            ak[r] = *(const v2u*)(AKV + (size_t)m * 512 + lane * 4); vv[r] = *(const v2u*)(AKV + (size_t)m * 512 + 256 + lane * 4); ik[r] = IK[(size_t)m * 64 + lane];
            const f32x4* rak = (const f32x4*)(RA + t * 16 + (lane & 3) * 4); c0[r] = rak[0]; c1[r] = rak[1]; ikc[r] = RI[t * 8 + (lane & 7)]; }
#pragma unroll
        for (int r = 0; r < 4; ++r) { const int m = m0 + r * NGW;
            {
                const v2u w = ak[r]; float y[4] = {bflo(w.x), bfhi(w.x), bflo(w.y), bfhi(w.y)};
                float ss = y[0] * y[0] + y[1] * y[1] + y[2] * y[2] + y[3] * y[3];
                ss = sum16(ss); ss += __shfl_xor(ss, 16);
                const float rstd = __builtin_amdgcn_rsqf(ss * (1.f / 128.f) + EPSN);
                y[0] *= rstd * gk.x; y[1] *= rstd * gk.y; y[2] *= rstd * gk.z; y[3] *= rstd * gk.w;
#pragma unroll
                for (int i = 0; i < 4; ++i) { const float o = dpp_xor4(y[i], lane); const f32x4 c4 = (i < 2) ? c0[r] : c1[r]; const float cs = (i & 1) ? c4.z : c4.x, sn = (i & 1) ? c4.w : c4.y;
                    if (sl < 4) y[i] = y[i] * cs - o * sn; else if (sl < 8) y[i] = y[i] * cs + o * sn; }
                int w8 = 0; w8 = __builtin_amdgcn_cvt_pk_fp8_f32(y[0] * 8.f, y[1] * 8.f, w8, false); w8 = __builtin_amdgcn_cvt_pk_fp8_f32(y[2] * 8.f, y[3] * 8.f, w8, true);
                *(int*)(KV8 + (size_t)m * 512 + lane * 4) = w8;
                const v2u v2 = vv[r];
                int v8 = 0; v8 = __builtin_amdgcn_cvt_pk_fp8_f32(bflo(v2.x) * 8.f, bfhi(v2.x) * 8.f, v8, false); v8 = __builtin_amdgcn_cvt_pk_fp8_f32(bflo(v2.y) * 8.f, bfhi(v2.y) * 8.f, v8, true);
                *(int*)(KV8 + (size_t)m * 512 + 256 + lane * 4) = v8;
            }
            if (r == 0) {
                float y[8] = {bflo(iqw.x), bfhi(iqw.x), bflo(iqw.y), bfhi(iqw.y), bflo(iqw.z), bfhi(iqw.z), bflo(iqw.w), bfhi(iqw.w)};
                const float cs[8] = {q0.x, q0.z, q1.x, q1.z, q2.x, q2.z, q3.x, q3.z}, sn[8] = {q0.y, q0.w, q1.y, q1.w, q2.y, q2.w, q3.y, q3.w};
                const bool hi = lane & 1;
#pragma unroll
                for (int j = 0; j < 8; ++j) { const float o = dpp_xor1(y[j]); y[j] = hi ? (y[j] * cs[j] + o * sn[j]) : (y[j] * cs[j] - o * sn[j]); }
                v4u o4; o4.x = pk2(y[0], y[1]); o4.y = pk2(y[2], y[3]); o4.z = pk2(y[4], y[5]); o4.w = pk2(y[6], y[7]); *(v4u*)iqp = o4;
            }
            {
                float y = bf2f(ik[r]); const float o = dpp_xor8(y); const float cs = ikc[r].x, sn = ikc[r].y;
                if (lane < 8) y = y * cs - o * sn; else if (lane < 16) y = y * cs + o * sn;
                IK[(size_t)m * 64 + lane] = (bf16)f2bf(y);
            }
        }
    }
}
typedef float f32x16 __attribute__((ext_vector_type(16)));
typedef short bf16x8 __attribute__((ext_vector_type(8)));
typedef float f32x2_ __attribute__((ext_vector_type(2)));
typedef __bf16 bf16x2_ __attribute__((ext_vector_type(2)));
__device__ __forceinline__ unsigned pkbf(float a, float b) { const f32x2_ v = {a, b}; return __builtin_bit_cast(unsigned, __builtin_convertvector(v, bf16x2_)); }
__device__ __forceinline__ int crow16(int reg, int h) { return (reg & 3) + 8 * (reg >> 2) + 4 * h; }
__device__ __forceinline__ int p16pos(int o) { return (o & ~12) | ((o & 4) << 1) | ((o & 8) >> 1); }
#define MFMA32(a, b, c) __builtin_amdgcn_mfma_f32_32x32x16_bf16((a), (b), (c), 0, 0, 0)
#define WG_BAR() do { asm volatile("s_waitcnt lgkmcnt(0)" ::: "memory"); __builtin_amdgcn_s_barrier(); asm volatile("" ::: "memory"); } while (0)

constexpr size_t WS_QKP = 458 * MiB;
constexpr size_t WS_GCUM = 490 * MiB;
constexpr size_t WS_RSTD = 491 * MiB;

__device__ __forceinline__ void phase_gdn_prep(const Args& a, LAS unsigned char* lds, int bx, int G, int tid, int wave, int lane) {
    bf16* QKV = (bf16*)(a.ws + WS_QKV); const bf16* HALO = (const bf16*)(a.ws + WS_HALO); const float* SM = (const float*)(a.ws + WS_SM);
    bf16* WGB = (bf16*)a.out + (size_t)MROWS * DM; bf16* QKP = (bf16*)(a.ws + WS_QKP); float* GCUM = (float*)(a.ws + WS_GCUM);
    const int half = tid >> 8, vw = wave & 3; const int lane0_ = lane;
    unsigned long long pacc[3] = {0ull, 0ull, 0ull}; (void)pacc;
    for (int it0 = 2 * bx; it0 < 4096; it0 += 2 * G) {
        const int item = it0 + half;
        int lane = lane0_; asm volatile("" : "+v"(lane));
        const int lr = lane & 31, lh = lane >> 5; const int vt = vw * 64 + lane;
#if (PROBE_TSA >= 20)
        const unsigned long long q0_ = __builtin_amdgcn_s_memrealtime();
#endif
        unsigned lbase = (unsigned)(size_t)lds + (unsigned)half * 81920u; asm volatile("" : "+v"(lbase));
        LAS unsigned char* ldsv = (LAS unsigned char*)(size_t)lbase;
        LAS unsigned char* KS = ldsv; LAS unsigned char* QS = ldsv + 17408; LAS unsigned char* VS = ldsv + 34816; LAS float* A32 = (LAS float*)(ldsv + 52224); LAS bf16* QKO = (LAS bf16*)(ldsv + 68608);
        LAS float* GC = (LAS float*)(ldsv + 76800); LAS float* BETA = GC + 64; LAS float* BETAW = GC + 128; LAS float* EQ = GC + 192; LAS float* EK = GC + 256;
        const int b = item >> 10, n = (item >> 3) & 127, h = item & 7; const int row0 = b * SEQ + n * 64; const int ch = (b * 8 + h) * 128 + n;
        float ga = 0.f, gb = 0.f, alog_ = 0.f, dtb_ = 0.f;
        if (vw == 0) { const size_t row = (size_t)row0 + lane; ga = SM[row * 32 + h]; gb = SM[row * 32 + 8 + h]; alog_ = a.a_log[h]; dtb_ = a.dt_bias[h]; }
        {
            const int grp = vt >> 4, c = vt & 15, p0 = grp * 4;
            v4u raw[3][7];
#pragma unroll
            for (int m = 0; m < 3; ++m) { const int col = m * 1024 + h * 128 + c * 8;
#pragma unroll
                for (int k = 0; k < 7; ++k) { const int r = p0 - 3 + k; v4u w = {0u, 0u, 0u, 0u};
                    if (r >= 0) w = *(const v4u*)(QKV + (size_t)(row0 + r) * 3072 + col);
                    else if (n > 0) w = *(const v4u*)(HALO + ((size_t)((row0 >> 6) - 1) * 3 + (r + 3)) * 3072 + col);
                    raw[m][k] = w; } }
            asm volatile("" ::: "memory");
            if (vw == 0) {
                const size_t row = (size_t)row0 + lane;
                float gg = -__expf(alog_) * softplusf_(ga + dtb_);
#pragma unroll
                for (int o = 1; o < 64; o <<= 1) { const float t = __shfl_up(gg, o); if (lane >= o) gg += t; }
                const float bt = sigm_(gb); const float eg = __expf(gg); const float glast = __shfl(gg, 63);
                GC[lane] = gg; BETA[lane] = bt; BETAW[lane] = bt * eg; EQ[lane] = eg; EK[lane] = __expf(glast - gg); GCUM[row * 8 + h] = gg;
            }
#pragma unroll
            for (int m = 0; m < 3; ++m) { f32x4 cwm[4][2]; { const int col = m * 1024 + h * 128 + c * 8;
#pragma unroll
                for (int j = 0; j < 4; ++j) { cwm[j][0] = *(const f32x4*)(a.conv_w + j * 3072 + col); cwm[j][1] = *(const f32x4*)(a.conv_w + j * 3072 + col + 4); } }
#pragma unroll
                for (int i = 0; i < 4; ++i) { const int p = p0 + i; float y[8];
#pragma unroll
                    for (int e = 0; e < 8; ++e) y[e] = 0.f;
#pragma unroll
                    for (int j = 0; j < 4; ++j) { const v4u w = raw[m][i + j]; const f32x4 c0 = cwm[j][0], c1 = cwm[j][1];
                        y[0] += c0.x * bflo(w.x); y[1] += c0.y * bfhi(w.x); y[2] += c0.z * bflo(w.y); y[3] += c0.w * bfhi(w.y);
                        y[4] += c1.x * bflo(w.z); y[5] += c1.y * bfhi(w.z); y[6] += c1.z * bflo(w.w); y[7] += c1.w * bfhi(w.w); }
#pragma unroll
                    for (int e = 0; e < 8; ++e) y[e] = siluf_(y[e]);
                    if (m < 2) { float ss = 0.f;
#pragma unroll
                        for (int e = 0; e < 8; ++e) ss += y[e] * y[e];
                        ss = sum16(ss);
                        float sc = __builtin_amdgcn_rsqf(ss + EPSN); if (m == 0) sc *= 0.08838834764831845f;
#pragma unroll
                        for (int e = 0; e < 8; ++e) y[e] *= sc; }
                    v4u o; o.x = pkbf(y[0], y[1]); o.y = pkbf(y[2], y[3]); o.z = pkbf(y[4], y[5]); o.w = pkbf(y[6], y[7]);
                    *(LAS v4u*)((m == 0 ? QS : m == 1 ? KS : VS) + p * 272 + c * 16) = o; }
                asm volatile("" ::: "memory"); }
        }
        __syncthreads();
#if (PROBE_TSA >= 20)
        const unsigned long long q1_ = __builtin_amdgcn_s_memrealtime();
#endif
        {
            const int c = vt & 15, pp = vt >> 4; const int g16 = c >> 1, oo = (c & 1) * 4;
#pragma unroll
            for (int pass = 0; pass < 4; ++pass) { const int p = pp + 16 * pass; const float eq = EQ[p]; bf16* rp = QKV + (size_t)(row0 + p) * 3072 + h * 128 + g16 * 16 + oo;
                const v4u q8 = *(const LAS v4u*)(QS + p * 272 + c * 16);
                *(v2u*)rp = (v2u){pkbf(bflo(q8.x) * eq, bfhi(q8.x) * eq), pkbf(bflo(q8.y) * eq, bfhi(q8.y) * eq)}; *(v2u*)(rp + 8) = (v2u){pkbf(bflo(q8.z) * eq, bfhi(q8.z) * eq), pkbf(bflo(q8.w) * eq, bfhi(q8.w) * eq)}; }
            const int dk = vt & 127;
#pragma unroll
            for (int pg2 = 0; pg2 < 2; ++pg2) { const int pg = 2 * (vt >> 7) + pg2;
                float kv[16];
#pragma unroll
                for (int i = 0; i < 16; ++i) kv[i] = bf2f(*(const LAS bf16*)(KS + (16 * pg + i) * 272 + dk * 2)) * EK[16 * pg + i];
                v4u o0, o1; o0.x = pkbf(kv[0], kv[1]); o0.y = pkbf(kv[2], kv[3]); o0.z = pkbf(kv[8], kv[9]); o0.w = pkbf(kv[10], kv[11]); o1.x = pkbf(kv[4], kv[5]); o1.y = pkbf(kv[6], kv[7]); o1.z = pkbf(kv[12], kv[13]); o1.w = pkbf(kv[14], kv[15]);
                bf16* kp = QKV + (size_t)(row0 + (dk >> 1)) * 3072 + 1024 + h * 128 + (dk & 1) * 64 + pg * 16;
                *(v4u*)kp = o0; *(v4u*)(kp + 8) = o1; }
        }
        {
            const int ti = (vw == 0 || vw == 2) ? 1 : 0, tj = (vw == 2) ? 1 : (vw == 3 ? 1 : 0);
            int vz2; asm volatile("v_mov_b32 %0, 0" : "=v"(vz2));
            LAS float* A32w = A32 + vz2; LAS bf16* QKOw = QKO + vz2; const LAS float* GCr = GC + vz2; const LAS float* BETAr = BETA + vz2;
            const int col = 32 * tj + lr; const float gcol = GCr[col]; const int pc = p16pos(col);
#pragma unroll
            for (int isqk = 0; isqk < 2; ++isqk) {
                f32x16 acc;
#pragma unroll
                for (int i = 0; i < 16; ++i) acc[i] = 0.f;
                if (vw != 3) { const LAS unsigned char* XS = isqk ? QS : KS;
#pragma unroll
                    for (int s = 0; s < 8; ++s) { const bf16x8 av = *(const LAS bf16x8*)(XS + (32 * ti + lr) * 272 + (16 * s + 8 * lh) * 2); const bf16x8 bv = *(const LAS bf16x8*)(KS + (32 * tj + lr) * 272 + (16 * s + 8 * lh) * 2);
                        acc = MFMA32(av, bv, acc); } }
                if (!isqk) {
#pragma unroll
                    for (int i = 0; i < 16; ++i) { const int row = 32 * ti + crow16(i, lh); const float dec = __expf(fminf(GCr[row] - gcol, 0.f)); const float v_ = acc[i] * BETAr[row] * dec;
                        A32w[row * 64 + col] = (row > col) ? v_ : 0.f; }
                } else {
#pragma unroll
                    for (int i = 0; i < 16; ++i) { const int row = 32 * ti + crow16(i, lh); const float dec = __expf(fminf(GCr[row] - gcol, 0.f)); const unsigned v_ = pkbf(acc[i] * dec, 0.f) & 0xffffu;
                        QKOw[row * 64 + pc] = (bf16)((row >= col) ? v_ : 0u); }
                }
            }
        }
        __syncthreads();
#if (PROBE_TSA >= 20)
        const unsigned long long q2_ = __builtin_amdgcn_s_memrealtime();
#endif
        if (vw < 2) {
            int vz; asm volatile("v_mov_b32 %0, 0" : "=v"(vz));
            const LAS float* A32v = A32 + vz; const bool isw = vw == 1; const LAS float* BMv = (isw ? BETAW : BETA) + vz;
            const LAS unsigned char* R = (isw ? KS : VS) + lane * 2;
            f32x2_ t[64];
#pragma unroll
            for (int i = 0; i < 64; ++i) t[i] = (f32x2_){0.f, 0.f};
#pragma unroll
            for (int i = 0; i < 64; ++i) {
                const float bm = BMv[i]; const f32x2_ rhs = {bf2f(*(const LAS bf16*)(R + i * 272)) * bm, bf2f(*(const LAS bf16*)(R + i * 272 + 128)) * bm};
                f32x2_ a0 = rhs, a1 = {0.f, 0.f}, a2 = {0.f, 0.f}, a3 = {0.f, 0.f};
#pragma unroll
                for (int j = 0; j < ((i + 3) & ~3); j += 4) { const f32x4 av = *(const LAS f32x4*)(A32v + i * 64 + j);
                    a0 -= (f32x2_){av.x, av.x} * t[j]; a1 -= (f32x2_){av.y, av.y} * t[j + 1]; a2 -= (f32x2_){av.z, av.z} * t[j + 2]; a3 -= (f32x2_){av.w, av.w} * t[j + 3]; }
                t[i] = (a0 + a1) + (a2 + a3);
                asm volatile("" ::: "memory");
            }
            if (!isw) { bf16* sp_ = QKV + (size_t)row0 * 3072 + 2048 + h * 128 + lane;
#pragma unroll
                for (int i = 0; i < 64; ++i) { sp_[0] = (bf16)(pkbf(t[i].x, 0.f) & 0xffffu); sp_[64] = (bf16)(pkbf(t[i].y, 0.f) & 0xffffu); sp_ += 3072; asm volatile("" : "+v"(sp_)); } }
            else { int wc0 = p16pos(lane), wc1 = p16pos(lane + 64); asm volatile("" : "+v"(wc0), "+v"(wc1)); bf16* sp_ = WGB + (size_t)row0 * 1024 + h * 128;
#pragma unroll
                for (int i = 0; i < 64; ++i) { sp_[wc0] = (bf16)(pkbf(t[i].x, 0.f) & 0xffffu); sp_[wc1] = (bf16)(pkbf(t[i].y, 0.f) & 0xffffu); sp_ += 1024; asm volatile("" : "+v"(sp_)); } }
        } else {
            const int ct = vt - 128; const LAS v4u* src = (const LAS v4u*)QKO; v4u* dst = (v4u*)(QKP + (size_t)ch * 4096);
#pragma unroll
            for (int i = 0; i < 4; ++i) dst[ct + 128 * i] = src[ct + 128 * i];
        }
        __syncthreads();
#if (PROBE_TSA >= 20)
        { const unsigned long long q3_ = __builtin_amdgcn_s_memrealtime(); pacc[0] += q1_ - q0_; pacc[1] += q2_ - q1_; pacc[2] += q3_ - q2_; }
#endif
    }
#if (PROBE_TSA >= 20)
    if (blockIdx.x == 0 && tid == 0) { unsigned long long* T_ = (unsigned long long*)(a.ws + WS_CTL + 65536); T_[30] = 0ull; T_[31] = pacc[0]; T_[32] = pacc[1]; T_[33] = pacc[2]; }
#endif
}
constexpr int SC_WL = 0, SC_QL = 17408, SC_KTL = 34816, SC_QKL = 53248, SC_UL = 62464, SC_BUF = 78848, SC_MISC = 2 * SC_BUF;
#ifndef PROBE_TSA
#define PROBE_TSA -1
#endif
#if (PROBE_TSA >= 20)
#define SCAN_BAR(acc_) do { const unsigned long long t0_ = __builtin_amdgcn_s_memrealtime(); WG_BAR(); acc_ += __builtin_amdgcn_s_memrealtime() - t0_; } while (0)
#else
#define SCAN_BAR(acc_) WG_BAR()
#endif
__device__ __forceinline__ void phase_scan(const Args& a, LAS unsigned char* lds, int bh, int tid, int wave, int lane) {
    unsigned long long wacc = 0ull; unsigned long long pacc[3] = {0ull, 0ull, 0ull}; (void)pacc;
    bf16* QKV = (bf16*)(a.ws + WS_QKV); const bf16* WGB = (const bf16*)a.out + (size_t)MROWS * DM; const bf16* QKP = (const bf16*)(a.ws + WS_QKP);
    const float* GCUM = (const float*)(a.ws + WS_GCUM); float* RSTD = (float*)(a.ws + WS_RSTD);
    const int b = bh >> 3, h = bh & 7; const int lr = lane & 31, lh = lane >> 5;
    LAS float* GLs = (LAS float*)(lds + SC_MISC);
    if (wave < 4) {
        const int jb = wave;
        f32x16 Sacc[4]; bf16x8 Sf[4][2];
#pragma unroll
        for (int r = 0; r < 4; ++r) {
#pragma unroll
            for (int i = 0; i < 16; ++i) Sacc[r][i] = 0.f;
#pragma unroll
            for (int s = 0; s < 2; ++s)
#pragma unroll
                for (int e = 0; e < 8; ++e) Sf[r][s][e] = 0; }
        WG_BAR();
        LAS unsigned* pfbin = (LAS unsigned*)(lds + SC_MISC + 64 + wave * 256);
        for (int n = 0; n < 128; ++n) {
            LAS unsigned char* B = lds + (n & 1) * SC_BUF;
            bf16x8 fa[2][8];
#pragma unroll
            for (int rt = 0; rt < 2; ++rt)
#pragma unroll
                for (int ks = 0; ks < 8; ++ks) fa[rt][ks] = *(const LAS bf16x8*)(B + SC_WL + (32 * rt + lr) * 272 + ks * 32 + lh * 16);
            float uu[2][16];
#pragma unroll
            for (int rt = 0; rt < 2; ++rt)
#pragma unroll
                for (int i = 0; i < 16; ++i) uu[rt][i] = bf2f(*(const LAS bf16*)(B + SC_UL + (32 * rt + crow16(i, lh)) * 256 + (32 * jb + lr) * 2));
            asm volatile("" ::: "memory");
            f32x16 ws_[2];
#pragma unroll
            for (int rt = 0; rt < 2; ++rt) {
#pragma unroll
                for (int i = 0; i < 16; ++i) ws_[rt][i] = 0.f; }
#pragma unroll
            for (int ks = 0; ks < 8; ++ks) {
#pragma unroll
                for (int rt = 0; rt < 2; ++rt) ws_[rt] = MFMA32(fa[rt][ks], Sf[ks >> 1][ks & 1], ws_[rt]); }
            bf16x8 fk[4][4];
#pragma unroll
            for (int r = 0; r < 4; ++r)
#pragma unroll
                for (int ks = 0; ks < 4; ++ks) fk[r][ks] = *(const LAS bf16x8*)(B + SC_KTL + (32 * r + lr) * 144 + ks * 32 + lh * 16);
            const float gl = GLs[n & 1];
            asm volatile("" ::: "memory");
            bf16x8 vf[2][2];
#pragma unroll
            for (int rt = 0; rt < 2; ++rt) {
                float vn[16];
#pragma unroll
                for (int i = 0; i < 16; ++i) vn[i] = uu[rt][i] - ws_[rt][i];
#pragma unroll
                for (int s = 0; s < 2; ++s) { v4u p; p.x = pkbf(vn[8 * s], vn[8 * s + 1]); p.y = pkbf(vn[8 * s + 2], vn[8 * s + 3]); p.z = pkbf(vn[8 * s + 4], vn[8 * s + 5]); p.w = pkbf(vn[8 * s + 6], vn[8 * s + 7]);
                    vf[rt][s] = __builtin_bit_cast(bf16x8, p); } }
#pragma unroll
            for (int rt = 0; rt < 2; ++rt) {
                bf16x8 fq[8], fm[4];
#pragma unroll
                for (int ks = 0; ks < 8; ++ks) fq[ks] = *(const LAS bf16x8*)(B + SC_QL + (32 * rt + lr) * 272 + ks * 32 + lh * 16);
#pragma unroll
                for (int js = 0; js < 2 * (rt + 1); ++js) fm[js] = *(const LAS bf16x8*)(B + SC_QKL + (32 * rt + lr) * 144 + js * 32 + lh * 16);
                asm volatile("" ::: "memory");
                f32x16 qs_;
#pragma unroll
                for (int i = 0; i < 16; ++i) qs_[i] = 0.f;
#pragma unroll
                for (int ks = 0; ks < 8; ++ks) qs_ = MFMA32(fq[ks], Sf[ks >> 1][ks & 1], qs_);
#pragma unroll
                for (int js = 0; js < 2 * (rt + 1); ++js) qs_ = MFMA32(fm[js], vf[js >> 1][js & 1], qs_);
#pragma unroll
                for (int i = 0; i < 16; ++i) { const int row = 32 * rt + crow16(i, lh); *(LAS bf16*)(B + SC_UL + row * 256 + (32 * jb + lr) * 2) = (bf16)(pkbf(qs_[i], 0.f) & 0xffffu); }
            }
#pragma unroll
            for (int r = 0; r < 4; ++r) {
#pragma unroll
                for (int i = 0; i < 16; ++i) Sacc[r][i] *= gl;
#pragma unroll
                for (int ks = 0; ks < 4; ++ks) Sacc[r] = MFMA32(fk[r][ks], vf[ks >> 1][ks & 1], Sacc[r]); }
#pragma unroll
            for (int r = 0; r < 4; ++r)
#pragma unroll
                for (int s = 0; s < 2; ++s) { v4u p; p.x = pkbf(Sacc[r][8 * s], Sacc[r][8 * s + 1]); p.y = pkbf(Sacc[r][8 * s + 2], Sacc[r][8 * s + 3]); p.z = pkbf(Sacc[r][8 * s + 4], Sacc[r][8 * s + 5]); p.w = pkbf(Sacc[r][8 * s + 6], Sacc[r][8 * s + 7]);
                    Sf[r][s] = __builtin_bit_cast(bf16x8, p); }
            SCAN_BAR(wacc);
        }
#if (PROBE_TSA >= 20)
        if (blockIdx.x == 0 && tid == 0) { ((unsigned long long*)(a.ws + WS_CTL + 65536))[20] = 0ull; ((unsigned long long*)(a.ws + WS_CTL + 65536))[21] = wacc; }
#endif
    } else {
        const int lt = tid - 256; const int up = lt >> 2, uq = lt & 3;
        v4u rw[4], rq[4], rk[4], ru[4], rm[2]; float glast = 0.f;
        auto issue = [&](int m) {
            const size_t row0 = (size_t)b * SEQ + (size_t)m * 64; const size_t ch = (size_t)bh * 128 + m;
#pragma unroll
            for (int i = 0; i < 4; ++i) { const int idx = lt + 256 * i, p = idx >> 4, c = idx & 15;
                rw[i] = *(const v4u*)(WGB + (row0 + p) * 1024 + h * 128 + c * 8);
                rq[i] = *(const v4u*)(QKV + (row0 + p) * 3072 + h * 128 + c * 8);
                rk[i] = *(const v4u*)(QKV + (row0 + p) * 3072 + 1024 + h * 128 + c * 8);
                ru[i] = *(const v4u*)(QKV + (row0 + up) * 3072 + 2048 + h * 128 + uq * 32 + i * 8);
                }
#pragma unroll
            for (int i = 0; i < 2; ++i) rm[i] = *(const v4u*)(QKP + ch * 4096 + (size_t)(lt + 256 * i) * 8);
            glast = GCUM[(row0 + 63) * 8 + h];
        };
        auto stage = [&](int bb) {
            LAS unsigned char* B = lds + bb * SC_BUF;
#pragma unroll
            for (int i = 0; i < 4; ++i) { const int idx = lt + 256 * i, p = idx >> 4, c = idx & 15;
                *(LAS v4u*)(B + SC_WL + p * 272 + c * 16) = rw[i];
                *(LAS v4u*)(B + SC_QL + p * 272 + c * 16) = rq[i];
                *(LAS v4u*)(B + SC_KTL + (2 * p + (c >> 3)) * 144 + (c & 7) * 16) = rk[i];
                *(LAS v4u*)(B + SC_UL + up * 256 + (uq * 32 + i * 8) * 2) = ru[i]; }
#pragma unroll
            for (int i = 0; i < 2; ++i) { const int idx = lt + 256 * i; *(LAS v4u*)(B + SC_QKL + (idx >> 3) * 144 + (idx & 7) * 16) = rm[i]; }
            if (lt == 0) GLs[bb] = __expf(glast);
        };
        auto finish = [&](int m, int bb, bool do_store) {
            const LAS unsigned char* B = lds + bb * SC_BUF; float ss = 0.f; v4u w[4];
#pragma unroll
            for (int i = 0; i < 4; ++i) { w[i] = *(const LAS v4u*)(B + SC_UL + up * 256 + (uq * 32 + i * 8) * 2);
                const float o0 = bflo(w[i].x), o1 = bfhi(w[i].x), o2 = bflo(w[i].y), o3 = bfhi(w[i].y), o4 = bflo(w[i].z), o5 = bfhi(w[i].z), o6 = bflo(w[i].w), o7 = bfhi(w[i].w);
                ss += (o0 * o0 + o1 * o1) + (o2 * o2 + o3 * o3) + (o4 * o4 + o5 * o5) + (o6 * o6 + o7 * o7); }
            ss += __shfl_xor(ss, 1); ss += __shfl_xor(ss, 2);
            const size_t row = (size_t)b * SEQ + (size_t)m * 64 + up;
            if (do_store) { bf16* op = QKV + row * 3072 + h * 128 + uq * 32;
#pragma unroll
                for (int i = 0; i < 4; ++i) *(v4u*)(op + i * 8) = w[i];
                if (uq == 0) RSTD[row * 8 + h] = __builtin_amdgcn_rsqf(ss * (1.f / 128.f) + EPSN); }
        };
        issue(0); stage(0); issue(1);
        WG_BAR();
        for (int n = 0; n < 128; ++n) {
#if (PROBE_TSA >= 20)
            const unsigned long long q0_ = __builtin_amdgcn_s_memrealtime();
#endif
            finish(n - 1, (n - 1) & 1, n >= 1);
            asm volatile("" ::: "memory");
#if (PROBE_TSA >= 20)
            asm volatile("s_waitcnt lgkmcnt(0)" ::: "memory"); const unsigned long long q1_ = __builtin_amdgcn_s_memrealtime();
#endif
            stage((n + 1) & 1);
            asm volatile("" ::: "memory");
#if (PROBE_TSA >= 20)
            asm volatile("s_waitcnt lgkmcnt(0)" ::: "memory"); const unsigned long long q2_ = __builtin_amdgcn_s_memrealtime();
#endif
            issue(n + 2 < 128 ? n + 2 : 127);
#if (PROBE_TSA >= 20)
            const unsigned long long q3_ = __builtin_amdgcn_s_memrealtime(); pacc[0] += q1_ - q0_; pacc[1] += q2_ - q1_; pacc[2] += q3_ - q2_;
#endif
            SCAN_BAR(wacc);
        }
#if (PROBE_TSA >= 20)
        if (blockIdx.x == 0 && tid == 256) { unsigned long long* T_ = (unsigned long long*)(a.ws + WS_CTL + 65536); T_[22] = 0ull; T_[23] = wacc; T_[24] = pacc[0]; T_[25] = pacc[1]; T_[26] = pacc[2]; }
#endif
        finish(127, 1, true);
    }
}
constexpr int TK_CAP = 832, TK_SMCAP = 128;
constexpr int TKL_CAND = 0, TKL_SEL = 106496, TKL_META = 139264, TKL_WL = 140288, TKL_QSLOT = 140800, TKL_OUT = 141312, TKL_SM = 149504;
__device__ __forceinline__ float relu_bits(float x) { const int b = __builtin_bit_cast(int, x); return __builtin_bit_cast(float, b > 0 ? b : 0); }
__device__ __forceinline__ int tk_bin(unsigned u) { const int t = (int)((u & 0x7fffffffu) >> 17) - 7232; const int mag = min(max(t, 0), 2047); return (u & 0x80000000u) ? 2047 - mag : 2048 + mag; }
__device__ __forceinline__ int tk_bin_of_key(unsigned key) { const unsigned u = (key & 0x80000000u) ? (key & 0x7fffffffu) : ~key; return tk_bin(u); }
template <int WPL>
__device__ __forceinline__ void tk_threshold(const LAS unsigned* hq, int lane, unsigned target, unsigned& thr_o, unsigned& nab_o) {
    const LAS unsigned* hp = hq + WPL * lane; unsigned own = 0u;
#pragma unroll
    for (int w4 = 0; w4 < WPL / 4; ++w4) { const v4u x = *(const LAS v4u*)(hp + 4 * w4); own += (x.x & 0xffffu) + (x.x >> 16) + (x.y & 0xffffu) + (x.y >> 16) + (x.z & 0xffffu) + (x.z >> 16) + (x.w & 0xffffu) + (x.w >> 16); }
    unsigned v = own;
#pragma unroll
    for (int o = 1; o < 64; o <<= 1) { const unsigned tt = __shfl_down(v, o); if (lane + o < 64) v += tt; }
    const unsigned long long mk = __ballot(v >= target); const int L = mk ? 63 - __builtin_clzll(mk) : 0;
    unsigned thr = 0u, nab = v;
    if (lane == L && mk) { unsigned cum = v - own; bool found = false;
        for (int w = WPL - 1; w >= 0 && !found; --w) { const unsigned x = hp[w]; const unsigned hi = x >> 16, lo = x & 0xffffu;
            if (cum + hi >= target) { thr = 2 * WPL * L + 2 * w + 1; nab = cum; found = true; }
            else { cum += hi; if (cum + lo >= target) { thr = 2 * WPL * L + 2 * w; nab = cum; found = true; } else cum += lo; } } }
    thr_o = __shfl(thr, L); nab_o = __shfl(nab, L);
}
__device__ __forceinline__ void phase_topk(const Args& a, LAS unsigned char* lds, int bx, int G, int tid, int wave, int lane) {
    const bf16* IQ = (const bf16*)(a.ws + WS_IQ); const bf16* IK = (const bf16*)(a.ws + WS_IK); const float* SM = (const float*)(a.ws + WS_SM); unsigned short* TOPK = (unsigned short*)(a.ws + WS_TOPK);
    LAS unsigned* HIST = (LAS unsigned*)lds; LAS unsigned long long* CAND = (LAS unsigned long long*)(lds + TKL_CAND); LAS unsigned* SELw = (LAS unsigned*)(lds + TKL_SEL + wave * 4096);
    LAS unsigned* META = (LAS unsigned*)(lds + TKL_META);
    LAS float* WL = (LAS float*)(lds + TKL_WL); LAS unsigned* QSLOT = (LAS unsigned*)(lds + TKL_QSLOT); LAS unsigned short* OUT = (LAS unsigned short*)(lds + TKL_OUT);
    LAS unsigned long long* SMw = (LAS unsigned long long*)(lds + TKL_SM + wave * 1024);
    unsigned* TKQ = (unsigned*)(a.ws + WS_CTL) + 9216;
    const int lr = lane & 31, lh = lane >> 5;
    for (;;) {
        if (tid == 0) QSLOT[0] = __hip_atomic_fetch_add(TKQ, 1u, __ATOMIC_RELAXED, __HIP_MEMORY_SCOPE_AGENT);
        __syncthreads();
        const int it = (int)QSLOT[0];
        __syncthreads();
        if (it >= 2048) break;
        const int qb = 511 - (it >> 2), b = it & 3; const int t0 = qb * 16; const size_t rowq0 = (size_t)b * SEQ + t0;
        if (t0 < 256) { for (int e = tid; e < 4096; e += 512) { const int q = e >> 8, j = e & 255; TOPK[(rowq0 + q) * 256 + j] = (j <= t0 + q) ? (unsigned short)j : (unsigned short)0xFFFF; } continue; }
        bf16x8 af[4][4];
        { const int hA = (lr & 3) | (((lr >> 3) & 1) << 2), tqA = ((lr >> 2) & 1) | (((lr >> 4) & 1) << 1);
#pragma unroll
          for (int rt = 0; rt < 4; ++rt)
#pragma unroll
            for (int ks = 0; ks < 4; ++ks) af[rt][ks] = *(const bf16x8*)(IQ + (rowq0 + rt * 4 + tqA) * 512 + hA * 64 + 16 * ks + 8 * lh);
          if (tid < 128) WL[tid] = SM[(rowq0 + (tid >> 3)) * 32 + 16 + (tid & 7)] * (0.35355339059327373f * 0.125f); }
        const int nt = (t0 + 15) / 32 + 1;
        int S = nt >= 128 ? 8 : nt >= 64 ? 4 : nt >= 32 ? 2 : 1;
#pragma unroll 1
        for (int attempt = 0; attempt < 2; ++attempt) {
            if (attempt) S = 1;
            const unsigned mtarget = S == 8 ? 58u : S == 4 ? 100u : S == 2 ? 170u : 256u;
            for (int e = tid; e < 8192; e += 512) ((LAS v4u*)HIST)[e] = (v4u){0u, 0u, 0u, 0u};
            if (tid < 80) META[tid] = 0u;
            __syncthreads();
#define RELU_(x) relu_bits((float)(x))
#define TK_MFMA4(ACC, RT, B) do { _Pragma("unroll") for (int i_ = 0; i_ < 16; ++i_) ACC[i_] = 0.f; _Pragma("unroll") for (int ks_ = 0; ks_ < 4; ++ks_) ACC = MFMA32(af[RT][ks_], B[ks_], ACC); } while (0)
#define TK_SCORE(ACC, RT, S_) do { \
        const LAS f32x4* wa_ = (const LAS f32x4*)(WL + ((RT) * 4 + lh) * 8); const f32x4 w0 = wa_[0], w1 = wa_[1], w2 = wa_[4], w3 = wa_[5]; \
        float sa = w0.x * RELU_(ACC[0]); sa = fmaf(w0.y, RELU_(ACC[1]), sa); sa = fmaf(w0.z, RELU_(ACC[2]), sa); sa = fmaf(w0.w, RELU_(ACC[3]), sa); \
        sa = fmaf(w1.x, RELU_(ACC[4]), sa); sa = fmaf(w1.y, RELU_(ACC[5]), sa); sa = fmaf(w1.z, RELU_(ACC[6]), sa); sa = fmaf(w1.w, RELU_(ACC[7]), sa); \
        float sb = w2.x * RELU_(ACC[8]); sb = fmaf(w2.y, RELU_(ACC[9]), sb); sb = fmaf(w2.z, RELU_(ACC[10]), sb); sb = fmaf(w2.w, RELU_(ACC[11]), sb); \
        sb = fmaf(w3.x, RELU_(ACC[12]), sb); sb = fmaf(w3.y, RELU_(ACC[13]), sb); sb = fmaf(w3.z, RELU_(ACC[14]), sb); sb = fmaf(w3.w, RELU_(ACC[15]), sb); \
        _Pragma("unroll") for (int hsel = 0; hsel < 2; ++hsel) { const int q = (RT) * 4 + lh + 2 * hsel; float sc = hsel ? sb : sa; if (sc == 0.f) sc = 0.f; \
            const bool valid = (S_) <= t0 + q; const unsigned u = __builtin_bit_cast(unsigned, sc); const int bin = tk_bin(u); \
            if (pass == 0) { if (valid) atomicAdd((unsigned*)&HIST[q * 2048 + (bin >> 1)], (bin & 1) ? 65536u : 1u); } \
            else if (valid && bin >= thrv[RT][hsel]) { const unsigned pos = atomicAdd((unsigned*)&META[48 + q], 1u); \
                if (pos < (unsigned)TK_CAP) { const unsigned key = (u & 0x80000000u) ? ~u : (u | 0x80000000u); CAND[q * TK_CAP + pos] = ((unsigned long long)key << 32) | (unsigned long long)(65535 - (S_)); } } } \
    } while (0)
#define TK_TILE(B, KT) do { const int s_ = (KT) * 32 + lr; f32x16 accA, accB; \
        TK_MFMA4(accA, 0, B); TK_MFMA4(accB, 1, B); TK_SCORE(accA, 0, s_); TK_MFMA4(accA, 2, B); TK_SCORE(accB, 1, s_); TK_MFMA4(accB, 3, B); TK_SCORE(accA, 2, s_); TK_SCORE(accB, 3, s_); } while (0)
#define TK_LOADB(B, KT) do { const int kc_ = min((KT), nt - 1); const bf16* kp_ = IK + ((size_t)b * SEQ + kc_ * 32 + lr) * 64 + 8 * lh; _Pragma("unroll") for (int ks_ = 0; ks_ < 4; ++ks_) B[ks_] = *(const bf16x8*)(kp_ + 16 * ks_); } while (0)
#pragma unroll 1
            for (int pass = 0; pass < 2; ++pass) {
                const int step = (pass == 0) ? 8 * S : 8;
                int thrv[4][2];
#pragma unroll
                for (int rt = 0; rt < 4; ++rt) { thrv[rt][0] = (int)META[rt * 4 + lh]; thrv[rt][1] = (int)META[rt * 4 + lh + 2]; }
                bf16x8 bA[4], bB[4];
                TK_LOADB(bA, wave);
                for (int kt = wave; kt < nt; kt += 2 * step) {
                    TK_LOADB(bB, kt + step);
                    TK_TILE(bA, kt);
                    if (kt + step < nt) { TK_LOADB(bA, kt + 2 * step); TK_TILE(bB, kt + step); }
                }
                __syncthreads();
                if (pass == 0) {
                    unsigned thr_[2], nab_[2];
#pragma unroll 1
                    for (int qq = 0; qq < 2; ++qq) tk_threshold<32>(HIST + (wave * 2 + qq) * 2048, lane, mtarget, thr_[qq], nab_[qq]);
                    __syncthreads();
                    if (lane == 0) { META[wave * 2] = thr_[0]; META[wave * 2 + 1] = thr_[1]; }
                    __syncthreads();
                }
            }
#undef TK_TILE
#undef TK_SCORE
#undef TK_MFMA4
#undef TK_LOADB
#pragma unroll 1
            for (int qq = 0; qq < 2; ++qq) { const int q = wave * 2 + qq; const unsigned cnt_raw = META[48 + q]; const int cnt = (int)min(cnt_raw, (unsigned)TK_CAP);
                if (cnt_raw < 256u || cnt_raw > (unsigned)TK_CAP) { if (lane == 0) META[64] = 1u; if (attempt == 0) continue; }
                const LAS unsigned long long* cp = CAND + q * TK_CAP;
                { v4u z = {0u, 0u, 0u, 0u}; LAS v4u* sp = (LAS v4u*)SELw + 4 * lane; sp[0] = z; sp[1] = z; sp[2] = z; sp[3] = z; }
                for (int i = lane; i < cnt; i += 64) { const int b11 = tk_bin_of_key((unsigned)(cp[i] >> 32)) >> 1; atomicAdd((unsigned*)&SELw[b11 >> 1], (b11 & 1) ? 65536u : 1u); }
                unsigned thr11, nab; tk_threshold<16>(SELw, lane, 256u, thr11, nab);
                const int need = 256 - (int)nab; unsigned obase = 0u, ebase = 0u;
                for (int i0 = 0; i0 < cnt; i0 += 64) { const int i = i0 + lane; const bool in = i < cnt; const unsigned long long c = in ? cp[i] : 0ull; const int b11 = tk_bin_of_key((unsigned)(c >> 32)) >> 1;
                    const bool above = in && b11 > (int)thr11, eq = in && b11 == (int)thr11;
                    const unsigned long long ma = __ballot(above), me = __ballot(eq);
                    const unsigned pa = obase + __builtin_amdgcn_mbcnt_hi((unsigned)(ma >> 32), __builtin_amdgcn_mbcnt_lo((unsigned)ma, 0u));
                    const unsigned pe = ebase + __builtin_amdgcn_mbcnt_hi((unsigned)(me >> 32), __builtin_amdgcn_mbcnt_lo((unsigned)me, 0u));
                    if (above && pa < 256u) OUT[q * 256 + pa] = (unsigned short)(65535 - (int)(c & 0xffffu));
                    if (eq && pe < (unsigned)TK_SMCAP) SMw[pe] = c;
                    obase += (unsigned)__builtin_popcountll(ma); ebase += (unsigned)__builtin_popcountll(me); }
                if (ebase <= (unsigned)TK_SMCAP) { const int ce = (int)ebase;
                    for (int i = lane; i < ce; i += 64) { const unsigned long long ci = SMw[i]; int rank = 0;
                        for (int j = 0; j < ce; ++j) rank += (SMw[j] > ci) ? 1 : 0;
                        if (rank < need) OUT[q * 256 + nab + rank] = (unsigned short)(65535 - (int)(ci & 0xffffu)); }
                } else {
                    for (int i0 = 0; i0 < cnt; i0 += 64) { const int i = i0 + lane; const unsigned long long ci = i < cnt ? cp[i] : 0ull; const bool eq = i < cnt && (tk_bin_of_key((unsigned)(ci >> 32)) >> 1) == (int)thr11; int rank = 0;
                        for (int j = 0; j < cnt; ++j) { const unsigned long long cj = cp[j]; rank += ((tk_bin_of_key((unsigned)(cj >> 32)) >> 1) == (int)thr11 && cj > ci) ? 1 : 0; }
                        if (eq && rank < need) OUT[q * 256 + nab + rank] = (unsigned short)(65535 - (int)(ci & 0xffffu)); } }
            }
            __syncthreads();
            const bool retry = META[64] != 0u;
            __syncthreads();
            if (!retry) break;
        }
        ((v4u*)(TOPK + rowq0 * 256))[tid] = ((const LAS v4u*)OUT)[tid];
        __syncthreads();
    }
}
typedef float f32x4_ __attribute__((ext_vector_type(4)));
constexpr int CW_ATTNQ = 8192;
#define LANE_FRESH ({ unsigned m_ = ~0u; asm volatile("" : "+s"(m_)); (int)__builtin_amdgcn_mbcnt_hi(m_, __builtin_amdgcn_mbcnt_lo(m_, 0u)); })
template <int AB>
__device__ __forceinline__ void attn_chunk(bf16* AQ, unsigned char* KV8, const unsigned short* TOPK, LAS unsigned char* wl, LAS const float* GQ, const float2* RA, int b, int c, int tbase, int lane) {
    const int col = lane & 15, g = lane >> 4; const size_t row0 = (size_t)b * SEQ + tbase;
    LAS unsigned char* PT = wl + 1024;
    const unsigned long long kvb = (unsigned long long)(KV8 + (size_t)b * SEQ * 512);
    const unsigned long long kvbu = ((unsigned long long)(unsigned)__builtin_amdgcn_readfirstlane((int)(kvb >> 32)) << 32) | (unsigned)__builtin_amdgcn_readfirstlane((int)kvb);
    const __amdgpu_buffer_rsrc_t rs = __builtin_amdgcn_make_buffer_rsrc((void*)kvbu, 0, SEQ * 512, 0x00020000);
    const int lf = LANE_FRESH; const int l8 = lane >> 3; const int voff = 256 + c * 128 + 16 * (lf & 7);
    LAS unsigned char* KS = wl + 3840;
    const int kwo = l8 * 128, kws0 = (((lane & 7) ^ (lane >> 4)) & 7) * 16, kws1 = (((lane & 7) ^ (4 + (lane >> 4))) & 7) * 16;
    const unsigned vwb = 256u * (unsigned)l8, vwk = (2u * (unsigned)(lane & 7)) ^ (((unsigned)l8 & 3u) << 2), vwh = (unsigned)(lane >> 5);
    const unsigned trq = (unsigned)(lane & 15) >> 2, trp = (unsigned)lane & 3u;
    const unsigned ksb = (unsigned)(size_t)KS;
    const unsigned trb0 = ksb + 256u * (8u * g + trq) + 16u * ((trp >> 1) ^ ((trq << 2) | ((2u * g) & 3u))) + 8u * (trp & 1u);
    const unsigned trb1 = ksb + 256u * (8u * g + 4u + trq) + 16u * ((trp >> 1) ^ ((trq << 2) | ((2u * g + 1u) & 3u))) + 8u * (trp & 1u);
    const unsigned ptb = (unsigned)(size_t)PT + (unsigned)((col < 4 ? col * 512 : 2048) + 16 * g);
    const int kdo0 = c * 128 + 16 * (((lf & 7) ^ (lf >> 4)) & 7), kdo1 = c * 128 + 16 * (((lf & 7) ^ (4 + (lf >> 4))) & 7);
    const int kro = col * 128, krs0 = (((2 * g) ^ (col >> 1)) & 7) * 16, krs1 = (((2 * g + 1) ^ (col >> 1)) & 7) * 16;
#define AT_DMAK(IP, BI, IMG) do { _Pragma("unroll") for (int tt = 0; tt < 4; ++tt) { _Pragma("unroll") for (int hh = 0; hh < 2; ++hh) { const unsigned id_ = (IP)[64 * (BI) + 16 * tt + 8 * hh + l8]; \
        __builtin_amdgcn_raw_ptr_buffer_load_lds(rs, (LAS void*)(KS + 8192 * (IMG) + 1024 * (2 * tt + hh)), 16, (int)(id_ * 512u) + (hh ? kdo1 : kdo0), 0, 0, 0); } } } while (0)
#define AT_LOADV(VW, GI) do { _Pragma("unroll") for (int jj = 0; jj < 8; ++jj) { const unsigned id_ = Ic[64 * (GI) + 8 * jj + l8]; VW[jj] = __builtin_amdgcn_raw_buffer_load_b128(rs, (int)(id_ * 512u) + voff, 0, 0); } } while (0)
#define AT_QK(IMG, BI) do { \
    _Pragma("unroll") for (int tt = 0; tt < 4; ++tt) { \
        const v4u r0_ = *(const LAS v4u*)(KS + 8192 * (IMG) + kro + tt * 2048 + krs0), r1_ = *(const LAS v4u*)(KS + 8192 * (IMG) + kro + tt * 2048 + krs1); \
        const long ak0_ = (long)(((unsigned long long)r0_.y << 32) | r0_.x), ak1_ = (long)(((unsigned long long)r0_.w << 32) | r0_.z), ak2_ = (long)(((unsigned long long)r1_.y << 32) | r1_.x), ak3_ = (long)(((unsigned long long)r1_.w << 32) | r1_.z); \
        f32x4_ acc = {0.f, 0.f, 0.f, 0.f}; \
        acc = __builtin_amdgcn_mfma_f32_16x16x32_fp8_fp8(ak0_, qh[0], acc, 0, 0, 0); acc = __builtin_amdgcn_mfma_f32_16x16x32_fp8_fp8(ak1_, qh[1], acc, 0, 0, 0); \
        acc = __builtin_amdgcn_mfma_f32_16x16x32_fp8_fp8(ak2_, qh[2], acc, 0, 0, 0); acc = __builtin_amdgcn_mfma_f32_16x16x32_fp8_fp8(ak3_, qh[3], acc, 0, 0, 0); \
        acc = __builtin_amdgcn_mfma_f32_16x16x32_fp8_fp8(ak0_, ql[0], acc, 0, 0, 0); acc = __builtin_amdgcn_mfma_f32_16x16x32_fp8_fp8(ak1_, ql[1], acc, 0, 0, 0); \
        acc = __builtin_amdgcn_mfma_f32_16x16x32_fp8_fp8(ak2_, ql[2], acc, 0, 0, 0); acc = __builtin_amdgcn_mfma_f32_16x16x32_fp8_fp8(ak3_, ql[3], acc, 0, 0, 0); \
        lg[4 * (BI) + tt][0] = acc[0] * LSC; lg[4 * (BI) + tt][1] = acc[1] * LSC; lg[4 * (BI) + tt][2] = acc[2] * LSC; lg[4 * (BI) + tt][3] = acc[3] * LSC; } } while (0)
#define AT_CV(D, X) do { D.x = __builtin_bit_cast(unsigned, __builtin_amdgcn_cvt_scalef32_pk_bf16_fp8((X).x, 1.0f, false)); D.y = __builtin_bit_cast(unsigned, __builtin_amdgcn_cvt_scalef32_pk_bf16_fp8((X).x, 1.0f, true)); \
        D.z = __builtin_bit_cast(unsigned, __builtin_amdgcn_cvt_scalef32_pk_bf16_fp8((X).y, 1.0f, false)); D.w = __builtin_bit_cast(unsigned, __builtin_amdgcn_cvt_scalef32_pk_bf16_fp8((X).y, 1.0f, true)); } while (0)
#define AT_W(VW, HF, G) do { _Pragma("unroll") for (int i4 = 0; i4 < 4; ++i4) { const v4u r_ = VW[4 * (HF) + i4]; v4u w0_, w1_; { const v2u lo_ = {r_.x, r_.y}; AT_CV(w0_, lo_); } { const v2u hi_ = {r_.z, r_.w}; AT_CV(w1_, hi_); } \
        const unsigned wa_ = vwb + 2048u * i4 + 16u * (vwk ^ ((2u * i4 + vwh) & 3u)) + 8192u * ((G) & 1); *(LAS v4u*)(KS + wa_) = w0_; *(LAS v4u*)(KS + (wa_ ^ 16u)) = w1_; } } while (0)
#define AT_R(B0, B1, PA, G) do { _Pragma("unroll") for (int cc = 0; cc < 8; ++cc) { const unsigned a0_ = trb0 ^ (32u * cc), a1_ = trb1 ^ (32u * cc); \
        if ((G) & 1) asm volatile("ds_read_b64_tr_b16 %0, %2 offset:8192\n\tds_read_b64_tr_b16 %1, %3 offset:8192" : "=&v"(B0[cc]), "=&v"(B1[cc]) : "v"(a0_), "v"(a1_) : "memory"); \
        else asm volatile("ds_read_b64_tr_b16 %0, %2\n\tds_read_b64_tr_b16 %1, %3" : "=&v"(B0[cc]), "=&v"(B1[cc]) : "v"(a0_), "v"(a1_) : "memory"); } \
        { const unsigned pa_a_ = ptb + 64u * (G); asm volatile("ds_read_b128 %0, %1" : "=&v"(PA) : "v"(pa_a_) : "memory"); } } while (0)
#define AT_WAIT(B0, B1, PA) asm volatile("s_waitcnt lgkmcnt(0)" : "+v"(B0[0]), "+v"(B1[0]), "+v"(B0[1]), "+v"(B1[1]), "+v"(B0[2]), "+v"(B1[2]), "+v"(B0[3]), "+v"(B1[3]), "+v"(B0[4]), "+v"(B1[4]), "+v"(B0[5]), "+v"(B1[5]), "+v"(B0[6]), "+v"(B1[6]), "+v"(B0[7]), "+v"(B1[7]), "+v"(PA) :: "memory")
#define AT_M(B0, B1, PA) do { _Pragma("unroll") for (int cc = 0; cc < 8; ++cc) { const v4u bw_ = {B0[cc].x, B0[cc].y, B1[cc].x, B1[cc].y}; \
        oacc[cc] = __builtin_amdgcn_mfma_f32_16x16x32_bf16(__builtin_bit_cast(bf16x8, PA), __builtin_bit_cast(bf16x8, bw_), oacc[cc], 0, 0, 0); } } while (0)
    const __amdgpu_buffer_rsrc_t rsQ = __builtin_amdgcn_make_buffer_rsrc((void*)AQ, 0, MROWS * 2048, 0x00020000);
    const __amdgpu_buffer_rsrc_t rsT = __builtin_amdgcn_make_buffer_rsrc((void*)TOPK, 0, MROWS * 512, 0x00020000);
    const __amdgpu_buffer_rsrc_t rsR = __builtin_amdgcn_make_buffer_rsrc((void*)RA, 0, SEQ * 128, 0x00020000);
    const int qvo = (4 * c + (lf >> 4)) * 256 + 16 * (lf & 15);
#define AT_LOADQ(R) do { qw = __builtin_amdgcn_raw_buffer_load_b128(rsQ, qvo, (int)(R) * 2048, 0); } while (0)
    v4u qw;
    {
        LAS unsigned short* I0 = (LAS unsigned short*)wl;
        *(LAS v2u*)(I0 + 4 * lane) = __builtin_amdgcn_raw_buffer_load_b64(rsT, 8 * lane, (int)row0 * 512, 0);
        { const f32x4 r0_ = __builtin_bit_cast(f32x4, __builtin_amdgcn_raw_buffer_load_b128(rsR, 16 * (lane & 7), tbase * 128, 0)); if (lane < 8) *(LAS f32x4*)(wl + 3584 + 16 * lane) = r0_; }
        asm volatile("s_waitcnt lgkmcnt(0)" ::: "memory");
        AT_DMAK(I0, 0, 0);
    }
#pragma unroll 1
    for (int i = 0; i < 8; ++i) {
        const size_t row = row0 + i; const int tq = tbase + i; const bool allv = tq >= 255;
        constexpr float LSC = 0.08838834764831845f * (1.f / 64.f) * 1.4426950408889634f;
        const size_t rown = (row + 1 < (size_t)MROWS) ? row + 1 : row; const int tn = (tbase + i + 1) & (SEQ - 1);
        LAS unsigned short* Ic = (LAS unsigned short*)(wl + ((i & 1) ? 512 : 0)); LAS unsigned short* In = (LAS unsigned short*)(wl + ((i & 1) ? 0 : 512));
        LAS const unsigned char* Rc = wl + 3584 + ((i & 1) ? 128 : 0); LAS unsigned char* Rn = wl + 3584 + ((i & 1) ? 0 : 128);
        AT_LOADQ(row);
        asm volatile("s_waitcnt lgkmcnt(0)" ::: "memory");
        AT_DMAK(Ic, 1, 1);
        v4u vA[8], vB[8];
        AT_LOADV(vA, 0); AT_LOADV(vB, 1);
        asm volatile("" ::: "memory");
        long qh[4], ql[4];
        {
            unsigned gqo = 32u * (unsigned)col; asm volatile("" : "+v"(gqo));
            float y[8] = {bflo(qw.x), bfhi(qw.x), bflo(qw.y), bfhi(qw.y), bflo(qw.z), bfhi(qw.z), bflo(qw.w), bfhi(qw.w)};
            float ss = 0.f;
#pragma unroll
            for (int e = 0; e < 8; ++e) ss += y[e] * y[e];
            ss = sum16(ss);
            const float rstd = __builtin_amdgcn_rsqf(ss * (1.f / 128.f) + EPSN) * 8.f;
            { const f32x4 g0 = *(LAS const f32x4*)((LAS const unsigned char*)GQ + gqo), g1 = *(LAS const f32x4*)((LAS const unsigned char*)GQ + gqo + 16);
              y[0] *= rstd * g0.x; y[1] *= rstd * g0.y; y[2] *= rstd * g0.z; y[3] *= rstd * g0.w; y[4] *= rstd * g1.x; y[5] *= rstd * g1.y; y[6] *= rstd * g1.z; y[7] *= rstd * g1.w; }
            {   const unsigned ro = 64u * (unsigned)(col & 1);
#pragma unroll
                for (int i2 = 0; i2 < 4; ++i2) { const f32x4 cs2 = *(LAS const f32x4*)(Rc + ro + 16 * i2);
                    const float oa = dpp_xor2(y[2 * i2]), ob = dpp_xor2(y[2 * i2 + 1]);
                    const float ra = (col & 2) ? (y[2 * i2] * cs2.x + oa * cs2.y) : (y[2 * i2] * cs2.x - oa * cs2.y), rb = (col & 2) ? (y[2 * i2 + 1] * cs2.z + ob * cs2.w) : (y[2 * i2 + 1] * cs2.z - ob * cs2.w);
                    if (col < 4) { y[2 * i2] = ra; y[2 * i2 + 1] = rb; } }
            }
            int h0 = 0, h1 = 0, l0 = 0, l1 = 0;
            h0 = __builtin_amdgcn_cvt_pk_fp8_f32(y[0], y[1], h0, false); h0 = __builtin_amdgcn_cvt_pk_fp8_f32(y[2], y[3], h0, true);
            h1 = __builtin_amdgcn_cvt_pk_fp8_f32(y[4], y[5], h1, false); h1 = __builtin_amdgcn_cvt_pk_fp8_f32(y[6], y[7], h1, true);
            const f32x2_ f0 = __builtin_amdgcn_cvt_pk_f32_fp8(h0, false), f1 = __builtin_amdgcn_cvt_pk_f32_fp8(h0, true), f2 = __builtin_amdgcn_cvt_pk_f32_fp8(h1, false), f3 = __builtin_amdgcn_cvt_pk_f32_fp8(h1, true);
            l0 = __builtin_amdgcn_cvt_pk_fp8_f32(y[0] - f0.x, y[1] - f0.y, l0, false); l0 = __builtin_amdgcn_cvt_pk_fp8_f32(y[2] - f1.x, y[3] - f1.y, l0, true);
            l1 = __builtin_amdgcn_cvt_pk_fp8_f32(y[4] - f2.x, y[5] - f2.y, l1, false); l1 = __builtin_amdgcn_cvt_pk_fp8_f32(y[6] - f3.x, y[7] - f3.y, l1, true);
            *(LAS v4u*)(PT + 16 * lane) = (v4u){(unsigned)h0, (unsigned)h1, (unsigned)l0, (unsigned)l1};
#pragma unroll
            for (int ks = 0; ks < 4; ++ks) { v4u t4 = {0u, 0u, 0u, 0u}; if (col < 4) t4 = *(const LAS v4u*)(PT + 256 * col + 64 * g + 16 * ks);
                qh[ks] = (long)(((unsigned long long)t4.y << 32) | t4.x); ql[ks] = (long)(((unsigned long long)t4.w << 32) | t4.z); }
        }
        float lg[16][4];
        asm volatile("s_waitcnt vmcnt(24)" ::: "memory");
        AT_QK(0, 0);
        asm volatile("s_waitcnt lgkmcnt(0)" ::: "memory");
        AT_DMAK(Ic, 2, 0);
        asm volatile("s_waitcnt vmcnt(24)" ::: "memory");
        AT_QK(1, 1);
        asm volatile("s_waitcnt lgkmcnt(0)" ::: "memory");
        AT_DMAK(Ic, 3, 1);
        asm volatile("s_waitcnt vmcnt(8)" ::: "memory");
        AT_QK(0, 2);
        const v2u nidx = __builtin_amdgcn_raw_buffer_load_b64(rsT, 8 * lane, (int)rown * 512, 0); const f32x4 nrope = __builtin_bit_cast(f32x4, __builtin_amdgcn_raw_buffer_load_b128(rsR, 16 * (lane & 7), tn * 128, 0));
        asm volatile("s_waitcnt vmcnt(2)" ::: "memory");
        AT_QK(1, 3);
        asm volatile("" ::: "memory");
        if (!allv) {
#pragma unroll
            for (int T = 0; T < 16; ++T)
#pragma unroll
                for (int r = 0; r < 4; ++r) lg[T][r] = (16 * T + 4 * g + r <= tq) ? lg[T][r] : -INFINITY;
        }
        float m = -INFINITY;
#pragma unroll
        for (int T = 0; T < 16; ++T) m = fmaxf(fmaxf(m, fmaxf(lg[T][0], lg[T][1])), fmaxf(lg[T][2], lg[T][3]));
        m = fmaxf(m, __shfl_xor(m, 16)); m = fmaxf(m, __shfl_xor(m, 32));
        float sum = 0.f;
#pragma unroll
        for (int T = 0; T < 16; ++T)
#pragma unroll
            for (int r = 0; r < 4; ++r) { lg[T][r] = __builtin_amdgcn_exp2f(lg[T][r] - m); sum += lg[T][r]; }
        sum += __shfl_xor(sum, 16); sum += __shfl_xor(sum, 32);
        const float inv = 0.125f * __builtin_amdgcn_rcpf(sum);
        if (col < 4) {
#pragma unroll
            for (int T = 0; T < 16; ++T) { const v2u pw = {pkbf(lg[T][0] * inv, lg[T][1] * inv), pkbf(lg[T][2] * inv, lg[T][3] * inv)}; *(LAS v2u*)(PT + col * 512 + 32 * T + 8 * g) = pw; }
        }
        f32x4_ oacc[8];
#pragma unroll
        for (int cc = 0; cc < 8; ++cc) oacc[cc] = (f32x4_){0.f, 0.f, 0.f, 0.f};
        *(LAS v2u*)(In + 4 * lane) = nidx; if (lane < 8) *(LAS f32x4*)(Rn + 16 * lane) = nrope;
        asm volatile("" ::: "memory");
        {
            v2u bA0[8], bA1[8], bB0[8], bB1[8]; v4u pA, pB;
            AT_W(vA, 0, 0); AT_R(bA0, bA1, pA, 0);
            AT_W(vA, 1, 1); AT_WAIT(bA0, bA1, pA); AT_R(bB0, bB1, pB, 1); AT_M(bA0, bA1, pA);
            AT_LOADV(vA, 2);
            AT_W(vB, 0, 2); AT_WAIT(bB0, bB1, pB); AT_R(bA0, bA1, pA, 2); AT_M(bB0, bB1, pB);
            AT_W(vB, 1, 3); AT_WAIT(bA0, bA1, pA); AT_R(bB0, bB1, pB, 3); AT_M(bA0, bA1, pA);
            AT_LOADV(vB, 3);
            AT_W(vA, 0, 4); AT_WAIT(bB0, bB1, pB); AT_R(bA0, bA1, pA, 4); AT_M(bB0, bB1, pB);
            AT_W(vA, 1, 5); AT_WAIT(bA0, bA1, pA); AT_R(bB0, bB1, pB, 5); AT_M(bA0, bA1, pA);
            AT_W(vB, 0, 6); AT_WAIT(bB0, bB1, pB); AT_R(bA0, bA1, pA, 6); AT_M(bB0, bB1, pB);
            AT_W(vB, 1, 7); AT_WAIT(bA0, bA1, pA);
            if (i < 7) AT_DMAK(In, 0, 0);
            AT_R(bB0, bB1, pB, 7); AT_M(bA0, bA1, pA);
            AT_WAIT(bB0, bB1, pB); AT_M(bB0, bB1, pB);
        }
        asm volatile("" ::: "memory");
        if (g == 0) {
#pragma unroll
            for (int cc = 0; cc < 8; ++cc)
#pragma unroll
                for (int r = 0; r < 4; ++r) *(LAS unsigned short*)(PT + (r * 128 + 16 * cc + col) * 2) = (unsigned short)(pkbf(oacc[cc][r], 0.f) & 0xffffu);
        }
        { const v4u w = *(const LAS v4u*)(PT + 16 * lane);
          if (AB == 0) __builtin_amdgcn_raw_buffer_store_b128(w, rsQ, (4 * c + g) * 256 + 16 * col, (int)row * 2048, 0); }
    }
#undef AT_LOADK
#undef AT_LOADV
#undef AT_QK
#undef AT_W
#undef AT_R
#undef AT_WAIT
#undef AT_M
#undef AT_CV
#undef AT_LOADQ
}
template <int AB>
__device__ __forceinline__ void phase_attn(const Args& a, LAS unsigned char* lds, int wave, int lane) {
    bf16* AQ = (bf16*)(a.ws + WS_AQ); unsigned char* KV8 = a.ws + WS_KV8; const unsigned short* TOPK = (const unsigned short*)(a.ws + WS_TOPK);
    unsigned* QH = (unsigned*)(a.ws + WS_CTL) + CW_ATTNQ + (AB ? 2048 : 0);
    LAS unsigned char* wl = lds + wave * 20224; LAS float* GQ = (LAS float*)(lds + 161792);
    if (wave < 2) GQ[wave * 64 + lane] = a.q_norm_g[wave * 64 + lane];
    if (lane < 32) *(LAS v4u*)(wl + 1024 + 2048 + 16 * lane) = (v4u){0u, 0u, 0u, 0u};
    __syncthreads();
    const unsigned xcc = (unsigned)__builtin_amdgcn_s_getreg((3 << 11) | 20) & 7u;
#if PROBE_ATT
    {
        const int col = lane & 15, g = lane >> 4; unsigned accx = 0u;
        LAS unsigned short* I0 = (LAS unsigned short*)wl;
        const int b = (int)(xcc >> 1), c = (int)(xcc & 1u);
        const unsigned long long kvb = (unsigned long long)(KV8 + (size_t)b * SEQ * 512);
        const unsigned long long kvbu = ((unsigned long long)(unsigned)__builtin_amdgcn_readfirstlane((int)(kvb >> 32)) << 32) | (unsigned)__builtin_amdgcn_readfirstlane((int)kvb);
        const __amdgpu_buffer_rsrc_t rs = __builtin_amdgcn_make_buffer_rsrc((void*)kvbu, 0, SEQ * 512, 0x00020000);
#if PROBE_ATT == 1
#define PA_LOADK(KR, BI) do { _Pragma("unroll") for (int tt = 0; tt < 4; ++tt) { const unsigned id_ = I0[64 * (BI) + 16 * tt + col]; const unsigned kid_ = (id_ == 0xFFFFu) ? 0u : id_; const int ko_ = (int)(kid_ * 512u) + c * 128 + 32 * g; \
        KR[tt][0] = __builtin_amdgcn_raw_buffer_load_b128(rs, ko_, 0, 0); KR[tt][1] = __builtin_amdgcn_raw_buffer_load_b128(rs, ko_ + 16, 0, 0); } } while (0)
#elif PROBE_ATT == 2
#define PA_LOADK(KR, BI) do { _Pragma("unroll") for (int tt = 0; tt < 4; ++tt) { _Pragma("unroll") for (int hh = 0; hh < 2; ++hh) { const unsigned id_ = I0[64 * (BI) + 16 * tt + 8 * hh + (lane >> 3)]; const unsigned kid_ = (id_ == 0xFFFFu) ? 0u : id_; const int ko_ = (int)(kid_ * 512u) + c * 128 + 16 * (lane & 7); \
        KR[tt][hh] = __builtin_amdgcn_raw_buffer_load_b128(rs, ko_, 0, 0); } } } while (0)
#else
#define PA_LOADK(KR, BI) do { _Pragma("unroll") for (int tt = 0; tt < 4; ++tt) { _Pragma("unroll") for (int hh = 0; hh < 2; ++hh) { const unsigned id_ = I0[64 * (BI) + 16 * tt + (lane >> 2)]; const unsigned kid_ = (id_ == 0xFFFFu) ? 0u : id_; const int ko_ = (int)(kid_ * 512u) + c * 128 + 64 * hh + 16 * (lane & 3); \
        KR[tt][hh] = __builtin_amdgcn_raw_buffer_load_b128(rs, ko_, 0, 0); } } } while (0)
#endif
#define PA_USE(KR) do { _Pragma("unroll") for (int tt = 0; tt < 4; ++tt) { _Pragma("unroll") for (int hh = 0; hh < 2; ++hh) accx ^= KR[tt][hh].x ^ KR[tt][hh].y ^ KR[tt][hh].z ^ KR[tt][hh].w; } } while (0)
#pragma unroll 1
        for (int it = 0; it < 32; ++it) {
            const int t = ((((int)blockIdx.x >> 3) & 31) * 8 + wave) * 32 + it; const size_t row = (size_t)b * SEQ + t;
            *(LAS v2u*)(I0 + 4 * lane) = *(const v2u*)(TOPK + row * 256 + 4 * lane);
            v4u kA[4][2], kB[4][2];
            PA_LOADK(kA, 0); PA_LOADK(kB, 1);
            asm volatile("" ::: "memory");
            PA_USE(kA); PA_LOADK(kA, 2);
            asm volatile("" ::: "memory");
            PA_USE(kB); PA_LOADK(kB, 3);
            asm volatile("" ::: "memory");
            PA_USE(kA);
            asm volatile("" ::: "memory");
            PA_USE(kB);
        }
        if (accx == 0x9e3779b9u) ((unsigned*)(a.ws + WS_CTL))[80000 + wave * 64 + lane] = accx;
        __syncthreads();
    }
#endif
    for (int qi = 0; qi < 8; ++qi) {
        const int queue = (int)((xcc + qi) & 7u); const int b = queue >> 1, c = queue & 1;
        for (;;) {
            unsigned base = 0u; if (lane == 0) base = __hip_atomic_fetch_add(QH + queue * 64, 8u, __ATOMIC_RELAXED, __HIP_MEMORY_SCOPE_AGENT);
            base = (unsigned)__builtin_amdgcn_readfirstlane((int)base);
            if (base >= (unsigned)SEQ) break;
            attn_chunk<AB>(AQ, KV8, TOPK, wl, GQ, (const float2*)(a.ws + WS_ROPEA), b, c, (int)base, lane);
        }
    }
}
#ifndef PROBE_DUP
#define PROBE_DUP 0
#endif
#ifndef PROBE_TSA
#define PROBE_TSA -1
#endif
#ifndef PROBE_TSB
#define PROBE_TSB -1
#endif
__device__ __forceinline__ void phase_p4b(const Args& a, int gw, int NGW, int lane) {
    bf16* H2 = (bf16*)(a.ws + WS_AQ);
    rms_rows_to_bf16(a.out, a.norm_mlp_g, H2, gw, NGW, lane);
}

__device__ __forceinline__ void gdn_naive_dev(int chain, int tid, LAS unsigned char* lb, const bf16* QKV, const bf16* Z, const float* SM, const float* conv_w, const float* a_log, const float* dt_bias,
                                              const float* gnorm_g, bf16* OG) {
    const int b = chain >> 3, h = chain & 7, lane = tid & 63, wave = tid >> 6;
    typedef float row128[128];
    LAS row128* sq = (LAS row128*)lb; LAS row128* sk = sq + 32; LAS row128* sv = sk + 32; LAS row128* so = sv + 32;
    LAS float* sdec = (LAS float*)(so + 32); LAS float* sbeta = sdec + 32;
    LAS row128* redA = (LAS row128*)(sbeta + 32); LAS row128* redB = redA + 2;
    float S[64];
#pragma unroll
    for (int i = 0; i < 64; ++i) S[i] = 0.f;
    const int col = tid & 127, half = tid >> 7;
    const float aexp = __expf(a_log[h]), dtb = dt_bias[h];
    for (int t0 = 0; t0 < SEQ; t0 += 32) {
        for (int e = tid; e < 32 * 384; e += 256) {
            const int tok = e / 384, cch = e % 384, which = cch >> 7, d = cch & 127, ch = which * 1024 + h * 128 + d, t = t0 + tok;
            float y = 0.f;
#pragma unroll
            for (int j = 0; j < 4; ++j) { const int tt = t - 3 + j; if (tt >= 0) y += conv_w[j * 3072 + ch] * bf2f(QKV[((size_t)b * SEQ + tt) * 3072 + ch]); }
            y = siluf_(y);
            if (which == 0) sq[tok][d] = y; else if (which == 1) sk[tok][d] = y; else sv[tok][d] = y;
        }
        __syncthreads();
        for (int vi = wave; vi < 64; vi += 4) { const int tok = vi >> 1; LAS float* p = (vi & 1) ? sk[tok] : sq[tok];
            const float x0 = p[lane], x1 = p[lane + 64]; const float ss = wave_sum(x0 * x0 + x1 * x1);
            float sc = 1.0f / sqrtf(ss + EPSN); if (!(vi & 1)) sc *= 0.08838834764831845f;
            p[lane] = x0 * sc; p[lane + 64] = x1 * sc; }
        if (tid < 32) { const size_t row = (size_t)b * SEQ + t0 + tid; const float ga = SM[row * 32 + h], gb = SM[row * 32 + 8 + h];
            sbeta[tid] = sigm_(gb); sdec[tid] = __expf(-aexp * softplusf_(ga + dtb)); }
        __syncthreads();
        for (int tok = 0; tok < 32; ++tok) {
            const float decay = sdec[tok]; const LAS float* kk = sk[tok] + half * 64; const LAS float* qq = sq[tok] + half * 64;
            float p = 0.f;
#pragma unroll
            for (int i = 0; i < 64; ++i) p += S[i] * kk[i];
            redA[half][col] = p; __syncthreads();
            const float kv = (redA[0][col] + redA[1][col]) * decay;
            const float delta = sbeta[tok] * (sv[tok][col] - kv);
            float po = 0.f;
#pragma unroll
            for (int i = 0; i < 64; ++i) { S[i] = decay * S[i] + kk[i] * delta; po += S[i] * qq[i]; }
            redB[half][col] = po; __syncthreads();
            if (half == 0) so[tok][col] = redB[0][col] + redB[1][col];
        }
        __syncthreads();
        for (int tok = wave; tok < 32; tok += 4) { const size_t row = (size_t)b * SEQ + t0 + tok;
            const float o0 = so[tok][lane], o1 = so[tok][lane + 64]; const float ss = wave_sum(o0 * o0 + o1 * o1);
            const float rstd = 1.0f / sqrtf(ss * (1.f / 128.f) + EPSN);
            const float z0 = bf2f(Z[row * 1024 + h * 128 + lane]), z1 = bf2f(Z[row * 1024 + h * 128 + lane + 64]);
            OG[row * 1024 + h * 128 + lane] = (bf16)f2bf(o0 * rstd * gnorm_g[lane] * siluf_(z0));
            OG[row * 1024 + h * 128 + lane + 64] = (bf16)f2bf(o1 * rstd * gnorm_g[lane + 64] * siluf_(z1)); }
        __syncthreads();
    }
}

__device__ __forceinline__ unsigned f2ord(float f) { if (f == 0.f) f = 0.f; const unsigned u = __builtin_bit_cast(unsigned, f); return (u & 0x80000000u) ? ~u : (u | 0x80000000u); }

__device__ __forceinline__ void topk_naive_dev(int bx, int G, int hf, int tid, LAS unsigned char* lb, const bf16* IQ, const bf16* IK, const float* SM, unsigned short* TOPK) {
    LAS float* sq = (LAS float*)lb; LAS float* sw = sq + 512; LAS unsigned* skey = (LAS unsigned*)(sw + 8); LAS unsigned* hist = skey + SEQ; LAS unsigned* smisc = hist + 256; LAS unsigned* scnt = smisc + 4;
    for (int pair = bx; pair < MROWS / 2; pair += G) {
        const int row = pair * 2 + hf, b = row >> 13, t = row & (SEQ - 1);
        unsigned short* outp = TOPK + (size_t)row * 256;
        if (t < 256) { outp[tid] = tid <= t ? (unsigned short)tid : (unsigned short)0xFFFF; continue; }
        sq[tid] = bf2f(IQ[(size_t)row * 512 + tid]); sq[tid + 256] = bf2f(IQ[(size_t)row * 512 + tid + 256]);
        if (tid < 8) sw[tid] = SM[(size_t)row * 32 + 16 + tid] * (0.35355339059327373f * 0.125f);
        if (tid == 0) smisc[2] = 0u;
        __syncthreads();
        const int n = t + 1;
        for (int s = tid; s < n; s += 256) {
            const v4u* kp = (const v4u*)(IK + ((size_t)b * SEQ + s) * 64); float k[64];
#pragma unroll
            for (int i = 0; i < 8; ++i) { const v4u w = kp[i]; k[8 * i] = bflo(w.x); k[8 * i + 1] = bfhi(w.x); k[8 * i + 2] = bflo(w.y); k[8 * i + 3] = bfhi(w.y); k[8 * i + 4] = bflo(w.z); k[8 * i + 5] = bfhi(w.z); k[8 * i + 6] = bflo(w.w); k[8 * i + 7] = bfhi(w.w); }
            float sc = 0.f;
#pragma unroll 1
            for (int hh = 0; hh < 8; ++hh) { float d = 0.f;
#pragma unroll
                for (int i = 0; i < 64; ++i) d += sq[hh * 64 + i] * k[i];
                sc += sw[hh] * fmaxf(d, 0.f); }
            skey[s] = f2ord(sc);
        }
        __syncthreads();
        unsigned prefix = 0u, mask = 0u, need = 256u;
        for (int pass = 0; pass < 4; ++pass) { const int shift = 24 - 8 * pass;
            hist[tid] = 0u; __syncthreads();
            for (int s = tid; s < n; s += 256) { const unsigned k = skey[s]; if ((k & mask) == prefix) atomicAdd((unsigned*)&hist[(k >> shift) & 255u], 1u); }
            __syncthreads();
            if (tid == 0) { unsigned cum = 0u; int d = 255; for (; d > 0; --d) { const unsigned c = hist[d]; if (cum + c >= need) break; cum += c; } smisc[0] = (unsigned)d; smisc[1] = need - cum; }
            __syncthreads();
            prefix |= smisc[0] << shift; mask |= 0xFFu << shift; need = smisc[1];
            __syncthreads();
        }
        const int per = (n + 255) / 256; const int s0 = tid * per, s1 = min(n, s0 + per);
        unsigned ceq = 0u;
        for (int s = s0; s < s1; ++s) { const unsigned k = skey[s]; if (k > prefix) { const unsigned pos = atomicAdd((unsigned*)&smisc[2], 1u); outp[pos] = (unsigned short)s; } else if (k == prefix) ++ceq; }
        scnt[tid] = ceq; __syncthreads();
        if (tid == 0) { unsigned run = 0u; for (int i = 0; i < 256; ++i) { const unsigned c = scnt[i]; scnt[i] = run; run += c; } }
        __syncthreads();
        const unsigned ngt = smisc[2]; unsigned rk = scnt[tid];
        for (int s = s0; s < s1; ++s) { if (skey[s] == prefix) { if (rk < need) outp[ngt + rk] = (unsigned short)s; ++rk; } }
        __syncthreads();
    }
}

__device__ __forceinline__ void attn_simple_dev(int bx, int G, int hf, int tid, LAS unsigned char* lb, bf16* AQ, const bf16* AKV, const unsigned short* TOPK) {
    const int lane = tid & 63, wave = tid >> 6;
    typedef float row256[256];
    LAS float* sq = (LAS float*)lb; LAS row256* sp = (LAS row256*)(sq + 1024); LAS int* sidx = (LAS int*)(sp + 8); LAS float* sred = (LAS float*)(sidx + 256);
    for (int pair = bx; pair < MROWS / 2; pair += G) {
        const int row = pair * 2 + hf, b = row >> 13;
        { const v2u w = *(const v2u*)(AQ + (size_t)row * 1024 + tid * 4); sq[tid * 4] = bflo(w.x); sq[tid * 4 + 1] = bfhi(w.x); sq[tid * 4 + 2] = bflo(w.y); sq[tid * 4 + 3] = bfhi(w.y); }
        const int idx = TOPK[(size_t)row * 256 + tid]; const bool valid = idx != 0xFFFF; sidx[tid] = valid ? idx : -1;
        __syncthreads();
        float lg[8];
        if (valid) { const bf16* kr = AKV + ((size_t)b * SEQ + idx) * 512;
#pragma unroll
            for (int c = 0; c < 2; ++c) { float acc4[4] = {0.f, 0.f, 0.f, 0.f};
                for (int i = 0; i < 16; ++i) { const v4u w = *(const v4u*)(kr + c * 128 + i * 8); const float kf[8] = {bflo(w.x), bfhi(w.x), bflo(w.y), bfhi(w.y), bflo(w.z), bfhi(w.z), bflo(w.w), bfhi(w.w)};
#pragma unroll
                    for (int g = 0; g < 4; ++g) { const LAS float* q = sq + (c * 4 + g) * 128 + i * 8;
#pragma unroll
                        for (int j = 0; j < 8; ++j) acc4[g] += q[j] * kf[j]; } }
#pragma unroll
                for (int g = 0; g < 4; ++g) lg[c * 4 + g] = acc4[g] * 0.08838834764831845f; }
        } else {
#pragma unroll
            for (int hh = 0; hh < 8; ++hh) lg[hh] = -INFINITY;
        }
#pragma unroll
        for (int hh = 0; hh < 8; ++hh) { float m = lg[hh];
#pragma unroll
            for (int o = 1; o < 64; o <<= 1) m = fmaxf(m, __shfl_xor(m, o));
            if (lane == 0) sred[hh * 4 + wave] = m; }
        __syncthreads();
        float ex[8];
#pragma unroll
        for (int hh = 0; hh < 8; ++hh) { const float m = fmaxf(fmaxf(sred[hh * 4], sred[hh * 4 + 1]), fmaxf(sred[hh * 4 + 2], sred[hh * 4 + 3])); ex[hh] = valid ? __expf(lg[hh] - m) : 0.f; }
        __syncthreads();
#pragma unroll
        for (int hh = 0; hh < 8; ++hh) { const float s = wave_sum(ex[hh]); if (lane == 0) sred[hh * 4 + wave] = s; }
        __syncthreads();
#pragma unroll
        for (int hh = 0; hh < 8; ++hh) { const float s = (sred[hh * 4] + sred[hh * 4 + 1]) + (sred[hh * 4 + 2] + sred[hh * 4 + 3]); sp[hh][tid] = ex[hh] / s; }
        __syncthreads();
        const int hh = tid >> 5, d0 = (tid & 31) * 4, c = hh >> 2; float o4[4] = {0.f, 0.f, 0.f, 0.f};
        for (int nn = 0; nn < 256; ++nn) { const int id = sidx[nn]; if (id < 0) continue; const float p = sp[hh][nn];
            const v2u w = *(const v2u*)(AKV + ((size_t)b * SEQ + id) * 512 + 256 + c * 128 + d0);
            o4[0] += p * bflo(w.x); o4[1] += p * bfhi(w.x); o4[2] += p * bflo(w.y); o4[3] += p * bfhi(w.y); }
        v2u o; o.x = pk2(o4[0], o4[1]); o.y = pk2(o4[2], o4[3]); *(v2u*)(AQ + (size_t)row * 1024 + tid * 4) = o;
        __syncthreads();
    }
}

typedef GAS unsigned gu32;
#define RLX_AGENT __ATOMIC_RELAXED, __HIP_MEMORY_SCOPE_AGENT
constexpr int CW_BAR = 4096;
constexpr int LDS_MISC_OFF = 163840 - 64;
#define XB_TMO      128
#define XB_XCNT(j)  (256  + 64 * (j))
#define XB_XSUB(j)  (1280 + 64 * (j))
#define XB_XGEN(j)  (2304 + 64 * (j))
#define XB_TOP      3328
#define XB_TOPGEN   3392
#define XCD_BAR_WORDS 3456
#define XB_SPIN_CAP (1u << 18)

__device__ __forceinline__ unsigned xb_ld(unsigned* p)              { return __hip_atomic_load(p, __ATOMIC_RELAXED, __HIP_MEMORY_SCOPE_AGENT); }
__device__ __forceinline__ unsigned xb_add(unsigned* p, unsigned v) { return __hip_atomic_fetch_add(p, v, __ATOMIC_RELAXED, __HIP_MEMORY_SCOPE_AGENT); }
__device__ __forceinline__ unsigned xb_xcc_id() { return (unsigned)__builtin_amdgcn_s_getreg((3 << 11) | 20) & 0xFu; }
#define XB_SPIN(cond, bar) do { unsigned _sp = 0; while (cond) { __builtin_amdgcn_s_sleep(1); \
    if ((++_sp & 255u) == 0u) { if (xb_ld(&(bar)[XB_TMO])) break; if (_sp > XB_SPIN_CAP) { atomicAdd(&(bar)[XB_TMO], 1u); break; } } } } while (0)

struct XcdBarrier {
    unsigned* bar; unsigned x; bool t0w;
    volatile LAS unsigned* st;
};

__device__ __forceinline__ XcdBarrier xcd_barrier_post(unsigned* bar, volatile LAS unsigned* st, int wave) {
    XcdBarrier b; b.bar = bar; b.x = xb_xcc_id(); b.st = st; b.t0w = (wave == 0);
    if (b.t0w && LANEID == 0) (void)xb_add(&bar[XB_XCNT(b.x)], 1u);
    return b;
}
__device__ __forceinline__ void xcd_barrier_complete(unsigned* bar, unsigned x, unsigned& nloc, unsigned& nx) {
    const unsigned G = gridDim.x * gridDim.y * gridDim.z;
    unsigned sum, cnt, mine, sp = 0u;
    for (;;) {
        sum = 0u; cnt = 0u; mine = 0u;
#pragma unroll
        for (unsigned j = 0; j < 16; ++j) { const unsigned c = xb_ld(&bar[XB_XCNT(j)]); sum += c; cnt += (c > 0u) ? 1u : 0u; mine = (j == x) ? c : mine; }
        if (sum == G) break;
        __builtin_amdgcn_s_sleep(1);
        if ((++sp & 255u) == 0u) { if (xb_ld(&bar[XB_TMO])) break; if (sp > XB_SPIN_CAP) { atomicAdd(&bar[XB_TMO], 1u); break; } }
    }
    nloc = mine > 0u ? mine : 1u; nx = cnt > 0u ? cnt : 1u;
}

__device__ __forceinline__ void xcd_barrier(const XcdBarrier& b) {
    asm volatile("s_waitcnt vmcnt(0)" ::: "memory");
    __syncthreads();
    if (b.t0w && LANEID == 0) {
        unsigned* bar = b.bar;
        __builtin_amdgcn_s_waitcnt(0);
        unsigned nloc = b.st[0], nx = b.st[1];
        if (nloc == 0u) { xcd_barrier_complete(bar, b.x, nloc, nx); b.st[0] = nloc; b.st[1] = nx; }
        const unsigned old = xb_add(&bar[XB_XSUB(b.x)], 1u);
        const unsigned gen = old / nloc;
        if (old + 1u == (gen + 1u) * nloc) {
            __builtin_amdgcn_fence(__ATOMIC_RELEASE, "agent");
            asm volatile("s_waitcnt vmcnt(0)" ::: "memory");
            const unsigned og = xb_add(&bar[XB_TOP], 1u);
            const unsigned tg = og / nx;
            if (og + 1u == (tg + 1u) * nx) xb_add(&bar[XB_TOPGEN], 1u);
            else XB_SPIN(xb_ld(&bar[XB_TOPGEN]) == tg, bar);
            __builtin_amdgcn_fence(__ATOMIC_ACQUIRE, "agent");
            xb_add(&bar[XB_XGEN(b.x)], 1u);
            asm volatile("s_waitcnt vmcnt(0)" ::: "memory");
        } else {
            XB_SPIN(xb_ld(&bar[XB_XGEN(b.x)]) == gen, bar);
            __builtin_amdgcn_fence(__ATOMIC_ACQUIRE, "agent");
            asm volatile("s_waitcnt vmcnt(0)" ::: "memory");
        }
    }
    __syncthreads();
}

namespace cg = cooperative_groups;
constexpr int NPHASE = 11;
__global__ void __launch_bounds__(NWAVES * 64, 2) fwd(Args a) {
    extern __shared__ __attribute__((aligned(16))) unsigned char lds_raw[];
    LAS unsigned char* lds = (LAS unsigned char*)lds_raw;
    const int wave = __builtin_amdgcn_readfirstlane((int)threadIdx.x >> 6);
    const int G = gridDim.x, bx = blockIdx.x; const int vcu = (G % 8 == 0) ? (bx % 8) * (G / 8) + bx / 8 : bx;
    const int gw = vcu * NWAVES + wave, NGW = G * NWAVES;
    unsigned char* ws = a.ws;
    bf16* H = (bf16*)a.out; bf16* OG = (bf16*)a.out + (size_t)MROWS * DM;
    bf16* WinT = (bf16*)(ws + WS_WINT);
    const int lo = a.ph_lo, hi = a.ph_hi;
    if (wave == 0 && LANEID < 16) ((LAS unsigned*)(lds + LDS_MISC_OFF))[LANEID] = 0u;
    __syncthreads();
    XcdBarrier bar = xcd_barrier_post((unsigned*)(ws + WS_CTL) + CW_BAR, (volatile LAS unsigned*)(lds + LDS_MISC_OFF), wave);
#ifndef PROBE_BLK
#define PROBE_BLK 0
#endif
#define STAMP(k) do { if (PROBE_TSA >= 0 && blockIdx.x == PROBE_BLK && (wave == 0 && LANEID == 0)) ((unsigned long long*)(ws + WS_CTL + 65536))[k] = __builtin_amdgcn_s_memrealtime(); } while (0)
    STAMP(0);
#define IN(k) (lo <= (k) && (k) < hi)
#define SEAM(k) do { if (IN(k) && IN((k) + 1)) xcd_barrier(bar); } while (0)
    if (a.ph_lo < 0) cg::this_grid().sync();
    if (IN(0)) phase_p0(a, lds, gw, NGW, wave, LANEID);
    SEAM(0); STAMP(1);
    if (IN(1)) {
        pg8::Gemm g{H, WinT, MROWS, N_IN1, DM}; pg8::StaticOrder S; S.init(MROWS, N_IN1, G, bx);
        pg8::EpiInProj E{(bf16*)(ws + WS_QKV), (bf16*)(ws + WS_Z), (bf16*)(ws + WS_AQ), (bf16*)(ws + WS_AKV), (bf16*)(ws + WS_IQ), (bf16*)(ws + WS_IK), (bf16*)(ws + WS_HALO), (float*)(ws + WS_SM)};
        pg8::gemm_phase<pg8::EpiInProj, pg8::StaticOrder, PG8_ALIGN, PG8_SP2>(lds, g, S, E, wave);
    }
    SEAM(1); STAMP(2);
    if (IN(2)) phase_p1b(a, gw, NGW, LANEID);
    SEAM(2); STAMP(3);
    if (IN(3)) phase_gdn_prep(a, lds, bx, G, (wave * 64 + LANEID), wave, LANEID);
    SEAM(3); STAMP(4);
    if (IN(4)) {
        if (bx < 32) { phase_scan(a, lds, bx, (wave * 64 + LANEID), wave, LANEID); __syncthreads(); STAMP(6); }
        phase_topk(a, lds, bx, G, (wave * 64 + LANEID), wave, LANEID);
    }
    STAMP(13); SEAM(4); STAMP(5);
    if (IN(5)) phase_attn<0>(a, lds, wave, LANEID);
    STAMP(14); SEAM(5); STAMP(7);
    if (IN(6)) {
        pg8::Gemm g{H, WinT + (size_t)N_IN1 * DM, MROWS, 2048, DM}; pg8::StaticOrder S; S.init(MROWS, 2048, G, bx);
        pg8::EpiGate E{(const bf16*)(ws + WS_QKV), 3072, (const bf16*)(ws + WS_AQ), 1024, (bf16*)(ws + WS_Z), (const float*)(ws + WS_RSTD), a.gdn_norm_g};
        pg8::gemm_phase<pg8::EpiGate, pg8::StaticOrder, PG8_ALIGN, PG8_SP2>(lds, g, S, E, wave);
    }
    SEAM(6); STAMP(8);
    if (IN(7)) {
        pg8::Gemm g{(const bf16*)(ws + WS_Z), (const bf16*)(ws + WS_WOT), MROWS, DM, DM}; pg8::StaticOrder S; S.init(MROWS, DM, G, bx);
        pg8::EpiResNorm E{a.x, a.out, (bf16*)(ws + WS_AQ), (float*)(ws + WS_AKV)};
        pg8::gemm_phase<pg8::EpiResNorm, pg8::StaticOrder, PG8_ALIGN, PG8_SP2>(lds, g, S, E, wave);
    }
    STAMP(9);
    if (IN(7) && IN(9)) xcd_barrier(bar);
    STAMP(10);
    if (IN(9)) {
        pg8::Gemm g{(const bf16*)(ws + WS_AQ), (const bf16*)(ws + WS_WUT), MROWS, DFF, DM}; pg8::StaticOrder S; S.init(MROWS, DFF, G, bx);
        pg8::EpiRelu2N E{(bf16*)(ws + WS_HID), DFF, (const float*)(ws + WS_AKV)};
        pg8::gemm_phase<pg8::EpiRelu2N, pg8::StaticOrder, PG8_ALIGN, PG8_SP2>(lds, g, S, E, wave);
    }
#if (PROBE_DUP & 2)
    __syncthreads();
    if (IN(9)) {
        pg8::Gemm g{(const bf16*)(ws + WS_AQ), (const bf16*)(ws + WS_WUT), MROWS, DFF, DM}; pg8::StaticOrder S; S.init(MROWS, DFF, G, bx);
        pg8::EpiRelu2 E{(bf16*)(ws + WS_HID), DFF};
        pg8::gemm_phase<pg8::EpiRelu2, pg8::StaticOrder, PG8_ALIGN, PG8_SP2>(lds, g, S, E, wave);
    }
#endif
    SEAM(9); STAMP(11);
    if (IN(10)) {
        pg8::Gemm g{(const bf16*)(ws + WS_HID), (const bf16*)(ws + WS_WDT), MROWS, DM, DFF}; pg8::StaticOrder S; S.init(MROWS, DM, G, bx);
        pg8::EpiResF32 E{a.out, a.out};
        pg8::gemm_phase<pg8::EpiResF32, pg8::StaticOrder, PG8_ALIGN, PG8_SP2>(lds, g, S, E, wave);
    }
#if (PROBE_TSA >= 0)
    STAMP(12);
#if (PROBE_TSA == 40)
    xcd_barrier(bar);
    if (blockIdx.x == PROBE_BLK && (wave == 0 && LANEID == 0)) { volatile unsigned long long* T_ = (volatile unsigned long long*)(ws + WS_CTL + 65536); T_[40] = 0ull; T_[41] = 100ull * (unsigned long long)__hip_atomic_load((unsigned*)(ws + WS_CTL) + 12288, __ATOMIC_RELAXED, __HIP_MEMORY_SCOPE_AGENT); }
#endif
    if (blockIdx.x == PROBE_BLK && (wave == 0 && LANEID == 0)) { const volatile unsigned long long* TS = (const volatile unsigned long long*)(ws + WS_CTL + 65536); const unsigned long long d = TS[PROBE_TSB] - TS[PROBE_TSA];
        const unsigned long long t0 = __builtin_amdgcn_s_memrealtime(); while (__builtin_amdgcn_s_memrealtime() - t0 < 4ull * d) __builtin_amdgcn_s_sleep(8); }
#endif
}

#ifndef PROBE_DUP
#define PROBE_DUP 0
#endif
#ifndef MK_ONE_LAUNCH
#define MK_ONE_LAUNCH 1
#endif
extern "C" void kernel_launch(void* const* d_in, const int* in_sizes, int n_in, void* d_out, int out_size, void* d_ws, size_t ws_size, hipStream_t stream) {
    static int grid = 0;
    if (grid == 0) {
        if (n_in != 13 || in_sizes[0] != MROWS * DM || out_size != MROWS * DM || ws_size < WS_NEED) { fprintf(stderr, "kernel_launch: unexpected shapes/workspace (%d inputs, ws %zu)\n", n_in, ws_size); grid = -1; return; }
        if (hipFuncSetAttribute((const void*)fwd, hipFuncAttributeMaxDynamicSharedMemorySize, LDS_BYTES) != hipSuccess) { fprintf(stderr, "kernel_launch: hipFuncSetAttribute failed\n"); grid = -1; return; }
        int dev = 0, cus = 0, per_cu = 0;
        hipGetDevice(&dev); hipDeviceGetAttribute(&cus, hipDeviceAttributeMultiprocessorCount, dev);
        hipOccupancyMaxActiveBlocksPerMultiprocessor(&per_cu, (const void*)fwd, NWAVES * 64, LDS_BYTES);
        if (per_cu < 1 || cus < 1) { fprintf(stderr, "kernel_launch: occupancy query says %d blocks/CU on %d CUs\n", per_cu, cus); grid = -1; return; }
        grid = cus;
    }
    if (grid < 0) return;
    if (hipMemsetAsync((char*)d_ws + WS_CTL, 0, CTL_ZERO_BYTES, stream) != hipSuccess) { fprintf(stderr, "kernel_launch: memset failed\n"); return; }
    Args a{};
    a.x = (const float*)d_in[0]; a.norm_mix_g = (const float*)d_in[1]; a.w_in = (const float*)d_in[2]; a.conv_w = (const float*)d_in[3]; a.a_log = (const float*)d_in[4];
    a.dt_bias = (const float*)d_in[5]; a.gdn_norm_g = (const float*)d_in[6]; a.q_norm_g = (const float*)d_in[7]; a.k_norm_g = (const float*)d_in[8]; a.w_out = (const float*)d_in[9];
    a.norm_mlp_g = (const float*)d_in[10]; a.w_up = (const float*)d_in[11]; a.w_down = (const float*)d_in[12];
    a.out = (float*)d_out; a.ws = (unsigned char*)d_ws;
#if MK_ONE_LAUNCH
    a.ph_lo = 0; a.ph_hi = NPHASE;
    void* args[] = {&a};
    hipError_t e = hipLaunchCooperativeKernel((const void*)fwd, dim3(grid), dim3(NWAVES * 64), args, LDS_BYTES, stream);
    if (e != hipSuccess) fprintf(stderr, "cooperative launch failed: %s (grid %d)\n", hipGetErrorString(e), grid);
#else
    for (int p = 0; p < NPHASE; ++p) { a.ph_lo = p; a.ph_hi = p + 1; hipLaunchKernelGGL(fwd, dim3(grid), dim3(NWAVES * 64), LDS_BYTES, stream, a); }
#endif
}
```

```cpp
#include <hip/hip_runtime.h>
#include <hip/hip_cooperative_groups.h>
#include <cstdio>
#include <cstdint>
#ifndef PROBE_TSA
#define PROBE_TSA -1
#endif
#ifndef PROBE_TSB
#define PROBE_TSB -1
#endif
#ifndef PROBE_DUP
#define PROBE_DUP 0
#endif
#ifndef PROBE_ATT
#define PROBE_ATT 0
#endif
namespace pg8 {
#define PG8_LAS __attribute__((address_space(3)))
typedef unsigned short bf16_t;
typedef short bf16x8 __attribute__((ext_vector_type(8)));
typedef float f32x4 __attribute__((ext_vector_type(4)));
typedef unsigned u32x4 __attribute__((ext_vector_type(4)));
constexpr int BM = 256, BK = 64, HALF = 128, HTB = HALF * BK * 2  , STAGE_BYTES = 8 * HTB, NXCD = 8, WGM = 8;

__host__ __device__ __forceinline__ int lds_byte(int r, int c) { const int st = (r >> 4) * 2 + (c >> 5), rr = r & 15, cc = c & 31, ob = rr * 64 + cc * 2; return st * 1024 + (ob ^ (((ob >> 9) & 1) << 5)); }
__host__ __device__ __forceinline__ void stage_rc(int b, int& R, int& C) { const int st = b / 1024, sb = b % 1024, swz = sb ^ (((sb >> 9) & 1) << 5); R = (st >> 1) * 16 + swz / 64; C = (st & 1) * 32 + (swz % 64) / 2; }
__host__ __device__ __forceinline__ int perm32(int rho) { const int n = rho >> 4, i = rho & 15; return 8 * (i >> 2) + 4 * n + (i & 3); }

struct Unit { int pm, pn; };
struct Gemm { const bf16_t* A; const bf16_t* Bt; int M, N, K; };

struct StaticOrder {
    int nM, nN, nwg, G, c;
    __host__ __device__ void init(int M, int N, int G_, int c_) { nM = M / BM; nN = N / BM; nwg = nM * nN; G = G_; c = c_; }
    __host__ __device__ bool next(int i, Unit& u) const {
        const long L = (long)i * G + c; if (L >= nwg) return false;
        int wgid = (int)L; { const int q = nwg / NXCD, r = nwg % NXCD, xcd = wgid % NXCD, off = wgid / NXCD; wgid = (xcd < r ? xcd * (q + 1) : r * (q + 1) + (xcd - r) * q) + off; }
        const int nig = WGM * nN, gid = wgid / nig, fm = gid * WGM, gsz = (nM - fm) < WGM ? (nM - fm) : WGM;
        u.pm = fm + ((wgid % nig) % gsz); u.pn = (wgid % nig) / gsz; return true;
    }
    __device__ __forceinline__ void a_ready(const Unit&) const {}
    __device__ __forceinline__ void done(const Unit&) const {}
};

__device__ __forceinline__ unsigned cvt_pk_bf16(float lo, float hi) { unsigned r; asm volatile("v_cvt_pk_bf16_f32 %0, %1, %2" : "=v"(r) : "v"(lo), "v"(hi)); return r; }
typedef unsigned u32x2 __attribute__((ext_vector_type(2)));
__device__ __forceinline__ float bf_lo(unsigned w) { return __builtin_bit_cast(float, w << 16); }
__device__ __forceinline__ float bf_hi(unsigned w) { return __builtin_bit_cast(float, w & 0xffff0000u); }
__device__ __forceinline__ float sigmoidf_(float x) { return __builtin_amdgcn_rcpf(1.0f + __expf(-x)); }

struct EpiInProj {
    static constexpr bool PERM = true, AFTER_DRAIN = false;
    bf16_t *QKV, *Z, *AQ, *AKV, *IQ, *IK, *HALO; float* SM;
    __device__ __forceinline__ void operator()(const f32x4 (&acc)[2][2][4][2], const Unit& u, int wr, int wc, int fr, int fq) const {
        const int pn = u.pn; const int row0 = u.pm * BM + wr * 64 + fr;
        if (pn < 24) {
            bf16_t* base; int ldc, colt;
            if (pn < 12) { base = QKV; ldc = 3072; colt = pn * 256; }
            else if (pn < 16) { base = Z; ldc = 1024; colt = (pn - 12) * 256; }
            else if (pn < 20) { base = AQ; ldc = 1024; colt = (pn - 16) * 256; }
            else if (pn < 22) { base = AKV; ldc = 512; colt = (pn - 20) * 256; }
            else { base = IQ; ldc = 512; colt = (pn - 22) * 256; }
            const int col0 = colt + wc * 32 + 8 * fq;
#pragma unroll
            for (int ai = 0; ai < 2; ++ai)
#pragma unroll
                for (int m = 0; m < 4; ++m) { const int row = row0 + ai * HALF + m * 16; bf16_t* rowp = base + (size_t)row * ldc + col0;
#pragma unroll
                    for (int bj = 0; bj < 2; ++bj) { const f32x4 v0 = acc[ai][bj][m][0], v1 = acc[ai][bj][m][1];
                        u32x4 w; w.x = cvt_pk_bf16(v0[0], v0[1]); w.y = cvt_pk_bf16(v0[2], v0[3]); w.z = cvt_pk_bf16(v1[0], v1[1]); w.w = cvt_pk_bf16(v1[2], v1[3]);
                        *(u32x4*)(rowp + bj * HALF) = w;
                        if (pn < 12 && m == 3 && fr >= 13) *(u32x4*)(HALO + ((size_t)(row >> 6) * 3 + (fr - 13)) * 3072 + col0 + bj * HALF) = w; } }
        } else {
#pragma unroll
            for (int ai = 0; ai < 2; ++ai)
#pragma unroll
                for (int m = 0; m < 4; ++m) { const int row = row0 + ai * HALF + m * 16; const f32x4 v0 = acc[ai][0][m][0], v1 = acc[ai][0][m][1];
                    if (wc < 2) { u32x4 w; w.x = cvt_pk_bf16(v0[0], v0[1]); w.y = cvt_pk_bf16(v0[2], v0[3]); w.z = cvt_pk_bf16(v1[0], v1[1]); w.w = cvt_pk_bf16(v1[2], v1[3]);
                        *(u32x4*)(IK + (size_t)row * 64 + wc * 32 + 8 * fq) = w; }
                    else if (wc == 2 && fq < 3) { float* p = SM + (size_t)row * 32 + 8 * fq; *(f32x4*)p = v0; *(f32x4*)(p + 4) = v1; } }
        }
    }
};
struct EpiGate {
    static constexpr bool PERM = true, AFTER_DRAIN = false;
    const bf16_t* OG; int ldog; const bf16_t* OA; int ldoa; bf16_t* ZM; const float* RSTD; const float* GN;
    __device__ __forceinline__ void operator()(const f32x4 (&acc)[2][2][4][2], const Unit& u, int wr, int wc, int fr, int fq) const {
        const int row0 = u.pm * BM + wr * 64 + fr; const int d0 = wc * 32 + 8 * fq; const int ch0 = u.pn * 128 + d0;
        const f32x4 g0 = *(const f32x4*)(GN + d0), g1 = *(const f32x4*)(GN + d0 + 4);
#pragma unroll
        for (int ai = 0; ai < 2; ++ai) {
            u32x4 ogv[4], oav[4], zzv[4]; float rsv[4];
#pragma unroll
            for (int m = 0; m < 4; ++m) { const int row = row0 + ai * HALF + m * 16;
                ogv[m] = *(const u32x4*)(OG + (size_t)row * ldog + ch0); oav[m] = *(const u32x4*)(OA + (size_t)row * ldoa + ch0); zzv[m] = *(const u32x4*)(ZM + (size_t)row * 1024 + ch0); rsv[m] = RSTD[(size_t)row * 8 + u.pn]; }
#pragma unroll
            for (int m = 0; m < 4; ++m) { const int row = row0 + ai * HALF + m * 16;
                const u32x4 og = ogv[m], oa = oav[m], zz = zzv[m]; const float rs = rsv[m];
                const f32x4 a0 = acc[ai][0][m][0], a1 = acc[ai][0][m][1], b0 = acc[ai][1][m][0], b1 = acc[ai][1][m][1];
                float r[8];
#define GATE1(i_, av_, bv_, ogv_, oav_, zv_, gv_) { const float z_ = (zv_); const float sz_ = z_ * __builtin_amdgcn_rcpf(1.0f + __expf(-z_)); r[i_] = sigmoidf_(av_) * ((ogv_) * rs * (gv_) * sz_) + sigmoidf_(bv_) * (oav_); }
                GATE1(0, a0[0], b0[0], bf_lo(og.x), bf_lo(oa.x), bf_lo(zz.x), g0.x) GATE1(1, a0[1], b0[1], bf_hi(og.x), bf_hi(oa.x), bf_hi(zz.x), g0.y)
                GATE1(2, a0[2], b0[2], bf_lo(og.y), bf_lo(oa.y), bf_lo(zz.y), g0.z) GATE1(3, a0[3], b0[3], bf_hi(og.y), bf_hi(oa.y), bf_hi(zz.y), g0.w)
                GATE1(4, a1[0], b1[0], bf_lo(og.z), bf_lo(oa.z), bf_lo(zz.z), g1.x) GATE1(5, a1[1], b1[1], bf_hi(og.z), bf_hi(oa.z), bf_hi(zz.z), g1.y)
                GATE1(6, a1[2], b1[2], bf_lo(og.w), bf_lo(oa.w), bf_lo(zz.w), g1.z) GATE1(7, a1[3], b1[3], bf_hi(og.w), bf_hi(oa.w), bf_hi(zz.w), g1.w)
#undef GATE1
                u32x4 w; w.x = cvt_pk_bf16(r[0], r[1]); w.y = cvt_pk_bf16(r[2], r[3]); w.z = cvt_pk_bf16(r[4], r[5]); w.w = cvt_pk_bf16(r[6], r[7]);
                *(u32x4*)(ZM + (size_t)row * 1024 + ch0) = w; }
            asm volatile("" ::: "memory");
        }
    }
};
struct EpiResF32 {
    static constexpr bool PERM = false, AFTER_DRAIN = false;
    const float* base; float* out;
    __device__ __forceinline__ void operator()(const f32x4 (&acc)[2][2][4][2], const Unit& u, int wr, int wc, int fr, int fq) const {
        const int col0 = u.pn * BM + wc * 32 + 4 * fq;
#pragma unroll
        for (int ai = 0; ai < 2; ++ai)
#pragma unroll
            for (int m = 0; m < 4; ++m) { const size_t off = (size_t)(u.pm * BM + ai * HALF + wr * 64 + m * 16 + fr) * 1024 + col0;
#pragma unroll
                for (int bj = 0; bj < 2; ++bj)
#pragma unroll
                    for (int n = 0; n < 2; ++n) { const f32x4 bs = *(const f32x4*)(base + off + bj * HALF + n * 16); *(f32x4*)(out + off + bj * HALF + n * 16) = bs + acc[ai][bj][m][n]; } }
    }
};
struct EpiResNorm {
    static constexpr bool PERM = false, AFTER_DRAIN = false;
    const float* base; float* out; bf16_t* XB; float* PS;
    __device__ __forceinline__ void operator()(const f32x4 (&acc)[2][2][4][2], const Unit& u, int wr, int wc, int fr, int fq) const {
        const int col0 = u.pn * BM + wc * 32 + 4 * fq;
#pragma unroll
        for (int ai = 0; ai < 2; ++ai)
#pragma unroll
            for (int m = 0; m < 4; ++m) { const int row = u.pm * BM + ai * HALF + wr * 64 + m * 16 + fr; const size_t off = (size_t)row * 1024 + col0; float ss = 0.f;
#pragma unroll
                for (int bj = 0; bj < 2; ++bj)
#pragma unroll
                    for (int n = 0; n < 2; ++n) { const f32x4 bs = *(const f32x4*)(base + off + bj * HALF + n * 16); const f32x4 v = bs + acc[ai][bj][m][n]; *(f32x4*)(out + off + bj * HALF + n * 16) = v;
                        ss += v[0] * v[0] + v[1] * v[1] + v[2] * v[2] + v[3] * v[3];
                        u32x2 w; w.x = cvt_pk_bf16(v[0], v[1]); w.y = cvt_pk_bf16(v[2], v[3]); *(u32x2*)(XB + off + bj * HALF + n * 16) = w; }
                ss += __shfl_xor(ss, 16); ss += __shfl_xor(ss, 32);
                if (fq == 0) PS[(size_t)row * 16 + u.pn * 4 + wc] = ss; }
    }
};
struct EpiRelu2N {
    static constexpr bool PERM = true, AFTER_DRAIN = false;
    bf16_t* O; int ldc; const float* PS;
    __device__ __forceinline__ void operator()(const f32x4 (&acc)[2][2][4][2], const Unit& u, int wr, int wc, int fr, int fq) const {
        const int row0 = u.pm * BM + wr * 64 + fr; const int col0 = u.pn * BM + wc * 32 + 8 * fq;
#pragma unroll
        for (int ai = 0; ai < 2; ++ai)
#pragma unroll
            for (int m = 0; m < 4; ++m) { const int row = row0 + ai * HALF + m * 16; bf16_t* rowp = O + (size_t)row * ldc + col0;
                const f32x4* pp = (const f32x4*)(PS + (size_t)row * 16); const f32x4 s4 = (pp[0] + pp[1]) + (pp[2] + pp[3]);
                const float rstd = __builtin_amdgcn_rsqf(((s4[0] + s4[1]) + (s4[2] + s4[3])) * (1.f / 1024.f) + 1e-6f);
#pragma unroll
                for (int bj = 0; bj < 2; ++bj) { f32x4 v0 = acc[ai][bj][m][0], v1 = acc[ai][bj][m][1];
#pragma unroll
                    for (int i = 0; i < 4; ++i) { const float a = fmaxf(v0[i] * rstd, 0.f), b = fmaxf(v1[i] * rstd, 0.f); v0[i] = a * a; v1[i] = b * b; }
                    u32x4 w; w.x = cvt_pk_bf16(v0[0], v0[1]); w.y = cvt_pk_bf16(v0[2], v0[3]); w.z = cvt_pk_bf16(v1[0], v1[1]); w.w = cvt_pk_bf16(v1[2], v1[3]);
                    *(u32x4*)(rowp + bj * HALF) = w; } }
    }
};
struct EpiRelu2 {
    static constexpr bool PERM = true, AFTER_DRAIN = false;
    bf16_t* O; int ldc;
    __device__ __forceinline__ void operator()(const f32x4 (&acc)[2][2][4][2], const Unit& u, int wr, int wc, int fr, int fq) const {
        const int row0 = u.pm * BM + wr * 64 + fr; const int col0 = u.pn * BM + wc * 32 + 8 * fq;
#pragma unroll
        for (int ai = 0; ai < 2; ++ai)
#pragma unroll
            for (int m = 0; m < 4; ++m) { bf16_t* rowp = O + (size_t)(row0 + ai * HALF + m * 16) * ldc + col0;
#pragma unroll
                for (int bj = 0; bj < 2; ++bj) { f32x4 v0 = acc[ai][bj][m][0], v1 = acc[ai][bj][m][1];
#pragma unroll
                    for (int i = 0; i < 4; ++i) { const float a = fmaxf(v0[i], 0.f), b = fmaxf(v1[i], 0.f); v0[i] = a * a; v1[i] = b * b; }
                    u32x4 w; w.x = cvt_pk_bf16(v0[0], v0[1]); w.y = cvt_pk_bf16(v0[2], v0[3]); w.z = cvt_pk_bf16(v1[0], v1[1]); w.w = cvt_pk_bf16(v1[2], v1[3]);
                    *(u32x4*)(rowp + bj * HALF) = w; } }
    }
};
template <class Epi, class Sched, bool ALIGN_EPI = false, bool SP2 = false>
__device__ __forceinline__ void gemm_phase(PG8_LAS unsigned char* lds, const Gemm g, const Sched& S, const Epi& E, const int wid) {
    const int lane = (int)__builtin_amdgcn_mbcnt_hi(~0u, __builtin_amdgcn_mbcnt_lo(~0u, 0u)), tid = wid * 64 + lane, wr = wid >> 2, wc = wid & 3, fr = lane & 15, fq = lane >> 4;
    const int K = g.K, nt = K / BK;
    unsigned voffA[2], voffB[2];
#pragma unroll
    for (int i = 0; i < 2; ++i) { int R, C; stage_rc(tid * 16 + i * 8192, R, C); const int Rb = Epi::PERM ? ((R & ~31) + perm32(R & 31)) : R;
        voffA[i] = (unsigned)(R * K + C) * 2u; voffB[i] = (unsigned)(Rb * K + C) * 2u; }
    const size_t kstep = (size_t)(BK * 2);
    const size_t hstep = (size_t)HALF * K * 2;
    const size_t tstep = 2 * hstep;
    const unsigned ldsw = (unsigned)wid * 1024u;
    const int aoff = lds_byte(wr * 64 + fr, fq * 8), boff = lds_byte(wc * 32 + fr, fq * 8);
#define PG8_SA(b, h) (((b) * 2 + (h)) * HTB)
#define PG8_SB(b, h) ((4 + (b) * 2 + (h)) * HTB)
#define PG8_STAGE(bufoff, gbase, voff) do { _Pragma("unroll") for (int _i = 0; _i < 2; ++_i) \
        __builtin_amdgcn_global_load_lds((const unsigned*)((const char*)(gbase) + (voff)[_i]), (PG8_LAS unsigned*)(lds + (bufoff) + ldsw + _i * 8192), 16, 0, 0); } while (0)
#define PG8_LDA(dst, b, h) do { _Pragma("unroll") for (int m = 0; m < 4; ++m) _Pragma("unroll") for (int k = 0; k < 2; ++k) dst[m][k] = *(const PG8_LAS bf16x8*)(lds + PG8_SA(b, h) + aoff + m * 2048 + k * 1024); } while (0)
#define PG8_LDB(dst, b, h) do { _Pragma("unroll") for (int n = 0; n < 2; ++n) _Pragma("unroll") for (int k = 0; k < 2; ++k) dst[n][k] = *(const PG8_LAS bf16x8*)(lds + PG8_SB(b, h) + boff + n * 2048 + k * 1024); } while (0)
#define PG8_MMA(ai, bj, At, Bt) do { __builtin_amdgcn_s_setprio(1); _Pragma("unroll") for (int m = 0; m < 4; ++m) _Pragma("unroll") for (int n = 0; n < 2; ++n) _Pragma("unroll") for (int k = 0; k < 2; ++k) \
        acc[ai][bj][m][n] = __builtin_amdgcn_mfma_f32_16x16x32_bf16(Bt[n][k], At[m][k], acc[ai][bj][m][n], 0, 0, 0); __builtin_amdgcn_s_setprio(0); } while (0)
#define PG8_WAIT_V(n) asm volatile("s_waitcnt vmcnt(" #n ")" ::: "memory")
#define PG8_WAIT_L(n) asm volatile("s_waitcnt lgkmcnt(" #n ")" ::: "memory")
#define PG8_BAR __builtin_amdgcn_s_barrier()
#define PG8_SCHED __builtin_amdgcn_sched_barrier(0)
    Unit cur, nxt; int ui = 0;
    if (!S.next(0, cur)) return;
    f32x4 acc[2][2][4][2];
#pragma unroll
    for (int a = 0; a < 2; ++a)
#pragma unroll
        for (int b = 0; b < 2; ++b)
#pragma unroll
            for (int m = 0; m < 4; ++m)
#pragma unroll
                for (int n = 0; n < 2; ++n) acc[a][b][m][n] = (f32x4){0.f, 0.f, 0.f, 0.f};
    bf16x8 At[4][2], B0[2][2], B1[2][2];
    const char* cA = (const char*)g.A + (size_t)cur.pm * tstep; const char* cB = (const char*)g.Bt + (size_t)cur.pn * tstep;
    S.a_ready(cur);
    if constexpr (SP2) {
        PG8_STAGE(PG8_SB(0, 0), cB, voffB); PG8_STAGE(PG8_SB(0, 1), cB + hstep, voffB); PG8_STAGE(PG8_SA(0, 0), cA, voffA); PG8_STAGE(PG8_SA(0, 1), cA + hstep, voffA);
        if (wr == 1) PG8_BAR;
        PG8_WAIT_V(2); PG8_BAR;
        PG8_STAGE(PG8_SB(1, 0), cB + kstep, voffB); PG8_STAGE(PG8_SA(1, 0), cA + kstep, voffA); PG8_STAGE(PG8_SB(1, 1), cB + hstep + kstep, voffB);
        PG8_WAIT_V(6); PG8_BAR;
    } else {
        PG8_STAGE(PG8_SB(0, 0), cB, voffB); PG8_STAGE(PG8_SA(0, 0), cA, voffA); PG8_STAGE(PG8_SB(0, 1), cB + hstep, voffB); PG8_STAGE(PG8_SA(0, 1), cA + hstep, voffA);
        if (wr == 1) PG8_BAR;
        PG8_WAIT_V(4); PG8_BAR;
        PG8_STAGE(PG8_SB(1, 0), cB + kstep, voffB); PG8_STAGE(PG8_SA(1, 0), cA + kstep, voffA); PG8_STAGE(PG8_SB(1, 1), cB + hstep + kstep, voffB);
        PG8_WAIT_V(6); PG8_BAR;
    }
    for (;;) {
        const bool has_next = S.next(ui + 1, nxt);
        const char* nA = has_next ? (const char*)g.A + (size_t)nxt.pm * tstep : cA; const char* nB = has_next ? (const char*)g.Bt + (size_t)nxt.pn * tstep : cB;
        for (int t = 0; t < nt; t += 2) {
            const bool last = (t == nt - 2);
            const char* a1 = cA + (size_t)(t + 1) * kstep;
            const char* a2 = last ? nA : cA + (size_t)(t + 2) * kstep; const char* b2 = last ? nB : cB + (size_t)(t + 2) * kstep;
            const char* a3 = a2 + kstep; const char* b3 = b2 + kstep;
            if (last && has_next) S.a_ready(nxt);
            if constexpr (SP2) {
            PG8_LDB(B0, 0, 0); PG8_LDB(B1, 0, 1); PG8_SCHED; PG8_LDA(At, 0, 0); PG8_STAGE(PG8_SA(1, 1), a1 + hstep, voffA);
            PG8_WAIT_V(8); PG8_WAIT_L(0); PG8_BAR; PG8_MMA(0, 0, At, B0); PG8_MMA(0, 1, At, B1); PG8_BAR; PG8_SCHED;
            PG8_LDA(At, 0, 1); PG8_STAGE(PG8_SB(0, 0), b2, voffB); PG8_STAGE(PG8_SB(0, 1), b2 + hstep, voffB); PG8_STAGE(PG8_SA(0, 0), a2, voffA);
            PG8_WAIT_V(8); PG8_WAIT_L(0); PG8_BAR; PG8_MMA(1, 0, At, B0); PG8_MMA(1, 1, At, B1); PG8_BAR; PG8_SCHED;
            PG8_LDB(B0, 1, 0); PG8_LDB(B1, 1, 1); PG8_SCHED; PG8_LDA(At, 1, 0); PG8_STAGE(PG8_SA(0, 1), a2 + hstep, voffA);
            PG8_WAIT_V(8); PG8_WAIT_L(0); PG8_BAR; PG8_MMA(0, 0, At, B0); PG8_MMA(0, 1, At, B1); PG8_BAR; PG8_SCHED;
            PG8_LDA(At, 1, 1); PG8_STAGE(PG8_SB(1, 0), b3, voffB); PG8_STAGE(PG8_SB(1, 1), b3 + hstep, voffB); PG8_STAGE(PG8_SA(1, 0), a3, voffA);
            PG8_WAIT_V(8); PG8_WAIT_L(0); PG8_BAR; PG8_MMA(1, 0, At, B0); PG8_MMA(1, 1, At, B1); PG8_BAR; PG8_SCHED;
            } else {
            PG8_LDB(B0, 0, 0); PG8_SCHED; PG8_LDA(At, 0, 0); PG8_STAGE(PG8_SA(1, 1), a1 + hstep, voffA);
            PG8_WAIT_L(8); PG8_BAR; PG8_WAIT_L(0); PG8_MMA(0, 0, At, B0); PG8_BAR; PG8_SCHED;
            PG8_LDB(B1, 0, 1); PG8_STAGE(PG8_SB(0, 0), b2, voffB);
            PG8_BAR; PG8_WAIT_L(0); PG8_MMA(0, 1, At, B1); PG8_BAR;
            PG8_LDA(At, 0, 1); PG8_STAGE(PG8_SA(0, 0), a2, voffA);
            PG8_BAR; PG8_WAIT_L(0); PG8_MMA(1, 0, At, B0); PG8_BAR; PG8_SCHED;
            PG8_STAGE(PG8_SB(0, 1), b2 + hstep, voffB);
            PG8_WAIT_V(6); PG8_BAR; PG8_MMA(1, 1, At, B1); PG8_BAR;
            PG8_LDB(B0, 1, 0); PG8_SCHED; PG8_LDA(At, 1, 0); PG8_STAGE(PG8_SA(0, 1), a2 + hstep, voffA);
            PG8_WAIT_L(8); PG8_BAR; PG8_WAIT_L(0); PG8_MMA(0, 0, At, B0); PG8_BAR; PG8_SCHED;
            PG8_LDB(B1, 1, 1); PG8_STAGE(PG8_SB(1, 0), b3, voffB);
            PG8_BAR; PG8_WAIT_L(0); PG8_MMA(0, 1, At, B1); PG8_BAR;
            PG8_LDA(At, 1, 1); PG8_STAGE(PG8_SA(1, 0), a3, voffA);
            PG8_BAR; PG8_WAIT_L(0); PG8_MMA(1, 0, At, B0); PG8_BAR; PG8_SCHED;
            PG8_STAGE(PG8_SB(1, 1), b3 + hstep, voffB);
            PG8_WAIT_V(6); PG8_BAR; PG8_MMA(1, 1, At, B1); PG8_BAR;
            }
        }
        if constexpr (ALIGN_EPI) { if (wr == 0) PG8_BAR; }
        if constexpr (!Epi::AFTER_DRAIN) { E(acc, cur, wr, wc, fr, fq); S.done(cur); }
        if (!has_next) break;
#pragma unroll
        for (int a = 0; a < 2; ++a)
#pragma unroll
            for (int b = 0; b < 2; ++b)
#pragma unroll
                for (int m = 0; m < 4; ++m)
#pragma unroll
                    for (int n = 0; n < 2; ++n) acc[a][b][m][n] = (f32x4){0.f, 0.f, 0.f, 0.f};
        cur = nxt; cA = nA; cB = nB; ++ui;
        if constexpr (ALIGN_EPI) { if (wr == 1) PG8_BAR; }
    }
    PG8_WAIT_V(0);
    if constexpr (!ALIGN_EPI) { if (wr == 0) PG8_BAR; }
    PG8_BAR;
    if constexpr (Epi::AFTER_DRAIN) { E.fused(acc, cur, wr, wc, fr, fq, lds, wid, lane); S.done(cur); }
#undef PG8_SA
#undef PG8_SB
#undef PG8_STAGE
#undef PG8_LDA
#undef PG8_LDB
#undef PG8_MMA
#undef PG8_WAIT_V
#undef PG8_WAIT_L
#undef PG8_BAR
#undef PG8_SCHED
}
}

#ifndef PG8_SP2
#define PG8_SP2 true
#endif
#ifndef PG8_ALIGN
#define PG8_ALIGN true
#endif
constexpr int NB = 4, SEQ = 8192, DM = 1024, MROWS = NB * SEQ, DFF = 4096;
constexpr int NWAVES = 8;
constexpr float EPSN = 1e-6f;
constexpr int N_IN1 = 6400;
constexpr int N_INT = 8448;
constexpr size_t MiB = 1u << 20;
constexpr size_t WS_CTL = 0, CTL_ZERO_BYTES = 1 * MiB;
constexpr size_t WS_ROPEI = 1 * MiB;
constexpr size_t WS_ROPEA = 1 * MiB + 512 * 1024;
constexpr size_t WS_WINT = 3 * MiB;
constexpr size_t WS_WOT = 20 * MiB, WS_WUT = 22 * MiB, WS_WDT = 30 * MiB;
constexpr size_t WS_QKV = 40 * MiB;
constexpr size_t WS_Z = 232 * MiB;
constexpr size_t WS_AQ = 296 * MiB;
constexpr size_t WS_AKV = 360 * MiB;
constexpr size_t WS_IQ = 392 * MiB;
constexpr size_t WS_IK = 424 * MiB;
constexpr size_t WS_SM = 428 * MiB;
constexpr size_t WS_HALO = 432 * MiB;
constexpr size_t WS_TOPK = 442 * MiB;
constexpr size_t WS_HID = 40 * MiB;
constexpr size_t WS_KV8 = 492 * MiB;
constexpr size_t WS_NEED = 508 * MiB;

constexpr int LDS_BYTES = 163840;

#define GAS __attribute__((address_space(1)))
#define LAS __attribute__((address_space(3)))
typedef unsigned short bf16;
typedef unsigned v4u __attribute__((ext_vector_type(4)));
typedef unsigned v2u __attribute__((ext_vector_type(2)));
#define LANEID ((int)__builtin_amdgcn_mbcnt_hi(~0u, __builtin_amdgcn_mbcnt_lo(~0u, 0u)))
typedef float f32x4 __attribute__((ext_vector_type(4)));
#define LDS_WAIT() asm volatile("s_waitcnt lgkmcnt(0)" ::: "memory")
__device__ __forceinline__ unsigned f2bf(float f) { unsigned u = __builtin_bit_cast(unsigned, f); return (u + 0x7fffu + ((u >> 16) & 1u)) >> 16; }
__device__ __forceinline__ unsigned pk2(float lo, float hi) { return f2bf(lo) | (f2bf(hi) << 16); }
__device__ __forceinline__ float bflo(unsigned w) { return __builtin_bit_cast(float, w << 16); }
__device__ __forceinline__ float bfhi(unsigned w) { return __builtin_bit_cast(float, w & 0xffff0000u); }
__device__ __forceinline__ float bf2f(bf16 v) { return __builtin_bit_cast(float, ((unsigned)v) << 16); }
__device__ __forceinline__ float wave_sum(float v) {
#pragma unroll
    for (int o = 1; o < 64; o <<= 1) v += __shfl_xor(v, o);
    return v;
}
#define DPPF(x, ctrl) __builtin_bit_cast(float, __builtin_amdgcn_update_dpp(0, __builtin_bit_cast(int, (float)(x)), (ctrl), 0xf, 0xf, true))
__device__ __forceinline__ float dpp_xor1(float x) { return DPPF(x, 0xB1); }
__device__ __forceinline__ float dpp_xor2(float x) { return DPPF(x, 0x4E); }
__device__ __forceinline__ float dpp_xor8(float x) { return DPPF(x, 0x128); }
__device__ __forceinline__ float dpp_xor4(float x, int lane) { const float a = DPPF(x, 0x104), b = DPPF(x, 0x114); return (lane & 4) ? b : a; }
__device__ __forceinline__ float sum4(float x) { x += dpp_xor1(x); x += dpp_xor2(x); return x; }
__device__ __forceinline__ float sum8(float x) { x = sum4(x); x += DPPF(x, 0x141); return x; }
__device__ __forceinline__ float sum16(float x) { x = sum8(x); x += DPPF(x, 0x140); return x; }
__device__ __forceinline__ float siluf_(float x) { return x * __builtin_amdgcn_rcpf(1.0f + __expf(-x)); }
__device__ __forceinline__ float sigm_(float x) { return __builtin_amdgcn_rcpf(1.0f + __expf(-x)); }
__device__ __forceinline__ float softplusf_(float x) { const float y = __expf(x); const float sm = y * (1.0f - y * (0.5f - y * 0.33333334f)); return x > 20.f ? x : (y < 0.01f ? sm : __logf(1.0f + y)); }

struct Args {
    const float* x; const float* norm_mix_g; const float* w_in; const float* conv_w; const float* a_log; const float* dt_bias;
    const float* gdn_norm_g; const float* q_norm_g; const float* k_norm_g; const float* w_out; const float* norm_mlp_g; const float* w_up; const float* w_down;
    float* out; unsigned char* ws; int ph_lo, ph_hi;
};

__device__ __forceinline__ int win_src_col(int n) {
    if (n < 4096) return n;
    if (n < 6208) return n + 16;
    if (n < 6216) return 4096 + (n - 6208);
    if (n < 6224) return 4104 + (n - 6216);
    if (n < 6232) return 6224 + (n - 6224);
    if (n < 6400) return -1;
    const int j = (n - 6400) >> 8, i = (n - 6400) & 255;
    return i < 128 ? 6232 + 128 * j + i : 7256 + 128 * j + (i - 128);
}
template <bool PERMUTE, bool KGAIN = false>
__device__ __forceinline__ void transpose_item(const float* W, int K, int Nsrc, bf16* WT, int n0, int k0, LAS float* scr, int lane, const float* kg = nullptr) {
    const int c0 = PERMUTE ? win_src_col(n0) : n0; const int c31 = PERMUTE ? win_src_col(n0 + 31) : n0 + 31;
    if (c0 >= 0 && c31 == c0 + 31) {
        const int r8 = lane >> 3, c4 = (lane & 7) * 4;
        f32x4 v[8];
#pragma unroll
        for (int i = 0; i < 8; ++i) v[i] = *(const f32x4*)(W + (size_t)(k0 + 8 * i + r8) * Nsrc + c0 + c4);
#pragma unroll
        for (int i = 0; i < 8; ++i) { LAS float* d = scr + (8 * i + r8) * 33 + c4; d[0] = v[i].x; d[1] = v[i].y; d[2] = v[i].z; d[3] = v[i].w; }
    } else {
        const int nd = n0 + (lane & 31); const int sc = PERMUTE ? win_src_col(nd) : nd;
#pragma unroll 8
        for (int i = 0; i < 32; ++i) { const int kk = 2 * i + (lane >> 5); scr[kk * 33 + (lane & 31)] = sc >= 0 ? W[(size_t)(k0 + kk) * Nsrc + sc] : 0.f; }
    }
    LDS_WAIT(); asm volatile("" ::: "memory");
    const int c = lane & 7;
    f32x4 ga = {1.f, 1.f, 1.f, 1.f}, gb = {1.f, 1.f, 1.f, 1.f}; if (KGAIN) { ga = *(const f32x4*)(kg + k0 + 8 * c); gb = *(const f32x4*)(kg + k0 + 8 * c + 4); }
#pragma unroll
    for (int j = 0; j < 4; ++j) { const int n = (lane >> 3) + 8 * j; const LAS float* s = scr + (8 * c) * 33 + n;
        v4u o; o.x = pk2(s[0 * 33] * ga.x, s[1 * 33] * ga.y); o.y = pk2(s[2 * 33] * ga.z, s[3 * 33] * ga.w); o.z = pk2(s[4 * 33] * gb.x, s[5 * 33] * gb.y); o.w = pk2(s[6 * 33] * gb.z, s[7 * 33] * gb.w);
        *(GAS v4u*)(WT + (size_t)(n0 + n) * K + k0 + 8 * c) = o; }
    LDS_WAIT(); asm volatile("" ::: "memory");
}
__device__ __forceinline__ void rms_row_to_bf16(const float* xrow, const float* g, bf16* orow, int lane) {
    const GAS f32x4* xr = (const GAS f32x4*)xrow + lane; const GAS f32x4* gr = (const GAS f32x4*)g + lane;
    f32x4 v[4]; float s = 0.f;
#pragma unroll
    for (int j = 0; j < 4; ++j) { v[j] = xr[64 * j]; s += (v[j].x * v[j].x + v[j].y * v[j].y) + (v[j].z * v[j].z + v[j].w * v[j].w); }
    const float rstd = __builtin_amdgcn_rsqf(wave_sum(s) * (1.f / DM) + EPSN);
    GAS unsigned long long* o8 = (GAS unsigned long long*)orow + lane;
#pragma unroll
    for (int j = 0; j < 4; ++j) { const f32x4 gv = gr[64 * j];
        o8[64 * j] = (unsigned long long)pk2(v[j].x * rstd * gv.x, v[j].y * rstd * gv.y) | ((unsigned long long)pk2(v[j].z * rstd * gv.z, v[j].w * rstd * gv.w) << 32); }
}

__device__ __forceinline__ void rms_rows_to_bf16(const float* X, const float* g, bf16* O, int gw, int NGW, int lane) {
    const GAS f32x4* gr = (const GAS f32x4*)g + lane; f32x4 gv[4];
#pragma unroll
    for (int j = 0; j < 4; ++j) gv[j] = gr[64 * j];
    for (int m0 = gw; m0 < MROWS; m0 += 4 * NGW) {
        f32x4 v[4][4];
#pragma unroll
        for (int r = 0; r < 4; ++r) { const GAS f32x4* xr = (const GAS f32x4*)(X + (size_t)(m0 + r * NGW) * DM) + lane;
#pragma unroll
            for (int j = 0; j < 4; ++j) v[r][j] = xr[64 * j]; }
#pragma unroll
        for (int r = 0; r < 4; ++r) { float s = 0.f;
#pragma unroll
            for (int j = 0; j < 4; ++j) s += (v[r][j].x * v[r][j].x + v[r][j].y * v[r][j].y) + (v[r][j].z * v[r][j].z + v[r][j].w * v[r][j].w);
            const float rstd = __builtin_amdgcn_rsqf(wave_sum(s) * (1.f / DM) + EPSN);
            GAS unsigned long long* o8 = (GAS unsigned long long*)(O + (size_t)(m0 + r * NGW) * DM) + lane;
#pragma unroll
            for (int j = 0; j < 4; ++j) o8[64 * j] = (unsigned long long)pk2(v[r][j].x * rstd * gv[j].x, v[r][j].y * rstd * gv[j].y) | ((unsigned long long)pk2(v[r][j].z * rstd * gv[j].z, v[r][j].w * rstd * gv[j].w) << 32); }
    }
}

__device__ __forceinline__ void phase_p0(const Args& a, LAS unsigned char* lds, int gw, int NGW, int wave, int lane) {
    LAS float* scr = (LAS float*)(lds + wave * 16384);
    bf16* WinT = (bf16*)(a.ws + WS_WINT); bf16* WoT = (bf16*)(a.ws + WS_WOT); bf16* WuT = (bf16*)(a.ws + WS_WUT); bf16* WdT = (bf16*)(a.ws + WS_WDT);
    constexpr int I_IN = (N_INT / 32) * (DM / 64), I_O = (DM / 32) * (DM / 64), I_U = (DFF / 32) * (DM / 64), I_D = (DM / 32) * (DFF / 64);
    constexpr int NITEMS = I_IN + I_O + I_U + I_D;
    for (int it = gw; it < NITEMS; it += NGW) {
        int r = it;
        if (r < I_IN) { const int nb = r % (N_INT / 32), kb = r / (N_INT / 32); transpose_item<true>(a.w_in, DM, 8280, WinT, nb * 32, kb * 64, scr, lane); continue; } r -= I_IN;
        if (r < I_O) { const int nb = r % (DM / 32), kb = r / (DM / 32); transpose_item<false>(a.w_out, DM, DM, WoT, nb * 32, kb * 64, scr, lane); continue; } r -= I_O;
        if (r < I_U) { const int nb = r % (DFF / 32), kb = r / (DFF / 32); transpose_item<false, true>(a.w_up, DM, DFF, WuT, nb * 32, kb * 64, scr, lane, a.norm_mlp_g); continue; } r -= I_U;
        { const int nb = r % (DM / 32), kb = r / (DM / 32); transpose_item<false>(a.w_down, DFF, DM, WdT, nb * 32, kb * 64, scr, lane); }
    }
    float2* RI = (float2*)(a.ws + WS_ROPEI); float2* RA = (float2*)(a.ws + WS_ROPEA);
    for (int e = gw * 64 + lane; e < SEQ * 24; e += NGW * 64) {
        const int t = e / 24, j = e % 24; float inv, sn, cs;
        if (j < 8) { inv = powf(500000.0f, -(float)(2 * j) / 16.0f); const float ang = (float)t * inv; sincosf(ang, &sn, &cs); RI[t * 8 + j] = make_float2(cs, sn); }
        else { const int jj = j - 8; inv = powf(500000.0f, -(float)(2 * jj) / 32.0f); const float ang = (float)t * inv; sincosf(ang, &sn, &cs); RA[t * 16 + jj] = make_float2(cs, sn); }
    }
    bf16* H = (bf16*)a.out;
    rms_rows_to_bf16(a.x, a.norm_mix_g, H, gw, NGW, lane);
}

__device__ __forceinline__ void phase_p1b(const Args& a, int gw, int NGW, int lane) {
    const bf16* AKV = (const bf16*)(a.ws + WS_AKV); bf16* IK = (bf16*)(a.ws + WS_IK); bf16* IQ = (bf16*)(a.ws + WS_IQ); unsigned char* KV8 = a.ws + WS_KV8;
    const float2* RI = (const float2*)(a.ws + WS_ROPEI); const float2* RA = (const float2*)(a.ws + WS_ROPEA);
    const int sl = lane & 31; const f32x4 gk = *(const f32x4*)(a.k_norm_g + sl * 4);
    for (int m0 = gw; m0 < MROWS; m0 += 4 * NGW) {
        v2u ak[4], vv[4]; bf16 ik[4]; f32x4 c0[4], c1[4]; float2 ikc[4];
        const int mq = m0 + (lane >> 4) * NGW; bf16* iqp = IQ + (size_t)mq * 512 + ((lane >> 1) & 7) * 64 + (lane & 1) * 8;
        const v4u iqw = *(const v4u*)iqp; const f32x4* rq = (const f32x4*)(RI + (mq & (SEQ - 1)) * 8);
        const f32x4 q0 = rq[0], q1 = rq[1], q2 = rq[2], q3 = rq[3];
#pragma unroll
        for (int r = 0; r < 4; ++r) { const int m = m0 + r * NGW, t = m & (SEQ - 1);
            ak[r] = *(const v2u*)(AKV + (size_t)m * 512 + lane * 4); vv[r] = *(const v2u*)(AKV + (size_t)m * 512 + 256 + lane * 4); ik[r] = IK[(size_t)m * 64 + lane];
            const f32x4* rak = (const f32x4*)(RA + t * 16 + (lane & 3) * 4); c0[r] = rak[0]; c1[r] = rak[1]; ikc[r] = RI[t * 8 + (lane & 7)]; }
#pragma unroll
        for (int r = 0; r < 4; ++r) { const int m = m0 + r * NGW;
            {
                const v2u w = ak[r]; float y[4] = {bflo(w.x), bfhi(w.x), bflo(w.y), bfhi(w.y)};
                float ss = y[0] * y[0] + y[1] * y[1] + y[2] * y[2] + y[3] * y[3];
                ss = sum16(ss); ss += __shfl_xor(ss, 16);
                const float rstd = __builtin_amdgcn_rsqf(ss * (1.f / 128.f) + EPSN);
                y[0] *= rstd * gk.x; y[1] *= rstd * gk.y; y[2] *= rstd * gk.z; y[3] *= rstd * gk.w;
#pragma unroll
                for (int i = 0; i < 4; ++i) { const float o = dpp_xor4(y[i], lane); const f32x4 c4 = (i < 2) ? c0[r] : c1[r]; const float cs = (i & 1) ? c4.z : c4.x, sn = (i & 1) ? c4.w : c4.y;
                    if (sl < 4) y[i] = y[i] * cs - o * sn; else if (sl < 8) y[i] = y[i] * cs + o * sn; }
                int w8 = 0; w8 = __builtin_amdgcn_cvt_pk_fp8_f32(y[0] * 8.f, y[1] * 8.f, w8, false); w8 = __builtin_amdgcn_cvt_pk_fp8_f32(y[2] * 8.f, y[3] * 8.f, w8, true);
                *(int*)(KV8 + (size_t)m * 512 + lane * 4) = w8;
                const v2u v2 = vv[r];
                int v8 = 0; v8 = __builtin_amdgcn_cvt_pk_fp8_f32(bflo(v2.x) * 8.f, bfhi(v2.x) * 8.f, v8, false); v8 = __builtin_amdgcn_cvt_pk_fp8_f32(bflo(v2.y) * 8.f, bfhi(v2.y) * 8.f, v8, true);
                *(int*)(KV8 + (size_t)m * 512 + 256 + lane * 4) = v8;
            }
            if (r == 0) {
                float y[8] = {bflo(iqw.x), bfhi(iqw.x), bflo(iqw.y), bfhi(iqw.y), bflo(iqw.z), bfhi(iqw.z), bflo(iqw.w), bfhi(iqw.w)};
                const float cs[8] = {q0.x, q0.z, q1.x, q1.z, q2.x, q2.z, q3.x, q3.z}, sn[8] = {q0.y, q0.w, q1.y, q1.w, q2.y, q2.w, q3.y, q3.w};
                const bool hi = lane & 1;
#pragma unroll
                for (int j = 0; j < 8; ++j) { const float o = dpp_xor1(y[j]); y[j] = hi ? (y[j] * cs[j] + o * sn[j]) : (y[j] * cs[j] - o * sn[j]); }
                v4u o4; o4.x = pk2(y[0], y[1]); o4.y = pk2(y[2], y[3]); o4.z = pk2(y[4], y[5]); o4.w = pk2(y[6], y[7]); *(v4u*)iqp = o4;
            }
            {
                float y = bf2f(ik[r]); const float o = dpp_xor8(y); const float cs = ikc[r].x, sn = ikc[r].y;
                if (lane < 8) y = y * cs - o * sn; else if (lane < 16) y = y * cs + o * sn;
                IK[(size_t)m * 64 + lane] = (bf16)f2bf(y);
            }
        }
    }
}
typedef float f32x16 __attribute__((ext_vector_type(16)));
typedef short bf16x8 __attribute__((ext_vector_type(8)));
typedef float f32x2_ __attribute__((ext_vector_type(2)));
typedef __bf16 bf16x2_ __attribute__((ext_vector_type(2)));
__device__ __forceinline__ unsigned pkbf(float a, float b) { const f32x2_ v = {a, b}; return __builtin_bit_cast(unsigned, __builtin_convertvector(v, bf16x2_)); }
__device__ __forceinline__ int crow16(int reg, int h) { return (reg & 3) + 8 * (reg >> 2) + 4 * h; }
__device__ __forceinline__ int p16pos(int o) { return (o & ~12) | ((o & 4) << 1) | ((o & 8) >> 1); }
#define MFMA32(a, b, c) __builtin_amdgcn_mfma_f32_32x32x16_bf16((a), (b), (c), 0, 0, 0)
#define WG_BAR() do { asm volatile("s_waitcnt lgkmcnt(0)" ::: "memory"); __builtin_amdgcn_s_barrier(); asm volatile("" ::: "memory"); } while (0)

constexpr size_t WS_QKP = 458 * MiB;
constexpr size_t WS_GCUM = 490 * MiB;
constexpr size_t WS_RSTD = 491 * MiB;

__device__ __forceinline__ void phase_gdn_prep(const Args& a, LAS unsigned char* lds, int bx, int G, int tid, int wave, int lane) {
    bf16* QKV = (bf16*)(a.ws + WS_QKV); const bf16* HALO = (const bf16*)(a.ws + WS_HALO); const float* SM = (const float*)(a.ws + WS_SM);
    bf16* WGB = (bf16*)a.out + (size_t)MROWS * DM; bf16* QKP = (bf16*)(a.ws + WS_QKP); float* GCUM = (float*)(a.ws + WS_GCUM);
    const int half = tid >> 8, vw = wave & 3; const int lane0_ = lane;
    unsigned long long pacc[3] = {0ull, 0ull, 0ull}; (void)pacc;
    for (int it0 = 2 * bx; it0 < 4096; it0 += 2 * G) {
        const int item = it0 + half;
        int lane = lane0_; asm volatile("" : "+v"(lane));
        const int lr = lane & 31, lh = lane >> 5; const int vt = vw * 64 + lane;
#if (PROBE_TSA >= 20)
        const unsigned long long q0_ = __builtin_amdgcn_s_memrealtime();
#endif
        unsigned lbase = (unsigned)(size_t)lds + (unsigned)half * 81920u; asm volatile("" : "+v"(lbase));
        LAS unsigned char* ldsv = (LAS unsigned char*)(size_t)lbase;
        LAS unsigned char* KS = ldsv; LAS unsigned char* QS = ldsv + 17408; LAS unsigned char* VS = ldsv + 34816; LAS float* A32 = (LAS float*)(ldsv + 52224); LAS bf16* QKO = (LAS bf16*)(ldsv + 68608);
        LAS float* GC = (LAS float*)(ldsv + 76800); LAS float* BETA = GC + 64; LAS float* BETAW = GC + 128; LAS float* EQ = GC + 192; LAS float* EK = GC + 256;
        const int b = item >> 10, n = (item >> 3) & 127, h = item & 7; const int row0 = b * SEQ + n * 64; const int ch = (b * 8 + h) * 128 + n;
        float ga = 0.f, gb = 0.f, alog_ = 0.f, dtb_ = 0.f;
        if (vw == 0) { const size_t row = (size_t)row0 + lane; ga = SM[row * 32 + h]; gb = SM[row * 32 + 8 + h]; alog_ = a.a_log[h]; dtb_ = a.dt_bias[h]; }
        {
            const int grp = vt >> 4, c = vt & 15, p0 = grp * 4;
            v4u raw[3][7];
#pragma unroll
            for (int m = 0; m < 3; ++m) { const int col = m * 1024 + h * 128 + c * 8;
#pragma unroll
                for (int k = 0; k < 7; ++k) { const int r = p0 - 3 + k; v4u w = {0u, 0u, 0u, 0u};
                    if (r >= 0) w = *(const v4u*)(QKV + (size_t)(row0 + r) * 3072 + col);
                    else if (n > 0) w = *(const v4u*)(HALO + ((size_t)((row0 >> 6) - 1) * 3 + (r + 3)) * 3072 + col);
                    raw[m][k] = w; } }
            asm volatile("" ::: "memory");
            if (vw == 0) {
                const size_t row = (size_t)row0 + lane;
                float gg = -__expf(alog_) * softplusf_(ga + dtb_);
#pragma unroll
                for (int o = 1; o < 64; o <<= 1) { const float t = __shfl_up(gg, o); if (lane >= o) gg += t; }
                const float bt = sigm_(gb); const float eg = __expf(gg); const float glast = __shfl(gg, 63);
                GC[lane] = gg; BETA[lane] = bt; BETAW[lane] = bt * eg; EQ[lane] = eg; EK[lane] = __expf(glast - gg); GCUM[row * 8 + h] = gg;
            }
#pragma unroll
            for (int m = 0; m < 3; ++m) { f32x4 cwm[4][2]; { const int col = m * 1024 + h * 128 + c * 8;
#pragma unroll
                for (int j = 0; j < 4; ++j) { cwm[j][0] = *(const f32x4*)(a.conv_w + j * 3072 + col); cwm[j][1] = *(const f32x4*)(a.conv_w + j * 3072 + col + 4); } }
#pragma unroll
                for (int i = 0; i < 4; ++i) { const int p = p0 + i; float y[8];
#pragma unroll
                    for (int e = 0; e < 8; ++e) y[e] = 0.f;
#pragma unroll
                    for (int j = 0; j < 4; ++j) { const v4u w = raw[m][i + j]; const f32x4 c0 = cwm[j][0], c1 = cwm[j][1];
                        y[0] += c0.x * bflo(w.x); y[1] += c0.y * bfhi(w.x); y[2] += c0.z * bflo(w.y); y[3] += c0.w * bfhi(w.y);
                        y[4] += c1.x * bflo(w.z); y[5] += c1.y * bfhi(w.z); y[6] += c1.z * bflo(w.w); y[7] += c1.w * bfhi(w.w); }
#pragma unroll
                    for (int e = 0; e < 8; ++e) y[e] = siluf_(y[e]);
                    if (m < 2) { float ss = 0.f;
#pragma unroll
                        for (int e = 0; e < 8; ++e) ss += y[e] * y[e];
                        ss = sum16(ss);
                        float sc = __builtin_amdgcn_rsqf(ss + EPSN); if (m == 0) sc *= 0.08838834764831845f;
#pragma unroll
                        for (int e = 0; e < 8; ++e) y[e] *= sc; }
                    v4u o; o.x = pkbf(y[0], y[1]); o.y = pkbf(y[2], y[3]); o.z = pkbf(y[4], y[5]); o.w = pkbf(y[6], y[7]);
                    *(LAS v4u*)((m == 0 ? QS : m == 1 ? KS : VS) + p * 272 + c * 16) = o; }
                asm volatile("" ::: "memory"); }
        }
        __syncthreads();
#if (PROBE_TSA >= 20)
        const unsigned long long q1_ = __builtin_amdgcn_s_memrealtime();
#endif
        {
            const int c = vt & 15, pp = vt >> 4; const int g16 = c >> 1, oo = (c & 1) * 4;
#pragma unroll
            for (int pass = 0; pass < 4; ++pass) { const int p = pp + 16 * pass; const float eq = EQ[p]; bf16* rp = QKV + (size_t)(row0 + p) * 3072 + h * 128 + g16 * 16 + oo;
                const v4u q8 = *(const LAS v4u*)(QS + p * 272 + c * 16);
                *(v2u*)rp = (v2u){pkbf(bflo(q8.x) * eq, bfhi(q8.x) * eq), pkbf(bflo(q8.y) * eq, bfhi(q8.y) * eq)}; *(v2u*)(rp + 8) = (v2u){pkbf(bflo(q8.z) * eq, bfhi(q8.z) * eq), pkbf(bflo(q8.w) * eq, bfhi(q8.w) * eq)}; }
            const int dk = vt & 127;
#pragma unroll
            for (int pg2 = 0; pg2 < 2; ++pg2) { const int pg = 2 * (vt >> 7) + pg2;
                float kv[16];
#pragma unroll
                for (int i = 0; i < 16; ++i) kv[i] = bf2f(*(const LAS bf16*)(KS + (16 * pg + i) * 272 + dk * 2)) * EK[16 * pg + i];
                v4u o0, o1; o0.x = pkbf(kv[0], kv[1]); o0.y = pkbf(kv[2], kv[3]); o0.z = pkbf(kv[8], kv[9]); o0.w = pkbf(kv[10], kv[11]); o1.x = pkbf(kv[4], kv[5]); o1.y = pkbf(kv[6], kv[7]); o1.z = pkbf(kv[12], kv[13]); o1.w = pkbf(kv[14], kv[15]);
                bf16* kp = QKV + (size_t)(row0 + (dk >> 1)) * 3072 + 1024 + h * 128 + (dk & 1) * 64 + pg * 16;
                *(v4u*)kp = o0; *(v4u*)(kp + 8) = o1; }
        }
        {
            const int ti = (vw == 0 || vw == 2) ? 1 : 0, tj = (vw == 2) ? 1 : (vw == 3 ? 1 : 0);
            int vz2; asm volatile("v_mov_b32 %0, 0" : "=v"(vz2));
            LAS float* A32w = A32 + vz2; LAS bf16* QKOw = QKO + vz2; const LAS float* GCr = GC + vz2; const LAS float* BETAr = BETA + vz2;
            const int col = 32 * tj + lr; const float gcol = GCr[col]; const int pc = p16pos(col);
#pragma unroll
            for (int isqk = 0; isqk < 2; ++isqk) {
                f32x16 acc;
#pragma unroll
                for (int i = 0; i < 16; ++i) acc[i] = 0.f;
                if (vw != 3) { const LAS unsigned char* XS = isqk ? QS : KS;
#pragma unroll
                    for (int s = 0; s < 8; ++s) { const bf16x8 av = *(const LAS bf16x8*)(XS + (32 * ti + lr) * 272 + (16 * s + 8 * lh) * 2); const bf16x8 bv = *(const LAS bf16x8*)(KS + (32 * tj + lr) * 272 + (16 * s + 8 * lh) * 2);
                        acc = MFMA32(av, bv, acc); } }
                if (!isqk) {
#pragma unroll
                    for (int i = 0; i < 16; ++i) { const int row = 32 * ti + crow16(i, lh); const float dec = __expf(fminf(GCr[row] - gcol, 0.f)); const float v_ = acc[i] * BETAr[row] * dec;
                        A32w[row * 64 + col] = (row > col) ? v_ : 0.f; }
                } else {
#pragma unroll
                    for (int i = 0; i < 16; ++i) { const int row = 32 * ti + crow16(i, lh); const float dec = __expf(fminf(GCr[row] - gcol, 0.f)); const unsigned v_ = pkbf(acc[i] * dec, 0.f) & 0xffffu;
                        QKOw[row * 64 + pc] = (bf16)((row >= col) ? v_ : 0u); }
                }
            }
        }
        __syncthreads();
#if (PROBE_TSA >= 20)
        const unsigned long long q2_ = __builtin_amdgcn_s_memrealtime();
#endif
        if (vw < 2) {
            int vz; asm volatile("v_mov_b32 %0, 0" : "=v"(vz));
            const LAS float* A32v = A32 + vz; const bool isw = vw == 1; const LAS float* BMv = (isw ? BETAW : BETA) + vz;
            const LAS unsigned char* R = (isw ? KS : VS) + lane * 2;
            f32x2_ t[64];
#pragma unroll
            for (int i = 0; i < 64; ++i) t[i] = (f32x2_){0.f, 0.f};
#pragma unroll
            for (int i = 0; i < 64; ++i) {
                const float bm = BMv[i]; const f32x2_ rhs = {bf2f(*(const LAS bf16*)(R + i * 272)) * bm, bf2f(*(const LAS bf16*)(R + i * 272 + 128)) * bm};
                f32x2_ a0 = rhs, a1 = {0.f, 0.f}, a2 = {0.f, 0.f}, a3 = {0.f, 0.f};
#pragma unroll
                for (int j = 0; j < ((i + 3) & ~3); j += 4) { const f32x4 av = *(const LAS f32x4*)(A32v + i * 64 + j);
                    a0 -= (f32x2_){av.x, av.x} * t[j]; a1 -= (f32x2_){av.y, av.y} * t[j + 1]; a2 -= (f32x2_){av.z, av.z} * t[j + 2]; a3 -= (f32x2_){av.w, av.w} * t[j + 3]; }
                t[i] = (a0 + a1) + (a2 + a3);
                asm volatile("" ::: "memory");
            }
            if (!isw) { bf16* sp_ = QKV + (size_t)row0 * 3072 + 2048 + h * 128 + lane;
#pragma unroll
                for (int i = 0; i < 64; ++i) { sp_[0] = (bf16)(pkbf(t[i].x, 0.f) & 0xffffu); sp_[64] = (bf16)(pkbf(t[i].y, 0.f) & 0xffffu); sp_ += 3072; asm volatile("" : "+v"(sp_)); } }
            else { int wc0 = p16pos(lane), wc1 = p16pos(lane + 64); asm volatile("" : "+v"(wc0), "+v"(wc1)); bf16* sp_ = WGB + (size_t)row0 * 1024 + h * 128;
#pragma unroll
                for (int i = 0; i < 64; ++i) { sp_[wc0] = (bf16)(pkbf(t[i].x, 0.f) & 0xffffu); sp_[wc1] = (bf16)(pkbf(t[i].y, 0.f) & 0xffffu); sp_ += 1024; asm volatile("" : "+v"(sp_)); } }
        } else {
            const int ct = vt - 128; const LAS v4u* src = (const LAS v4u*)QKO; v4u* dst = (v4u*)(QKP + (size_t)ch * 4096);
#pragma unroll
            for (int i = 0; i < 4; ++i) dst[ct + 128 * i] = src[ct + 128 * i];
        }
        __syncthreads();
#if (PROBE_TSA >= 20)
        { const unsigned long long q3_ = __builtin_amdgcn_s_memrealtime(); pacc[0] += q1_ - q0_; pacc[1] += q2_ - q1_; pacc[2] += q3_ - q2_; }
#endif
    }
#if (PROBE_TSA >= 20)
    if (blockIdx.x == 0 && tid == 0) { unsigned long long* T_ = (unsigned long long*)(a.ws + WS_CTL + 65536); T_[30] = 0ull; T_[31] = pacc[0]; T_[32] = pacc[1]; T_[33] = pacc[2]; }
#endif
}
constexpr int SC_WL = 0, SC_QL = 17408, SC_KTL = 34816, SC_QKL = 53248, SC_UL = 62464, SC_BUF = 78848, SC_MISC = 2 * SC_BUF;
#ifndef PROBE_TSA
#define PROBE_TSA -1
#endif
#if (PROBE_TSA >= 20)
#define SCAN_BAR(acc_) do { const unsigned long long t0_ = __builtin_amdgcn_s_memrealtime(); WG_BAR(); acc_ += __builtin_amdgcn_s_memrealtime() - t0_; } while (0)
#else
#define SCAN_BAR(acc_) WG_BAR()
#endif
__device__ __forceinline__ void phase_scan(const Args& a, LAS unsigned char* lds, int bh, int tid, int wave, int lane) {
    unsigned long long wacc = 0ull; unsigned long long pacc[3] = {0ull, 0ull, 0ull}; (void)pacc;
    bf16* QKV = (bf16*)(a.ws + WS_QKV); const bf16* WGB = (const bf16*)a.out + (size_t)MROWS * DM; const bf16* QKP = (const bf16*)(a.ws + WS_QKP);
    const float* GCUM = (const float*)(a.ws + WS_GCUM); float* RSTD = (float*)(a.ws + WS_RSTD);
    const int b = bh >> 3, h = bh & 7; const int lr = lane & 31, lh = lane >> 5;
    LAS float* GLs = (LAS float*)(lds + SC_MISC);
    if (wave < 4) {
        const int jb = wave;
        f32x16 Sacc[4]; bf16x8 Sf[4][2];
#pragma unroll
        for (int r = 0; r < 4; ++r) {
#pragma unroll
            for (int i = 0; i < 16; ++i) Sacc[r][i] = 0.f;
#pragma unroll
            for (int s = 0; s < 2; ++s)
#pragma unroll
                for (int e = 0; e < 8; ++e) Sf[r][s][e] = 0; }
        WG_BAR();
        LAS unsigned* pfbin = (LAS unsigned*)(lds + SC_MISC + 64 + wave * 256);
        for (int n = 0; n < 128; ++n) {
            LAS unsigned char* B = lds + (n & 1) * SC_BUF;
            bf16x8 fa[2][8];
#pragma unroll
            for (int rt = 0; rt < 2; ++rt)
#pragma unroll
                for (int ks = 0; ks < 8; ++ks) fa[rt][ks] = *(const LAS bf16x8*)(B + SC_WL + (32 * rt + lr) * 272 + ks * 32 + lh * 16);
            float uu[2][16];
#pragma unroll
            for (int rt = 0; rt < 2; ++rt)
#pragma unroll
                for (int i = 0; i < 16; ++i) uu[rt][i] = bf2f(*(const LAS bf16*)(B + SC_UL + (32 * rt + crow16(i, lh)) * 256 + (32 * jb + lr) * 2));
            asm volatile("" ::: "memory");
            f32x16 ws_[2];
#pragma unroll
            for (int rt = 0; rt < 2; ++rt) {
#pragma unroll
                for (int i = 0; i < 16; ++i) ws_[rt][i] = 0.f; }
#pragma unroll
            for (int ks = 0; ks < 8; ++ks) {
#pragma unroll
                for (int rt = 0; rt < 2; ++rt) ws_[rt] = MFMA32(fa[rt][ks], Sf[ks >> 1][ks & 1], ws_[rt]); }
            bf16x8 fk[4][4];
#pragma unroll
            for (int r = 0; r < 4; ++r)
#pragma unroll
                for (int ks = 0; ks < 4; ++ks) fk[r][ks] = *(const LAS bf16x8*)(B + SC_KTL + (32 * r + lr) * 144 + ks * 32 + lh * 16);
            const float gl = GLs[n & 1];
            asm volatile("" ::: "memory");
            bf16x8 vf[2][2];
#pragma unroll
            for (int rt = 0; rt < 2; ++rt) {
                float vn[16];
#pragma unroll
                for (int i = 0; i < 16; ++i) vn[i] = uu[rt][i] - ws_[rt][i];
#pragma unroll
                for (int s = 0; s < 2; ++s) { v4u p; p.x = pkbf(vn[8 * s], vn[8 * s + 1]); p.y = pkbf(vn[8 * s + 2], vn[8 * s + 3]); p.z = pkbf(vn[8 * s + 4], vn[8 * s + 5]); p.w = pkbf(vn[8 * s + 6], vn[8 * s + 7]);
                    vf[rt][s] = __builtin_bit_cast(bf16x8, p); } }
#pragma unroll
            for (int rt = 0; rt < 2; ++rt) {
                bf16x8 fq[8], fm[4];
#pragma unroll
                for (int ks = 0; ks < 8; ++ks) fq[ks] = *(const LAS bf16x8*)(B + SC_QL + (32 * rt + lr) * 272 + ks * 32 + lh * 16);
#pragma unroll
                for (int js = 0; js < 2 * (rt + 1); ++js) fm[js] = *(const LAS bf16x8*)(B + SC_QKL + (32 * rt + lr) * 144 + js * 32 + lh * 16);
                asm volatile("" ::: "memory");
                f32x16 qs_;
#pragma unroll
                for (int i = 0; i < 16; ++i) qs_[i] = 0.f;
#pragma unroll
                for (int ks = 0; ks < 8; ++ks) qs_ = MFMA32(fq[ks], Sf[ks >> 1][ks & 1], qs_);
#pragma unroll
                for (int js = 0; js < 2 * (rt + 1); ++js) qs_ = MFMA32(fm[js], vf[js >> 1][js & 1], qs_);
#pragma unroll
                for (int i = 0; i < 16; ++i) { const int row = 32 * rt + crow16(i, lh); *(LAS bf16*)(B + SC_UL + row * 256 + (32 * jb + lr) * 2) = (bf16)(pkbf(qs_[i], 0.f) & 0xffffu); }
            }
#pragma unroll
            for (int r = 0; r < 4; ++r) {
#pragma unroll
                for (int i = 0; i < 16; ++i) Sacc[r][i] *= gl;
#pragma unroll
                for (int ks = 0; ks < 4; ++ks) Sacc[r] = MFMA32(fk[r][ks], vf[ks >> 1][ks & 1], Sacc[r]); }
#pragma unroll
            for (int r = 0; r < 4; ++r)
#pragma unroll
                for (int s = 0; s < 2; ++s) { v4u p; p.x = pkbf(Sacc[r][8 * s], Sacc[r][8 * s + 1]); p.y = pkbf(Sacc[r][8 * s + 2], Sacc[r][8 * s + 3]); p.z = pkbf(Sacc[r][8 * s + 4], Sacc[r][8 * s + 5]); p.w = pkbf(Sacc[r][8 * s + 6], Sacc[r][8 * s + 7]);
                    Sf[r][s] = __builtin_bit_cast(bf16x8, p); }
            SCAN_BAR(wacc);
        }
#if (PROBE_TSA >= 20)
        if (blockIdx.x == 0 && tid == 0) { ((unsigned long long*)(a.ws + WS_CTL + 65536))[20] = 0ull; ((unsigned long long*)(a.ws + WS_CTL + 65536))[21] = wacc; }
#endif
    } else {
        const int lt = tid - 256; const int up = lt >> 2, uq = lt & 3;
        v4u rw[4], rq[4], rk[4], ru[4], rm[2]; float glast = 0.f;
        auto issue = [&](int m) {
            const size_t row0 = (size_t)b * SEQ + (size_t)m * 64; const size_t ch = (size_t)bh * 128 + m;
#pragma unroll
            for (int i = 0; i < 4; ++i) { const int idx = lt + 256 * i, p = idx >> 4, c = idx & 15;
                rw[i] = *(const v4u*)(WGB + (row0 + p) * 1024 + h * 128 + c * 8);
                rq[i] = *(const v4u*)(QKV + (row0 + p) * 3072 + h * 128 + c * 8);
                rk[i] = *(const v4u*)(QKV + (row0 + p) * 3072 + 1024 + h * 128 + c * 8);
                ru[i] = *(const v4u*)(QKV + (row0 + up) * 3072 + 2048 + h * 128 + uq * 32 + i * 8);
                }
#pragma unroll
            for (int i = 0; i < 2; ++i) rm[i] = *(const v4u*)(QKP + ch * 4096 + (size_t)(lt + 256 * i) * 8);
            glast = GCUM[(row0 + 63) * 8 + h];
        };
        auto stage = [&](int bb) {
            LAS unsigned char* B = lds + bb * SC_BUF;
#pragma unroll
            for (int i = 0; i < 4; ++i) { const int idx = lt + 256 * i, p = idx >> 4, c = idx & 15;
                *(LAS v4u*)(B + SC_WL + p * 272 + c * 16) = rw[i];
                *(LAS v4u*)(B + SC_QL + p * 272 + c * 16) = rq[i];
                *(LAS v4u*)(B + SC_KTL + (2 * p + (c >> 3)) * 144 + (c & 7) * 16) = rk[i];
                *(LAS v4u*)(B + SC_UL + up * 256 + (uq * 32 + i * 8) * 2) = ru[i]; }
#pragma unroll
            for (int i = 0; i < 2; ++i) { const int idx = lt + 256 * i; *(LAS v4u*)(B + SC_QKL + (idx >> 3) * 144 + (idx & 7) * 16) = rm[i]; }
            if (lt == 0) GLs[bb] = __expf(glast);
        };
        auto finish = [&](int m, int bb, bool do_store) {
            const LAS unsigned char* B = lds + bb * SC_BUF; float ss = 0.f; v4u w[4];
#pragma unroll
            for (int i = 0; i < 4; ++i) { w[i] = *(const LAS v4u*)(B + SC_UL + up * 256 + (uq * 32 + i * 8) * 2);
                const float o0 = bflo(w[i].x), o1 = bfhi(w[i].x), o2 = bflo(w[i].y), o3 = bfhi(w[i].y), o4 = bflo(w[i].z), o5 = bfhi(w[i].z), o6 = bflo(w[i].w), o7 = bfhi(w[i].w);
                ss += (o0 * o0 + o1 * o1) + (o2 * o2 + o3 * o3) + (o4 * o4 + o5 * o5) + (o6 * o6 + o7 * o7); }
            ss += __shfl_xor(ss, 1); ss += __shfl_xor(ss, 2);
            const size_t row = (size_t)b * SEQ + (size_t)m * 64 + up;
            if (do_store) { bf16* op = QKV + row * 3072 + h * 128 + uq * 32;
#pragma unroll
                for (int i = 0; i < 4; ++i) *(v4u*)(op + i * 8) = w[i];
                if (uq == 0) RSTD[row * 8 + h] = __builtin_amdgcn_rsqf(ss * (1.f / 128.f) + EPSN); }
        };
        issue(0); stage(0); issue(1);
        WG_BAR();
        for (int n = 0; n < 128; ++n) {
#if (PROBE_TSA >= 20)
            const unsigned long long q0_ = __builtin_amdgcn_s_memrealtime();
#endif
            finish(n - 1, (n - 1) & 1, n >= 1);
            asm volatile("" ::: "memory");
#if (PROBE_TSA >= 20)
            asm volatile("s_waitcnt lgkmcnt(0)" ::: "memory"); const unsigned long long q1_ = __builtin_amdgcn_s_memrealtime();
#endif
            stage((n + 1) & 1);
            asm volatile("" ::: "memory");
#if (PROBE_TSA >= 20)
            asm volatile("s_waitcnt lgkmcnt(0)" ::: "memory"); const unsigned long long q2_ = __builtin_amdgcn_s_memrealtime();
#endif
            issue(n + 2 < 128 ? n + 2 : 127);
#if (PROBE_TSA >= 20)
            const unsigned long long q3_ = __builtin_amdgcn_s_memrealtime(); pacc[0] += q1_ - q0_; pacc[1] += q2_ - q1_; pacc[2] += q3_ - q2_;
#endif
            SCAN_BAR(wacc);
        }
#if (PROBE_TSA >= 20)
        if (blockIdx.x == 0 && tid == 256) { unsigned long long* T_ = (unsigned long long*)(a.ws + WS_CTL + 65536); T_[22] = 0ull; T_[23] = wacc; T_[24] = pacc[0]; T_[25] = pacc[1]; T_[26] = pacc[2]; }
#endif
        finish(127, 1, true);
    }
}
constexpr int TK_CAP = 832, TK_SMCAP = 128;
constexpr int TKL_CAND = 0, TKL_SEL = 106496, TKL_META = 139264, TKL_WL = 140288, TKL_QSLOT = 140800, TKL_OUT = 141312, TKL_SM = 149504;
__device__ __forceinline__ float relu_bits(float x) { const int b = __builtin_bit_cast(int, x); return __builtin_bit_cast(float, b > 0 ? b : 0); }
__device__ __forceinline__ int tk_bin(unsigned u) { const int t = (int)((u & 0x7fffffffu) >> 17) - 7232; const int mag = min(max(t, 0), 2047); return (u & 0x80000000u) ? 2047 - mag : 2048 + mag; }
__device__ __forceinline__ int tk_bin_of_key(unsigned key) { const unsigned u = (key & 0x80000000u) ? (key & 0x7fffffffu) : ~key; return tk_bin(u); }
template <int WPL>
__device__ __forceinline__ void tk_threshold(const LAS unsigned* hq, int lane, unsigned target, unsigned& thr_o, unsigned& nab_o) {
    const LAS unsigned* hp = hq + WPL * lane; unsigned own = 0u;
#pragma unroll
    for (int w4 = 0; w4 < WPL / 4; ++w4) { const v4u x = *(const LAS v4u*)(hp + 4 * w4); own += (x.x & 0xffffu) + (x.x >> 16) + (x.y & 0xffffu) + (x.y >> 16) + (x.z & 0xffffu) + (x.z >> 16) + (x.w & 0xffffu) + (x.w >> 16); }
    unsigned v = own;
#pragma unroll
    for (int o = 1; o < 64; o <<= 1) { const unsigned tt = __shfl_down(v, o); if (lane + o < 64) v += tt; }
    const unsigned long long mk = __ballot(v >= target); const int L = mk ? 63 - __builtin_clzll(mk) : 0;
    unsigned thr = 0u, nab = v;
    if (lane == L && mk) { unsigned cum = v - own; bool found = false;
        for (int w = WPL - 1; w >= 0 && !found; --w) { const unsigned x = hp[w]; const unsigned hi = x >> 16, lo = x & 0xffffu;
            if (cum + hi >= target) { thr = 2 * WPL * L + 2 * w + 1; nab = cum; found = true; }
            else { cum += hi; if (cum + lo >= target) { thr = 2 * WPL * L + 2 * w; nab = cum; found = true; } else cum += lo; } } }
    thr_o = __shfl(thr, L); nab_o = __shfl(nab, L);
}
__device__ __forceinline__ void phase_topk(const Args& a, LAS unsigned char* lds, int bx, int G, int tid, int wave, int lane) {
    const bf16* IQ = (const bf16*)(a.ws + WS_IQ); const bf16* IK = (const bf16*)(a.ws + WS_IK); const float* SM = (const float*)(a.ws + WS_SM); unsigned short* TOPK = (unsigned short*)(a.ws + WS_TOPK);
    LAS unsigned* HIST = (LAS unsigned*)lds; LAS unsigned long long* CAND = (LAS unsigned long long*)(lds + TKL_CAND); LAS unsigned* SELw = (LAS unsigned*)(lds + TKL_SEL + wave * 4096);
    LAS unsigned* META = (LAS unsigned*)(lds + TKL_META);
    LAS float* WL = (LAS float*)(lds + TKL_WL); LAS unsigned* QSLOT = (LAS unsigned*)(lds + TKL_QSLOT); LAS unsigned short* OUT = (LAS unsigned short*)(lds + TKL_OUT);
    LAS unsigned long long* SMw = (LAS unsigned long long*)(lds + TKL_SM + wave * 1024);
    unsigned* TKQ = (unsigned*)(a.ws + WS_CTL) + 9216;
    const int lr = lane & 31, lh = lane >> 5;
    for (;;) {
        if (tid == 0) QSLOT[0] = __hip_atomic_fetch_add(TKQ, 1u, __ATOMIC_RELAXED, __HIP_MEMORY_SCOPE_AGENT);
        __syncthreads();
        const int it = (int)QSLOT[0];
        __syncthreads();
        if (it >= 2048) break;
        const int qb = 511 - (it >> 2), b = it & 3; const int t0 = qb * 16; const size_t rowq0 = (size_t)b * SEQ + t0;
        if (t0 < 256) { for (int e = tid; e < 4096; e += 512) { const int q = e >> 8, j = e & 255; TOPK[(rowq0 + q) * 256 + j] = (j <= t0 + q) ? (unsigned short)j : (unsigned short)0xFFFF; } continue; }
        bf16x8 af[4][4];
        { const int hA = (lr & 3) | (((lr >> 3) & 1) << 2), tqA = ((lr >> 2) & 1) | (((lr >> 4) & 1) << 1);
#pragma unroll
          for (int rt = 0; rt < 4; ++rt)
#pragma unroll
            for (int ks = 0; ks < 4; ++ks) af[rt][ks] = *(const bf16x8*)(IQ + (rowq0 + rt * 4 + tqA) * 512 + hA * 64 + 16 * ks + 8 * lh);
          if (tid < 128) WL[tid] = SM[(rowq0 + (tid >> 3)) * 32 + 16 + (tid & 7)] * (0.35355339059327373f * 0.125f); }
        const int nt = (t0 + 15) / 32 + 1;
        int S = nt >= 128 ? 8 : nt >= 64 ? 4 : nt >= 32 ? 2 : 1;
#pragma unroll 1
        for (int attempt = 0; attempt < 2; ++attempt) {
            if (attempt) S = 1;
            const unsigned mtarget = S == 8 ? 58u : S == 4 ? 100u : S == 2 ? 170u : 256u;
            for (int e = tid; e < 8192; e += 512) ((LAS v4u*)HIST)[e] = (v4u){0u, 0u, 0u, 0u};
            if (tid < 80) META[tid] = 0u;
            __syncthreads();
#define RELU_(x) relu_bits((float)(x))
#define TK_MFMA4(ACC, RT, B) do { _Pragma("unroll") for (int i_ = 0; i_ < 16; ++i_) ACC[i_] = 0.f; _Pragma("unroll") for (int ks_ = 0; ks_ < 4; ++ks_) ACC = MFMA32(af[RT][ks_], B[ks_], ACC); } while (0)
#define TK_SCORE(ACC, RT, S_) do { \
        const LAS f32x4* wa_ = (const LAS f32x4*)(WL + ((RT) * 4 + lh) * 8); const f32x4 w0 = wa_[0], w1 = wa_[1], w2 = wa_[4], w3 = wa_[5]; \
        float sa = w0.x * RELU_(ACC[0]); sa = fmaf(w0.y, RELU_(ACC[1]), sa); sa = fmaf(w0.z, RELU_(ACC[2]), sa); sa = fmaf(w0.w, RELU_(ACC[3]), sa); \
        sa = fmaf(w1.x, RELU_(ACC[4]), sa); sa = fmaf(w1.y, RELU_(ACC[5]), sa); sa = fmaf(w1.z, RELU_(ACC[6]), sa); sa = fmaf(w1.w, RELU_(ACC[7]), sa); \
        float sb = w2.x * RELU_(ACC[8]); sb = fmaf(w2.y, RELU_(ACC[9]), sb); sb = fmaf(w2.z, RELU_(ACC[10]), sb); sb = fmaf(w2.w, RELU_(ACC[11]), sb); \
        sb = fmaf(w3.x, RELU_(ACC[12]), sb); sb = fmaf(w3.y, RELU_(ACC[13]), sb); sb = fmaf(w3.z, RELU_(ACC[14]), sb); sb = fmaf(w3.w, RELU_(ACC[15]), sb); \
        _Pragma("unroll") for (int hsel = 0; hsel < 2; ++hsel) { const int q = (RT) * 4 + lh + 2 * hsel; float sc = hsel ? sb : sa; if (sc == 0.f) sc = 0.f; \
            const bool valid = (S_) <= t0 + q; const unsigned u = __builtin_bit_cast(unsigned, sc); const int bin = tk_bin(u); \
            if (pass == 0) { if (valid) atomicAdd((unsigned*)&HIST[q * 2048 + (bin >> 1)], (bin & 1) ? 65536u : 1u); } \
            else if (valid && bin >= thrv[RT][hsel]) { const unsigned pos = atomicAdd((unsigned*)&META[48 + q], 1u); \
                if (pos < (unsigned)TK_CAP) { const unsigned key = (u & 0x80000000u) ? ~u : (u | 0x80000000u); CAND[q * TK_CAP + pos] = ((unsigned long long)key << 32) | (unsigned long long)(65535 - (S_)); } } } \
    } while (0)
#define TK_TILE(B, KT) do { const int s_ = (KT) * 32 + lr; f32x16 accA, accB; \
        TK_MFMA4(accA, 0, B); TK_MFMA4(accB, 1, B); TK_SCORE(accA, 0, s_); TK_MFMA4(accA, 2, B); TK_SCORE(accB, 1, s_); TK_MFMA4(accB, 3, B); TK_SCORE(accA, 2, s_); TK_SCORE(accB, 3, s_); } while (0)
#define TK_LOADB(B, KT) do { const int kc_ = min((KT), nt - 1); const bf16* kp_ = IK + ((size_t)b * SEQ + kc_ * 32 + lr) * 64 + 8 * lh; _Pragma("unroll") for (int ks_ = 0; ks_ < 4; ++ks_) B[ks_] = *(const bf16x8*)(kp_ + 16 * ks_); } while (0)
#pragma unroll 1
            for (int pass = 0; pass < 2; ++pass) {
                const int step = (pass == 0) ? 8 * S : 8;
                int thrv[4][2];
#pragma unroll
                for (int rt = 0; rt < 4; ++rt) { thrv[rt][0] = (int)META[rt * 4 + lh]; thrv[rt][1] = (int)META[rt * 4 + lh + 2]; }
                bf16x8 bA[4], bB[4];
                TK_LOADB(bA, wave);
                for (int kt = wave; kt < nt; kt += 2 * step) {
                    TK_LOADB(bB, kt + step);
                    TK_TILE(bA, kt);
                    if (kt + step < nt) { TK_LOADB(bA, kt + 2 * step); TK_TILE(bB, kt + step); }
                }
                __syncthreads();
                if (pass == 0) {
                    unsigned thr_[2], nab_[2];
#pragma unroll 1
                    for (int qq = 0; qq < 2; ++qq) tk_threshold<32>(HIST + (wave * 2 + qq) * 2048, lane, mtarget, thr_[qq], nab_[qq]);
                    __syncthreads();
                    if (lane == 0) { META[wave * 2] = thr_[0]; META[wave * 2 + 1] = thr_[1]; }
                    __syncthreads();
                }
            }
#undef TK_TILE
#undef TK_SCORE
#undef TK_MFMA4
#undef TK_LOADB
#pragma unroll 1
            for (int qq = 0; qq < 2; ++qq) { const int q = wave * 2 + qq; const unsigned cnt_raw = META[48 + q]; const int cnt = (int)min(cnt_raw, (unsigned)TK_CAP);
                if (cnt_raw < 256u || cnt_raw > (unsigned)TK_CAP) { if (lane == 0) META[64] = 1u; if (attempt == 0) continue; }
                const LAS unsigned long long* cp = CAND + q * TK_CAP;
                { v4u z = {0u, 0u, 0u, 0u}; LAS v4u* sp = (LAS v4u*)SELw + 4 * lane; sp[0] = z; sp[1] = z; sp[2] = z; sp[3] = z; }
                for (int i = lane; i < cnt; i += 64) { const int b11 = tk_bin_of_key((unsigned)(cp[i] >> 32)) >> 1; atomicAdd((unsigned*)&SELw[b11 >> 1], (b11 & 1) ? 65536u : 1u); }
                unsigned thr11, nab; tk_threshold<16>(SELw, lane, 256u, thr11, nab);
                const int need = 256 - (int)nab; unsigned obase = 0u, ebase = 0u;
                for (int i0 = 0; i0 < cnt; i0 += 64) { const int i = i0 + lane; const bool in = i < cnt; const unsigned long long c = in ? cp[i] : 0ull; const int b11 = tk_bin_of_key((unsigned)(c >> 32)) >> 1;
                    const bool above = in && b11 > (int)thr11, eq = in && b11 == (int)thr11;
                    const unsigned long long ma = __ballot(above), me = __ballot(eq);
                    const unsigned pa = obase + __builtin_amdgcn_mbcnt_hi((unsigned)(ma >> 32), __builtin_amdgcn_mbcnt_lo((unsigned)ma, 0u));
                    const unsigned pe = ebase + __builtin_amdgcn_mbcnt_hi((unsigned)(me >> 32), __builtin_amdgcn_mbcnt_lo((unsigned)me, 0u));
                    if (above && pa < 256u) OUT[q * 256 + pa] = (unsigned short)(65535 - (int)(c & 0xffffu));
                    if (eq && pe < (unsigned)TK_SMCAP) SMw[pe] = c;
                    obase += (unsigned)__builtin_popcountll(ma); ebase += (unsigned)__builtin_popcountll(me); }
                if (ebase <= (unsigned)TK_SMCAP) { const int ce = (int)ebase;
                    for (int i = lane; i < ce; i += 64) { const unsigned long long ci = SMw[i]; int rank = 0;
                        for (int j = 0; j < ce; ++j) rank += (SMw[j] > ci) ? 1 : 0;
                        if (rank < need) OUT[q * 256 + nab + rank] = (unsigned short)(65535 - (int)(ci & 0xffffu)); }
                } else {
                    for (int i0 = 0; i0 < cnt; i0 += 64) { const int i = i0 + lane; const unsigned long long ci = i < cnt ? cp[i] : 0ull; const bool eq = i < cnt && (tk_bin_of_key((unsigned)(ci >> 32)) >> 1) == (int)thr11; int rank = 0;
                        for (int j = 0; j < cnt; ++j) { const unsigned long long cj = cp[j]; rank += ((tk_bin_of_key((unsigned)(cj >> 32)) >> 1) == (int)thr11 && cj > ci) ? 1 : 0; }
                        if (eq && rank < need) OUT[q * 256 + nab + rank] = (unsigned short)(65535 - (int)(ci & 0xffffu)); } }
            }
            __syncthreads();
            const bool retry = META[64] != 0u;
            __syncthreads();
            if (!retry) break;
        }
        ((v4u*)(TOPK + rowq0 * 256))[tid] = ((const LAS v4u*)OUT)[tid];
        __syncthreads();
    }
}
typedef float f32x4_ __attribute__((ext_vector_type(4)));
constexpr int CW_ATTNQ = 8192;
template <int AB>
__device__ __forceinline__ void attn_chunk(bf16* AQ, unsigned char* KV8, const unsigned short* TOPK, LAS unsigned char* wl, LAS const float* GQ, const float2* RA, int b, int c, int tbase, int lane) {
    const int col = lane & 15, g = lane >> 4; const size_t row0 = (size_t)b * SEQ + tbase;
    LAS unsigned char* PT = wl + 1024;
    const unsigned long long kvb = (unsigned long long)(KV8 + (size_t)b * SEQ * 512);
    const unsigned long long kvbu = ((unsigned long long)(unsigned)__builtin_amdgcn_readfirstlane((int)(kvb >> 32)) << 32) | (unsigned)__builtin_amdgcn_readfirstlane((int)kvb);
    const __amdgpu_buffer_rsrc_t rs = __builtin_amdgcn_make_buffer_rsrc((void*)kvbu, 0, SEQ * 512, 0x00020000);
    const int l8 = lane >> 3; const int koff = c * 128 + 16 * (lane & 7), voff = 256 + c * 128 + 16 * (lane & 7);
    LAS unsigned char* KS = wl + 3840;
    const int kwo = l8 * 128, kws0 = (((lane & 7) ^ (lane >> 4)) & 7) * 16, kws1 = (((lane & 7) ^ (4 + (lane >> 4))) & 7) * 16;
    const unsigned vwb = 256u * (unsigned)l8, vwk = (2u * (unsigned)(lane & 7)) ^ (((unsigned)l8 & 3u) << 2), vwh = (unsigned)(lane >> 5);
    const unsigned trq = (unsigned)(lane & 15) >> 2, trp = (unsigned)lane & 3u;
    const unsigned ksb = (unsigned)(size_t)KS;
    const unsigned trb0 = ksb + 256u * (8u * g + trq) + 16u * ((trp >> 1) ^ ((trq << 2) | ((2u * g) & 3u))) + 8u * (trp & 1u);
    const unsigned trb1 = ksb + 256u * (8u * g + 4u + trq) + 16u * ((trp >> 1) ^ ((trq << 2) | ((2u * g + 1u) & 3u))) + 8u * (trp & 1u);
    const unsigned ptb = (unsigned)(size_t)PT + (unsigned)((col < 4 ? col * 512 : 2048) + 16 * g);
    const int kro = col * 128, krs0 = (((2 * g) ^ (col >> 1)) & 7) * 16, krs1 = (((2 * g + 1) ^ (col >> 1)) & 7) * 16;
#define AT_LOADK(IP, KR, BI) do { _Pragma("unroll") for (int tt = 0; tt < 4; ++tt) { _Pragma("unroll") for (int hh = 0; hh < 2; ++hh) { const unsigned id_ = (IP)[64 * (BI) + 16 * tt + 8 * hh + l8]; \
        KR[tt][hh] = __builtin_amdgcn_raw_buffer_load_b128(rs, (int)(id_ * 512u) + koff, 0, 0); } } } while (0)
#define AT_LOADV(VW, GI) do { _Pragma("unroll") for (int jj = 0; jj < 8; ++jj) { const unsigned id_ = Ic[64 * (GI) + 8 * jj + l8]; VW[jj] = __builtin_amdgcn_raw_buffer_load_b128(rs, (int)(id_ * 512u) + voff, 0, 0); } } while (0)
#define AT_QK(KR, BI) do { _Pragma("unroll") for (int tt = 0; tt < 4; ++tt) { _Pragma("unroll") for (int hh = 0; hh < 2; ++hh) *(LAS v4u*)(KS + kwo + (16 * tt + 8 * hh) * 128 + ((hh ? kws1 : kws0))) = KR[tt][hh]; } \
    long akf_[4][4]; f32x4_ acq_[4]; \
    _Pragma("unroll") for (int tt = 0; tt < 4; ++tt) { const v4u r0_ = *(const LAS v4u*)(KS + kro + tt * 2048 + krs0), r1_ = *(const LAS v4u*)(KS + kro + tt * 2048 + krs1); \
        akf_[tt][0] = (long)(((unsigned long long)r0_.y << 32) | r0_.x); akf_[tt][1] = (long)(((unsigned long long)r0_.w << 32) | r0_.z); akf_[tt][2] = (long)(((unsigned long long)r1_.y << 32) | r1_.x); akf_[tt][3] = (long)(((unsigned long long)r1_.w << 32) | r1_.z); \
        acq_[tt] = (f32x4_){0.f, 0.f, 0.f, 0.f}; } \
      \
    _Pragma("unroll") for (int ks = 0; ks < 4; ++ks) { _Pragma("unroll") for (int tt = 0; tt < 4; ++tt) acq_[tt] = __builtin_amdgcn_mfma_f32_16x16x32_fp8_fp8(akf_[tt][ks], qh[ks], acq_[tt], 0, 0, 0); } \
    _Pragma("unroll") for (int ks = 0; ks < 4; ++ks) { _Pragma("unroll") for (int tt = 0; tt < 4; ++tt) acq_[tt] = __builtin_amdgcn_mfma_f32_16x16x32_fp8_fp8(akf_[tt][ks], ql[ks], acq_[tt], 0, 0, 0); } \
    _Pragma("unroll") for (int tt = 0; tt < 4; ++tt) { lg[4 * (BI) + tt][0] = acq_[tt][0] * LSC; lg[4 * (BI) + tt][1] = acq_[tt][1] * LSC; lg[4 * (BI) + tt][2] = acq_[tt][2] * LSC; lg[4 * (BI) + tt][3] = acq_[tt][3] * LSC; } } while (0)
#define AT_CV(D, X) do { D.x = __builtin_bit_cast(unsigned, __builtin_amdgcn_cvt_scalef32_pk_bf16_fp8((X).x, 1.0f, false)); D.y = __builtin_bit_cast(unsigned, __builtin_amdgcn_cvt_scalef32_pk_bf16_fp8((X).x, 1.0f, true)); \
        D.z = __builtin_bit_cast(unsigned, __builtin_amdgcn_cvt_scalef32_pk_bf16_fp8((X).y, 1.0f, false)); D.w = __builtin_bit_cast(unsigned, __builtin_amdgcn_cvt_scalef32_pk_bf16_fp8((X).y, 1.0f, true)); } while (0)
#define AT_W(VW, HF, G) do { _Pragma("unroll") for (int i4 = 0; i4 < 4; ++i4) { const v4u r_ = VW[4 * (HF) + i4]; v4u w0_, w1_; { const v2u lo_ = {r_.x, r_.y}; AT_CV(w0_, lo_); } { const v2u hi_ = {r_.z, r_.w}; AT_CV(w1_, hi_); } \
        const unsigned wa_ = vwb + 2048u * i4 + 16u * (vwk ^ ((2u * i4 + vwh) & 3u)) + 8192u * ((G) & 1); *(LAS v4u*)(KS + wa_) = w0_; *(LAS v4u*)(KS + (wa_ ^ 16u)) = w1_; } } while (0)
#define AT_R(B0, B1, PA, G) do { _Pragma("unroll") for (int cc = 0; cc < 8; ++cc) { const unsigned a0_ = trb0 ^ (32u * cc), a1_ = trb1 ^ (32u * cc); \
        if ((G) & 1) asm volatile("ds_read_b64_tr_b16 %0, %2 offset:8192\n\tds_read_b64_tr_b16 %1, %3 offset:8192" : "=&v"(B0[cc]), "=&v"(B1[cc]) : "v"(a0_), "v"(a1_) : "memory"); \
        else asm volatile("ds_read_b64_tr_b16 %0, %2\n\tds_read_b64_tr_b16 %1, %3" : "=&v"(B0[cc]), "=&v"(B1[cc]) : "v"(a0_), "v"(a1_) : "memory"); } \
        { const unsigned pa_a_ = ptb + 64u * (G); asm volatile("ds_read_b128 %0, %1" : "=&v"(PA) : "v"(pa_a_) : "memory"); } } while (0)
#define AT_WAIT(B0, B1, PA) asm volatile("s_waitcnt lgkmcnt(0)" : "+v"(B0[0]), "+v"(B1[0]), "+v"(B0[1]), "+v"(B1[1]), "+v"(B0[2]), "+v"(B1[2]), "+v"(B0[3]), "+v"(B1[3]), "+v"(B0[4]), "+v"(B1[4]), "+v"(B0[5]), "+v"(B1[5]), "+v"(B0[6]), "+v"(B1[6]), "+v"(B0[7]), "+v"(B1[7]), "+v"(PA) :: "memory")
#define AT_M(B0, B1, PA) do { _Pragma("unroll") for (int cc = 0; cc < 8; ++cc) { const v4u bw_ = {B0[cc].x, B0[cc].y, B1[cc].x, B1[cc].y}; \
        oacc[cc] = __builtin_amdgcn_mfma_f32_16x16x32_bf16(__builtin_bit_cast(bf16x8, PA), __builtin_bit_cast(bf16x8, bw_), oacc[cc], 0, 0, 0); } } while (0)
    const __amdgpu_buffer_rsrc_t rsQ = __builtin_amdgcn_make_buffer_rsrc((void*)AQ, 0, MROWS * 2048, 0x00020000);
    const __amdgpu_buffer_rsrc_t rsT = __builtin_amdgcn_make_buffer_rsrc((void*)TOPK, 0, MROWS * 512, 0x00020000);
    const __amdgpu_buffer_rsrc_t rsR = __builtin_amdgcn_make_buffer_rsrc((void*)RA, 0, SEQ * 128, 0x00020000);
    const int qvo = (4 * c + g) * 256 + 16 * col;
#define AT_LOADQ(R) do { qw = __builtin_amdgcn_raw_buffer_load_b128(rsQ, qvo, (int)(R) * 2048, 0); } while (0)
    v4u kA[4][2], qw;
    {
        LAS unsigned short* I0 = (LAS unsigned short*)wl;
        *(LAS v2u*)(I0 + 4 * lane) = __builtin_amdgcn_raw_buffer_load_b64(rsT, 8 * lane, (int)row0 * 512, 0);
        { const f32x4 r0_ = __builtin_bit_cast(f32x4, __builtin_amdgcn_raw_buffer_load_b128(rsR, 16 * (lane & 7), tbase * 128, 0)); if (lane < 8) *(LAS f32x4*)(wl + 3584 + 16 * lane) = r0_; }
        AT_LOADK(I0, kA, 0); AT_LOADQ(row0);
    }
#pragma unroll 1
    for (int i = 0; i < 8; ++i) {
        const size_t row = row0 + i; const int tq = tbase + i; const bool allv = tq >= 255;
        constexpr float LSC = 0.08838834764831845f * (1.f / 64.f) * 1.4426950408889634f;
        const size_t rown = (row + 1 < (size_t)MROWS) ? row + 1 : row; const int tn = (tbase + i + 1) & (SEQ - 1);
        LAS unsigned short* Ic = (LAS unsigned short*)(wl + ((i & 1) ? 512 : 0)); LAS unsigned short* In = (LAS unsigned short*)(wl + ((i & 1) ? 0 : 512));
        LAS const unsigned char* Rc = wl + 3584 + ((i & 1) ? 128 : 0); LAS unsigned char* Rn = wl + 3584 + ((i & 1) ? 0 : 128);
        v4u kB[4][2];
        AT_LOADK(Ic, kA, 0); AT_LOADQ(row); AT_LOADK(Ic, kB, 1);
        asm volatile("" ::: "memory");
        long qh[4], ql[4];
        {
            unsigned gqo = 32u * (unsigned)col; asm volatile("" : "+v"(gqo));
            float y[8] = {bflo(qw.x), bfhi(qw.x), bflo(qw.y), bfhi(qw.y), bflo(qw.z), bfhi(qw.z), bflo(qw.w), bfhi(qw.w)};
            float ss = 0.f;
#pragma unroll
            for (int e = 0; e < 8; ++e) ss += y[e] * y[e];
            ss = sum16(ss);
            const float rstd = __builtin_amdgcn_rsqf(ss * (1.f / 128.f) + EPSN) * 8.f;
            { const f32x4 g0 = *(LAS const f32x4*)((LAS const unsigned char*)GQ + gqo), g1 = *(LAS const f32x4*)((LAS const unsigned char*)GQ + gqo + 16);
              y[0] *= rstd * g0.x; y[1] *= rstd * g0.y; y[2] *= rstd * g0.z; y[3] *= rstd * g0.w; y[4] *= rstd * g1.x; y[5] *= rstd * g1.y; y[6] *= rstd * g1.z; y[7] *= rstd * g1.w; }
            {   const unsigned ro = 64u * (unsigned)(col & 1);
#pragma unroll
                for (int i2 = 0; i2 < 4; ++i2) { const f32x4 cs2 = *(LAS const f32x4*)(Rc + ro + 16 * i2);
                    const float oa = dpp_xor2(y[2 * i2]), ob = dpp_xor2(y[2 * i2 + 1]);
                    const float ra = (col & 2) ? (y[2 * i2] * cs2.x + oa * cs2.y) : (y[2 * i2] * cs2.x - oa * cs2.y), rb = (col & 2) ? (y[2 * i2 + 1] * cs2.z + ob * cs2.w) : (y[2 * i2 + 1] * cs2.z - ob * cs2.w);
                    if (col < 4) { y[2 * i2] = ra; y[2 * i2 + 1] = rb; } }
            }
            int h0 = 0, h1 = 0, l0 = 0, l1 = 0;
            h0 = __builtin_amdgcn_cvt_pk_fp8_f32(y[0], y[1], h0, false); h0 = __builtin_amdgcn_cvt_pk_fp8_f32(y[2], y[3], h0, true);
            h1 = __builtin_amdgcn_cvt_pk_fp8_f32(y[4], y[5], h1, false); h1 = __builtin_amdgcn_cvt_pk_fp8_f32(y[6], y[7], h1, true);
            const f32x2_ f0 = __builtin_amdgcn_cvt_pk_f32_fp8(h0, false), f1 = __builtin_amdgcn_cvt_pk_f32_fp8(h0, true), f2 = __builtin_amdgcn_cvt_pk_f32_fp8(h1, false), f3 = __builtin_amdgcn_cvt_pk_f32_fp8(h1, true);
            l0 = __builtin_amdgcn_cvt_pk_fp8_f32(y[0] - f0.x, y[1] - f0.y, l0, false); l0 = __builtin_amdgcn_cvt_pk_fp8_f32(y[2] - f1.x, y[3] - f1.y, l0, true);
            l1 = __builtin_amdgcn_cvt_pk_fp8_f32(y[4] - f2.x, y[5] - f2.y, l1, false); l1 = __builtin_amdgcn_cvt_pk_fp8_f32(y[6] - f3.x, y[7] - f3.y, l1, true);
            *(LAS v4u*)(PT + 16 * lane) = (v4u){(unsigned)h0, (unsigned)h1, (unsigned)l0, (unsigned)l1};
#pragma unroll
            for (int ks = 0; ks < 4; ++ks) { v4u t4 = {0u, 0u, 0u, 0u}; if (col < 4) t4 = *(const LAS v4u*)(PT + 256 * col + 64 * g + 16 * ks);
                qh[ks] = (long)(((unsigned long long)t4.y << 32) | t4.x); ql[ks] = (long)(((unsigned long long)t4.w << 32) | t4.z); }
        }
        float lg[16][4];
        v4u vA[8], vB[8];
        AT_QK(kA, 0);
        AT_LOADK(Ic, kA, 2);
        asm volatile("" ::: "memory");
        AT_QK(kB, 1);
        AT_LOADK(Ic, kB, 3);
        asm volatile("" ::: "memory");
        AT_QK(kA, 2);
        asm volatile("" ::: "memory");
        AT_QK(kB, 3);
        const v2u nidx = __builtin_amdgcn_raw_buffer_load_b64(rsT, 8 * lane, (int)rown * 512, 0); const f32x4 nrope = __builtin_bit_cast(f32x4, __builtin_amdgcn_raw_buffer_load_b128(rsR, 16 * (lane & 7), tn * 128, 0));
        AT_LOADV(vA, 0);
        asm volatile("" ::: "memory");
        if (!allv) {
#pragma unroll
            for (int T = 0; T < 16; ++T)
#pragma unroll
                for (int r = 0; r < 4; ++r) lg[T][r] = (16 * T + 4 * g + r <= tq) ? lg[T][r] : -INFINITY;
        }
        float m = -INFINITY;
#pragma unroll
        for (int T = 0; T < 16; ++T) m = fmaxf(fmaxf(m, fmaxf(lg[T][0], lg[T][1])), fmaxf(lg[T][2], lg[T][3]));
        m = fmaxf(m, __shfl_xor(m, 16)); m = fmaxf(m, __shfl_xor(m, 32));
        float sum = 0.f;
#pragma unroll
        for (int T = 0; T < 16; ++T)
#pragma unroll
            for (int r = 0; r < 4; ++r) { lg[T][r] = __builtin_amdgcn_exp2f(lg[T][r] - m); sum += lg[T][r]; }
        sum += __shfl_xor(sum, 16); sum += __shfl_xor(sum, 32);
        const float inv = 0.125f * __builtin_amdgcn_rcpf(sum);
        if (col < 4) {
#pragma unroll
            for (int T = 0; T < 16; ++T) { const v2u pw = {pkbf(lg[T][0] * inv, lg[T][1] * inv), pkbf(lg[T][2] * inv, lg[T][3] * inv)}; *(LAS v2u*)(PT + col * 512 + 32 * T + 8 * g) = pw; }
        }
        f32x4_ oacc[8];
#pragma unroll
        for (int cc = 0; cc < 8; ++cc) oacc[cc] = (f32x4_){0.f, 0.f, 0.f, 0.f};
        *(LAS v2u*)(In + 4 * lane) = nidx; if (lane < 8) *(LAS f32x4*)(Rn + 16 * lane) = nrope;
        AT_LOADV(vB, 1);
        asm volatile("" ::: "memory");
        {
            v2u bA0[8], bA1[8], bB0[8], bB1[8]; v4u pA, pB;
            AT_W(vA, 0, 0); AT_R(bA0, bA1, pA, 0);
            AT_W(vA, 1, 1); AT_WAIT(bA0, bA1, pA); AT_R(bB0, bB1, pB, 1); AT_M(bA0, bA1, pA);
            AT_LOADV(vA, 2);
            AT_W(vB, 0, 2); AT_WAIT(bB0, bB1, pB); AT_R(bA0, bA1, pA, 2); AT_M(bB0, bB1, pB);
            AT_W(vB, 1, 3); AT_WAIT(bA0, bA1, pA); AT_R(bB0, bB1, pB, 3); AT_M(bA0, bA1, pA);
            AT_LOADV(vB, 3);
            AT_W(vA, 0, 4); AT_WAIT(bB0, bB1, pB); AT_R(bA0, bA1, pA, 4); AT_M(bB0, bB1, pB);
            AT_W(vA, 1, 5); AT_WAIT(bA0, bA1, pA); AT_R(bB0, bB1, pB, 5); AT_M(bA0, bA1, pA);
            AT_W(vB, 0, 6); AT_WAIT(bB0, bB1, pB); AT_R(bA0, bA1, pA, 6); AT_M(bB0, bB1, pB);
            AT_W(vB, 1, 7); AT_WAIT(bA0, bA1, pA); AT_R(bB0, bB1, pB, 7); AT_M(bA0, bA1, pA);
            AT_WAIT(bB0, bB1, pB); AT_M(bB0, bB1, pB);
        }
        asm volatile("" ::: "memory");
        if (g == 0) {
#pragma unroll
            for (int cc = 0; cc < 8; ++cc)
#pragma unroll
                for (int r = 0; r < 4; ++r) *(LAS unsigned short*)(PT + (r * 128 + 16 * cc + col) * 2) = (unsigned short)(pkbf(oacc[cc][r], 0.f) & 0xffffu);
        }
        { const v4u w = *(const LAS v4u*)(PT + 16 * lane);
          if (AB == 0) __builtin_amdgcn_raw_buffer_store_b128(w, rsQ, (4 * c + g) * 256 + 16 * col, (int)row * 2048, 0); }
    }
#undef AT_LOADK
#undef AT_LOADV
#undef AT_QK
#undef AT_W
#undef AT_R
#undef AT_WAIT
#undef AT_M
#undef AT_CV
#undef AT_LOADQ
}
template <int AB>
__device__ __forceinline__ void phase_attn(const Args& a, LAS unsigned char* lds, int wave, int lane) {
    bf16* AQ = (bf16*)(a.ws + WS_AQ); unsigned char* KV8 = a.ws + WS_KV8; const unsigned short* TOPK = (const unsigned short*)(a.ws + WS_TOPK);
    unsigned* QH = (unsigned*)(a.ws + WS_CTL) + CW_ATTNQ + (AB ? 2048 : 0);
    LAS unsigned char* wl = lds + wave * 20224; LAS float* GQ = (LAS float*)(lds + 161792);
    if (wave < 2) GQ[wave * 64 + lane] = a.q_norm_g[wave * 64 + lane];
    if (lane < 32) *(LAS v4u*)(wl + 1024 + 2048 + 16 * lane) = (v4u){0u, 0u, 0u, 0u};
    __syncthreads();
    const unsigned xcc = (unsigned)__builtin_amdgcn_s_getreg((3 << 11) | 20) & 7u;
#if PROBE_ATT
    {
        const int col = lane & 15, g = lane >> 4; unsigned accx = 0u;
        LAS unsigned short* I0 = (LAS unsigned short*)wl;
        const int b = (int)(xcc >> 1), c = (int)(xcc & 1u);
        const unsigned long long kvb = (unsigned long long)(KV8 + (size_t)b * SEQ * 512);
        const unsigned long long kvbu = ((unsigned long long)(unsigned)__builtin_amdgcn_readfirstlane((int)(kvb >> 32)) << 32) | (unsigned)__builtin_amdgcn_readfirstlane((int)kvb);
        const __amdgpu_buffer_rsrc_t rs = __builtin_amdgcn_make_buffer_rsrc((void*)kvbu, 0, SEQ * 512, 0x00020000);
#if PROBE_ATT == 1
#define PA_LOADK(KR, BI) do { _Pragma("unroll") for (int tt = 0; tt < 4; ++tt) { const unsigned id_ = I0[64 * (BI) + 16 * tt + col]; const unsigned kid_ = (id_ == 0xFFFFu) ? 0u : id_; const int ko_ = (int)(kid_ * 512u) + c * 128 + 32 * g; \
        KR[tt][0] = __builtin_amdgcn_raw_buffer_load_b128(rs, ko_, 0, 0); KR[tt][1] = __builtin_amdgcn_raw_buffer_load_b128(rs, ko_ + 16, 0, 0); } } while (0)
#elif PROBE_ATT == 2
#define PA_LOADK(KR, BI) do { _Pragma("unroll") for (int tt = 0; tt < 4; ++tt) { _Pragma("unroll") for (int hh = 0; hh < 2; ++hh) { const unsigned id_ = I0[64 * (BI) + 16 * tt + 8 * hh + (lane >> 3)]; const unsigned kid_ = (id_ == 0xFFFFu) ? 0u : id_; const int ko_ = (int)(kid_ * 512u) + c * 128 + 16 * (lane & 7); \
        KR[tt][hh] = __builtin_amdgcn_raw_buffer_load_b128(rs, ko_, 0, 0); } } } while (0)
#else
#define PA_LOADK(KR, BI) do { _Pragma("unroll") for (int tt = 0; tt < 4; ++tt) { _Pragma("unroll") for (int hh = 0; hh < 2; ++hh) { const unsigned id_ = I0[64 * (BI) + 16 * tt + (lane >> 2)]; const unsigned kid_ = (id_ == 0xFFFFu) ? 0u : id_; const int ko_ = (int)(kid_ * 512u) + c * 128 + 64 * hh + 16 * (lane & 3); \
        KR[tt][hh] = __builtin_amdgcn_raw_buffer_load_b128(rs, ko_, 0, 0); } } } while (0)
#endif
#define PA_USE(KR) do { _Pragma("unroll") for (int tt = 0; tt < 4; ++tt) { _Pragma("unroll") for (int hh = 0; hh < 2; ++hh) accx ^= KR[tt][hh].x ^ KR[tt][hh].y ^ KR[tt][hh].z ^ KR[tt][hh].w; } } while (0)
#pragma unroll 1
        for (int it = 0; it < 32; ++it) {
            const int t = ((((int)blockIdx.x >> 3) & 31) * 8 + wave) * 32 + it; const size_t row = (size_t)b * SEQ + t;
            *(LAS v2u*)(I0 + 4 * lane) = *(const v2u*)(TOPK + row * 256 + 4 * lane);
            v4u kA[4][2], kB[4][2];
            PA_LOADK(kA, 0); PA_LOADK(kB, 1);
            asm volatile("" ::: "memory");
            PA_USE(kA); PA_LOADK(kA, 2);
            asm volatile("" ::: "memory");
            PA_USE(kB); PA_LOADK(kB, 3);
            asm volatile("" ::: "memory");
            PA_USE(kA);
            asm volatile("" ::: "memory");
            PA_USE(kB);
        }
        if (accx == 0x9e3779b9u) ((unsigned*)(a.ws + WS_CTL))[80000 + wave * 64 + lane] = accx;
        __syncthreads();
    }
#endif
    for (int qi = 0; qi < 8; ++qi) {
        const int queue = (int)((xcc + qi) & 7u); const int b = queue >> 1, c = queue & 1;
        for (;;) {
            unsigned base = 0u; if (lane == 0) base = __hip_atomic_fetch_add(QH + queue * 64, 8u, __ATOMIC_RELAXED, __HIP_MEMORY_SCOPE_AGENT);
            base = (unsigned)__builtin_amdgcn_readfirstlane((int)base);
            if (base >= (unsigned)SEQ) break;
            attn_chunk<AB>(AQ, KV8, TOPK, wl, GQ, (const float2*)(a.ws + WS_ROPEA), b, c, (int)base, lane);
        }
    }
}
#ifndef PROBE_DUP
#define PROBE_DUP 0
#endif
#ifndef PROBE_TSA
#define PROBE_TSA -1
#endif
#ifndef PROBE_TSB
#define PROBE_TSB -1
#endif
__device__ __forceinline__ void phase_p4b(const Args& a, int gw, int NGW, int lane) {
    bf16* H2 = (bf16*)(a.ws + WS_AQ);
    rms_rows_to_bf16(a.out, a.norm_mlp_g, H2, gw, NGW, lane);
}

__device__ __forceinline__ void gdn_naive_dev(int chain, int tid, LAS unsigned char* lb, const bf16* QKV, const bf16* Z, const float* SM, const float* conv_w, const float* a_log, const float* dt_bias,
                                              const float* gnorm_g, bf16* OG) {
    const int b = chain >> 3, h = chain & 7, lane = tid & 63, wave = tid >> 6;
    typedef float row128[128];
    LAS row128* sq = (LAS row128*)lb; LAS row128* sk = sq + 32; LAS row128* sv = sk + 32; LAS row128* so = sv + 32;
    LAS float* sdec = (LAS float*)(so + 32); LAS float* sbeta = sdec + 32;
    LAS row128* redA = (LAS row128*)(sbeta + 32); LAS row128* redB = redA + 2;
    float S[64];
#pragma unroll
    for (int i = 0; i < 64; ++i) S[i] = 0.f;
    const int col = tid & 127, half = tid >> 7;
    const float aexp = __expf(a_log[h]), dtb = dt_bias[h];
    for (int t0 = 0; t0 < SEQ; t0 += 32) {
        for (int e = tid; e < 32 * 384; e += 256) {
            const int tok = e / 384, cch = e % 384, which = cch >> 7, d = cch & 127, ch = which * 1024 + h * 128 + d, t = t0 + tok;
            float y = 0.f;
#pragma unroll
            for (int j = 0; j < 4; ++j) { const int tt = t - 3 + j; if (tt >= 0) y += conv_w[j * 3072 + ch] * bf2f(QKV[((size_t)b * SEQ + tt) * 3072 + ch]); }
            y = siluf_(y);
            if (which == 0) sq[tok][d] = y; else if (which == 1) sk[tok][d] = y; else sv[tok][d] = y;
        }
        __syncthreads();
        for (int vi = wave; vi < 64; vi += 4) { const int tok = vi >> 1; LAS float* p = (vi & 1) ? sk[tok] : sq[tok];
            const float x0 = p[lane], x1 = p[lane + 64]; const float ss = wave_sum(x0 * x0 + x1 * x1);
            float sc = 1.0f / sqrtf(ss + EPSN); if (!(vi & 1)) sc *= 0.08838834764831845f;
            p[lane] = x0 * sc; p[lane + 64] = x1 * sc; }
        if (tid < 32) { const size_t row = (size_t)b * SEQ + t0 + tid; const float ga = SM[row * 32 + h], gb = SM[row * 32 + 8 + h];
            sbeta[tid] = sigm_(gb); sdec[tid] = __expf(-aexp * softplusf_(ga + dtb)); }
        __syncthreads();
        for (int tok = 0; tok < 32; ++tok) {
            const float decay = sdec[tok]; const LAS float* kk = sk[tok] + half * 64; const LAS float* qq = sq[tok] + half * 64;
            float p = 0.f;
#pragma unroll
            for (int i = 0; i < 64; ++i) p += S[i] * kk[i];
            redA[half][col] = p; __syncthreads();
            const float kv = (redA[0][col] + redA[1][col]) * decay;
            const float delta = sbeta[tok] * (sv[tok][col] - kv);
            float po = 0.f;
#pragma unroll
            for (int i = 0; i < 64; ++i) { S[i] = decay * S[i] + kk[i] * delta; po += S[i] * qq[i]; }
            redB[half][col] = po; __syncthreads();
            if (half == 0) so[tok][col] = redB[0][col] + redB[1][col];
        }
        __syncthreads();
        for (int tok = wave; tok < 32; tok += 4) { const size_t row = (size_t)b * SEQ + t0 + tok;
            const float o0 = so[tok][lane], o1 = so[tok][lane + 64]; const float ss = wave_sum(o0 * o0 + o1 * o1);
            const float rstd = 1.0f / sqrtf(ss * (1.f / 128.f) + EPSN);
            const float z0 = bf2f(Z[row * 1024 + h * 128 + lane]), z1 = bf2f(Z[row * 1024 + h * 128 + lane + 64]);
            OG[row * 1024 + h * 128 + lane] = (bf16)f2bf(o0 * rstd * gnorm_g[lane] * siluf_(z0));
            OG[row * 1024 + h * 128 + lane + 64] = (bf16)f2bf(o1 * rstd * gnorm_g[lane + 64] * siluf_(z1)); }
        __syncthreads();
    }
}

__device__ __forceinline__ unsigned f2ord(float f) { if (f == 0.f) f = 0.f; const unsigned u = __builtin_bit_cast(unsigned, f); return (u & 0x80000000u) ? ~u : (u | 0x80000000u); }

__device__ __forceinline__ void topk_naive_dev(int bx, int G, int hf, int tid, LAS unsigned char* lb, const bf16* IQ, const bf16* IK, const float* SM, unsigned short* TOPK) {
    LAS float* sq = (LAS float*)lb; LAS float* sw = sq + 512; LAS unsigned* skey = (LAS unsigned*)(sw + 8); LAS unsigned* hist = skey + SEQ; LAS unsigned* smisc = hist + 256; LAS unsigned* scnt = smisc + 4;
    for (int pair = bx; pair < MROWS / 2; pair += G) {
        const int row = pair * 2 + hf, b = row >> 13, t = row & (SEQ - 1);
        unsigned short* outp = TOPK + (size_t)row * 256;
        if (t < 256) { outp[tid] = tid <= t ? (unsigned short)tid : (unsigned short)0xFFFF; continue; }
        sq[tid] = bf2f(IQ[(size_t)row * 512 + tid]); sq[tid + 256] = bf2f(IQ[(size_t)row * 512 + tid + 256]);
        if (tid < 8) sw[tid] = SM[(size_t)row * 32 + 16 + tid] * (0.35355339059327373f * 0.125f);
        if (tid == 0) smisc[2] = 0u;
        __syncthreads();
        const int n = t + 1;
        for (int s = tid; s < n; s += 256) {
            const v4u* kp = (const v4u*)(IK + ((size_t)b * SEQ + s) * 64); float k[64];
#pragma unroll
            for (int i = 0; i < 8; ++i) { const v4u w = kp[i]; k[8 * i] = bflo(w.x); k[8 * i + 1] = bfhi(w.x); k[8 * i + 2] = bflo(w.y); k[8 * i + 3] = bfhi(w.y); k[8 * i + 4] = bflo(w.z); k[8 * i + 5] = bfhi(w.z); k[8 * i + 6] = bflo(w.w); k[8 * i + 7] = bfhi(w.w); }
            float sc = 0.f;
#pragma unroll 1
            for (int hh = 0; hh < 8; ++hh) { float d = 0.f;
#pragma unroll
                for (int i = 0; i < 64; ++i) d += sq[hh * 64 + i] * k[i];
                sc += sw[hh] * fmaxf(d, 0.f); }
            skey[s] = f2ord(sc);
        }
        __syncthreads();
        unsigned prefix = 0u, mask = 0u, need = 256u;
        for (int pass = 0; pass < 4; ++pass) { const int shift = 24 - 8 * pass;
            hist[tid] = 0u; __syncthreads();
            for (int s = tid; s < n; s += 256) { const unsigned k = skey[s]; if ((k & mask) == prefix) atomicAdd((unsigned*)&hist[(k >> shift) & 255u], 1u); }
            __syncthreads();
            if (tid == 0) { unsigned cum = 0u; int d = 255; for (; d > 0; --d) { const unsigned c = hist[d]; if (cum + c >= need) break; cum += c; } smisc[0] = (unsigned)d; smisc[1] = need - cum; }
            __syncthreads();
            prefix |= smisc[0] << shift; mask |= 0xFFu << shift; need = smisc[1];
            __syncthreads();
        }
        const int per = (n + 255) / 256; const int s0 = tid * per, s1 = min(n, s0 + per);
        unsigned ceq = 0u;
        for (int s = s0; s < s1; ++s) { const unsigned k = skey[s]; if (k > prefix) { const unsigned pos = atomicAdd((unsigned*)&smisc[2], 1u); outp[pos] = (unsigned short)s; } else if (k == prefix) ++ceq; }
        scnt[tid] = ceq; __syncthreads();
        if (tid == 0) { unsigned run = 0u; for (int i = 0; i < 256; ++i) { const unsigned c = scnt[i]; scnt[i] = run; run += c; } }
        __syncthreads();
        const unsigned ngt = smisc[2]; unsigned rk = scnt[tid];
        for (int s = s0; s < s1; ++s) { if (skey[s] == prefix) { if (rk < need) outp[ngt + rk] = (unsigned short)s; ++rk; } }
        __syncthreads();
    }
}

__device__ __forceinline__ void attn_simple_dev(int bx, int G, int hf, int tid, LAS unsigned char* lb, bf16* AQ, const bf16* AKV, const unsigned short* TOPK) {
    const int lane = tid & 63, wave = tid >> 6;
    typedef float row256[256];
    LAS float* sq = (LAS float*)lb; LAS row256* sp = (LAS row256*)(sq + 1024); LAS int* sidx = (LAS int*)(sp + 8); LAS float* sred = (LAS float*)(sidx + 256);
    for (int pair = bx; pair < MROWS / 2; pair += G) {
        const int row = pair * 2 + hf, b = row >> 13;
        { const v2u w = *(const v2u*)(AQ + (size_t)row * 1024 + tid * 4); sq[tid * 4] = bflo(w.x); sq[tid * 4 + 1] = bfhi(w.x); sq[tid * 4 + 2] = bflo(w.y); sq[tid * 4 + 3] = bfhi(w.y); }
        const int idx = TOPK[(size_t)row * 256 + tid]; const bool valid = idx != 0xFFFF; sidx[tid] = valid ? idx : -1;
        __syncthreads();
        float lg[8];
        if (valid) { const bf16* kr = AKV + ((size_t)b * SEQ + idx) * 512;
#pragma unroll
            for (int c = 0; c < 2; ++c) { float acc4[4] = {0.f, 0.f, 0.f, 0.f};
                for (int i = 0; i < 16; ++i) { const v4u w = *(const v4u*)(kr + c * 128 + i * 8); const float kf[8] = {bflo(w.x), bfhi(w.x), bflo(w.y), bfhi(w.y), bflo(w.z), bfhi(w.z), bflo(w.w), bfhi(w.w)};
#pragma unroll
                    for (int g = 0; g < 4; ++g) { const LAS float* q = sq + (c * 4 + g) * 128 + i * 8;
#pragma unroll
                        for (int j = 0; j < 8; ++j) acc4[g] += q[j] * kf[j]; } }
#pragma unroll
                for (int g = 0; g < 4; ++g) lg[c * 4 + g] = acc4[g] * 0.08838834764831845f; }
        } else {
#pragma unroll
            for (int hh = 0; hh < 8; ++hh) lg[hh] = -INFINITY;
        }
#pragma unroll
        for (int hh = 0; hh < 8; ++hh) { float m = lg[hh];
#pragma unroll
            for (int o = 1; o < 64; o <<= 1) m = fmaxf(m, __shfl_xor(m, o));
            if (lane == 0) sred[hh * 4 + wave] = m; }
        __syncthreads();
        float ex[8];
#pragma unroll
        for (int hh = 0; hh < 8; ++hh) { const float m = fmaxf(fmaxf(sred[hh * 4], sred[hh * 4 + 1]), fmaxf(sred[hh * 4 + 2], sred[hh * 4 + 3])); ex[hh] = valid ? __expf(lg[hh] - m) : 0.f; }
        __syncthreads();
#pragma unroll
        for (int hh = 0; hh < 8; ++hh) { const float s = wave_sum(ex[hh]); if (lane == 0) sred[hh * 4 + wave] = s; }
        __syncthreads();
#pragma unroll
        for (int hh = 0; hh < 8; ++hh) { const float s = (sred[hh * 4] + sred[hh * 4 + 1]) + (sred[hh * 4 + 2] + sred[hh * 4 + 3]); sp[hh][tid] = ex[hh] / s; }
        __syncthreads();
        const int hh = tid >> 5, d0 = (tid & 31) * 4, c = hh >> 2; float o4[4] = {0.f, 0.f, 0.f, 0.f};
        for (int nn = 0; nn < 256; ++nn) { const int id = sidx[nn]; if (id < 0) continue; const float p = sp[hh][nn];
            const v2u w = *(const v2u*)(AKV + ((size_t)b * SEQ + id) * 512 + 256 + c * 128 + d0);
            o4[0] += p * bflo(w.x); o4[1] += p * bfhi(w.x); o4[2] += p * bflo(w.y); o4[3] += p * bfhi(w.y); }
        v2u o; o.x = pk2(o4[0], o4[1]); o.y = pk2(o4[2], o4[3]); *(v2u*)(AQ + (size_t)row * 1024 + tid * 4) = o;
        __syncthreads();
    }
}

typedef GAS unsigned gu32;
#define RLX_AGENT __ATOMIC_RELAXED, __HIP_MEMORY_SCOPE_AGENT
constexpr int CW_BAR = 4096;
constexpr int LDS_MISC_OFF = 163840 - 64;
#define XB_TMO      128
#define XB_XCNT(j)  (256  + 64 * (j))
#define XB_XSUB(j)  (1280 + 64 * (j))
#define XB_XGEN(j)  (2304 + 64 * (j))
#define XB_TOP      3328
#define XB_TOPGEN   3392
#define XCD_BAR_WORDS 3456
#define XB_SPIN_CAP (1u << 18)

__device__ __forceinline__ unsigned xb_ld(unsigned* p)              { return __hip_atomic_load(p, __ATOMIC_RELAXED, __HIP_MEMORY_SCOPE_AGENT); }
__device__ __forceinline__ unsigned xb_add(unsigned* p, unsigned v) { return __hip_atomic_fetch_add(p, v, __ATOMIC_RELAXED, __HIP_MEMORY_SCOPE_AGENT); }
__device__ __forceinline__ unsigned xb_xcc_id() { return (unsigned)__builtin_amdgcn_s_getreg((3 << 11) | 20) & 0xFu; }
#define XB_SPIN(cond, bar) do { unsigned _sp = 0; while (cond) { __builtin_amdgcn_s_sleep(1); \
    if ((++_sp & 255u) == 0u) { if (xb_ld(&(bar)[XB_TMO])) break; if (_sp > XB_SPIN_CAP) { atomicAdd(&(bar)[XB_TMO], 1u); break; } } } } while (0)

struct XcdBarrier {
    unsigned* bar; unsigned x; bool t0w;
    volatile LAS unsigned* st;
};

__device__ __forceinline__ XcdBarrier xcd_barrier_post(unsigned* bar, volatile LAS unsigned* st, int wave) {
    XcdBarrier b; b.bar = bar; b.x = xb_xcc_id(); b.st = st; b.t0w = (wave == 0);
    if (b.t0w && LANEID == 0) (void)xb_add(&bar[XB_XCNT(b.x)], 1u);
    return b;
}
__device__ __forceinline__ void xcd_barrier_complete(unsigned* bar, unsigned x, unsigned& nloc, unsigned& nx) {
    const unsigned G = gridDim.x * gridDim.y * gridDim.z;
    unsigned sum, cnt, mine, sp = 0u;
    for (;;) {
        sum = 0u; cnt = 0u; mine = 0u;
#pragma unroll
        for (unsigned j = 0; j < 16; ++j) { const unsigned c = xb_ld(&bar[XB_XCNT(j)]); sum += c; cnt += (c > 0u) ? 1u : 0u; mine = (j == x) ? c : mine; }
        if (sum == G) break;
        __builtin_amdgcn_s_sleep(1);
        if ((++sp & 255u) == 0u) { if (xb_ld(&bar[XB_TMO])) break; if (sp > XB_SPIN_CAP) { atomicAdd(&bar[XB_TMO], 1u); break; } }
    }
    nloc = mine > 0u ? mine : 1u; nx = cnt > 0u ? cnt : 1u;
}

__device__ __forceinline__ void xcd_barrier(const XcdBarrier& b) {
    asm volatile("s_waitcnt vmcnt(0)" ::: "memory");
    __syncthreads();
    if (b.t0w && LANEID == 0) {
        unsigned* bar = b.bar;
        __builtin_amdgcn_s_waitcnt(0);
        unsigned nloc = b.st[0], nx = b.st[1];
        if (nloc == 0u) { xcd_barrier_complete(bar, b.x, nloc, nx); b.st[0] = nloc; b.st[1] = nx; }
        const unsigned old = xb_add(&bar[XB_XSUB(b.x)], 1u);
        const unsigned gen = old / nloc;
        if (old + 1u == (gen + 1u) * nloc) {
            __builtin_amdgcn_fence(__ATOMIC_RELEASE, "agent");
            asm volatile("s_waitcnt vmcnt(0)" ::: "memory");
            const unsigned og = xb_add(&bar[XB_TOP], 1u);
            const unsigned tg = og / nx;
            if (og + 1u == (tg + 1u) * nx) xb_add(&bar[XB_TOPGEN], 1u);
            else XB_SPIN(xb_ld(&bar[XB_TOPGEN]) == tg, bar);
            __builtin_amdgcn_fence(__ATOMIC_ACQUIRE, "agent");
            xb_add(&bar[XB_XGEN(b.x)], 1u);
            asm volatile("s_waitcnt vmcnt(0)" ::: "memory");
        } else {
            XB_SPIN(xb_ld(&bar[XB_XGEN(b.x)]) == gen, bar);
            __builtin_amdgcn_fence(__ATOMIC_ACQUIRE, "agent");
            asm volatile("s_waitcnt vmcnt(0)" ::: "memory");
        }
    }
    __syncthreads();
}

namespace cg = cooperative_groups;
constexpr int NPHASE = 11;
__global__ void __launch_bounds__(NWAVES * 64, 2) fwd(Args a) {
    extern __shared__ __attribute__((aligned(16))) unsigned char lds_raw[];
    LAS unsigned char* lds = (LAS unsigned char*)lds_raw;
    const int wave = __builtin_amdgcn_readfirstlane((int)threadIdx.x >> 6);
    const int G = gridDim.x, bx = blockIdx.x; const int vcu = (G % 8 == 0) ? (bx % 8) * (G / 8) + bx / 8 : bx;
    const int gw = vcu * NWAVES + wave, NGW = G * NWAVES;
    unsigned char* ws = a.ws;
    bf16* H = (bf16*)a.out; bf16* OG = (bf16*)a.out + (size_t)MROWS * DM;
    bf16* WinT = (bf16*)(ws + WS_WINT);
    const int lo = a.ph_lo, hi = a.ph_hi;
    if (wave == 0 && LANEID < 16) ((LAS unsigned*)(lds + LDS_MISC_OFF))[LANEID] = 0u;
    __syncthreads();
    XcdBarrier bar = xcd_barrier_post((unsigned*)(ws + WS_CTL) + CW_BAR, (volatile LAS unsigned*)(lds + LDS_MISC_OFF), wave);
#ifndef PROBE_BLK
#define PROBE_BLK 0
#endif
#define STAMP(k) do { if (PROBE_TSA >= 0 && blockIdx.x == PROBE_BLK && (wave == 0 && LANEID == 0)) ((unsigned long long*)(ws + WS_CTL + 65536))[k] = __builtin_amdgcn_s_memrealtime(); } while (0)
    STAMP(0);
#define IN(k) (lo <= (k) && (k) < hi)
#define SEAM(k) do { if (IN(k) && IN((k) + 1)) xcd_barrier(bar); } while (0)
    if (a.ph_lo < 0) cg::this_grid().sync();
    if (IN(0)) phase_p0(a, lds, gw, NGW, wave, LANEID);
    SEAM(0); STAMP(1);
    if (IN(1)) {
        pg8::Gemm g{H, WinT, MROWS, N_IN1, DM}; pg8::StaticOrder S; S.init(MROWS, N_IN1, G, bx);
        pg8::EpiInProj E{(bf16*)(ws + WS_QKV), (bf16*)(ws + WS_Z), (bf16*)(ws + WS_AQ), (bf16*)(ws + WS_AKV), (bf16*)(ws + WS_IQ), (bf16*)(ws + WS_IK), (bf16*)(ws + WS_HALO), (float*)(ws + WS_SM)};
        pg8::gemm_phase<pg8::EpiInProj, pg8::StaticOrder, PG8_ALIGN, PG8_SP2>(lds, g, S, E, wave);
    }
    SEAM(1); STAMP(2);
    if (IN(2)) phase_p1b(a, gw, NGW, LANEID);
    SEAM(2); STAMP(3);
    if (IN(3)) phase_gdn_prep(a, lds, bx, G, (wave * 64 + LANEID), wave, LANEID);
    SEAM(3); STAMP(4);
    if (IN(4)) {
        if (bx < 32) { phase_scan(a, lds, bx, (wave * 64 + LANEID), wave, LANEID); __syncthreads(); STAMP(6); }
        phase_topk(a, lds, bx, G, (wave * 64 + LANEID), wave, LANEID);
    }
    STAMP(13); SEAM(4); STAMP(5);
    if (IN(5)) phase_attn<0>(a, lds, wave, LANEID);
    STAMP(14); SEAM(5); STAMP(7);
    if (IN(6)) {
        pg8::Gemm g{H, WinT + (size_t)N_IN1 * DM, MROWS, 2048, DM}; pg8::StaticOrder S; S.init(MROWS, 2048, G, bx);
        pg8::EpiGate E{(const bf16*)(ws + WS_QKV), 3072, (const bf16*)(ws + WS_AQ), 1024, (bf16*)(ws + WS_Z), (const float*)(ws + WS_RSTD), a.gdn_norm_g};
        pg8::gemm_phase<pg8::EpiGate, pg8::StaticOrder, PG8_ALIGN, PG8_SP2>(lds, g, S, E, wave);
    }
    SEAM(6); STAMP(8);
    if (IN(7)) {
        pg8::Gemm g{(const bf16*)(ws + WS_Z), (const bf16*)(ws + WS_WOT), MROWS, DM, DM}; pg8::StaticOrder S; S.init(MROWS, DM, G, bx);
        pg8::EpiResNorm E{a.x, a.out, (bf16*)(ws + WS_AQ), (float*)(ws + WS_AKV)};
        pg8::gemm_phase<pg8::EpiResNorm, pg8::StaticOrder, PG8_ALIGN, PG8_SP2>(lds, g, S, E, wave);
    }
    STAMP(9);
    if (IN(7) && IN(9)) xcd_barrier(bar);
    STAMP(10);
    if (IN(9)) {
        pg8::Gemm g{(const bf16*)(ws + WS_AQ), (const bf16*)(ws + WS_WUT), MROWS, DFF, DM}; pg8::StaticOrder S; S.init(MROWS, DFF, G, bx);
        pg8::EpiRelu2N E{(bf16*)(ws + WS_HID), DFF, (const float*)(ws + WS_AKV)};
        pg8::gemm_phase<pg8::EpiRelu2N, pg8::StaticOrder, PG8_ALIGN, PG8_SP2>(lds, g, S, E, wave);
    }
#if (PROBE_DUP & 2)
    __syncthreads();
    if (IN(9)) {
        pg8::Gemm g{(const bf16*)(ws + WS_AQ), (const bf16*)(ws + WS_WUT), MROWS, DFF, DM}; pg8::StaticOrder S; S.init(MROWS, DFF, G, bx);
        pg8::EpiRelu2 E{(bf16*)(ws + WS_HID), DFF};
        pg8::gemm_phase<pg8::EpiRelu2, pg8::StaticOrder, PG8_ALIGN, PG8_SP2>(lds, g, S, E, wave);
    }
#endif
    SEAM(9); STAMP(11);
    if (IN(10)) {
        pg8::Gemm g{(const bf16*)(ws + WS_HID), (const bf16*)(ws + WS_WDT), MROWS, DM, DFF}; pg8::StaticOrder S; S.init(MROWS, DM, G, bx);
        pg8::EpiResF32 E{a.out, a.out};
        pg8::gemm_phase<pg8::EpiResF32, pg8::StaticOrder, PG8_ALIGN, PG8_SP2>(lds, g, S, E, wave);
    }
#if (PROBE_TSA >= 0)
    STAMP(12);
#if (PROBE_TSA == 40)
    xcd_barrier(bar);
    if (blockIdx.x == PROBE_BLK && (wave == 0 && LANEID == 0)) { volatile unsigned long long* T_ = (volatile unsigned long long*)(ws + WS_CTL + 65536); T_[40] = 0ull; T_[41] = 100ull * (unsigned long long)__hip_atomic_load((unsigned*)(ws + WS_CTL) + 12288, __ATOMIC_RELAXED, __HIP_MEMORY_SCOPE_AGENT); }
#endif
    if (blockIdx.x == PROBE_BLK && (wave == 0 && LANEID == 0)) { const volatile unsigned long long* TS = (const volatile unsigned long long*)(ws + WS_CTL + 65536); const unsigned long long d = TS[PROBE_TSB] - TS[PROBE_TSA];
        const unsigned long long t0 = __builtin_amdgcn_s_memrealtime(); while (__builtin_amdgcn_s_memrealtime() - t0 < 4ull * d) __builtin_amdgcn_s_sleep(8); }
#endif
}

#ifndef PROBE_DUP
#define PROBE_DUP 0
#endif
#ifndef MK_ONE_LAUNCH
#define MK_ONE_LAUNCH 1
#endif
extern "C" void kernel_launch(void* const* d_in, const int* in_sizes, int n_in, void* d_out, int out_size, void* d_ws, size_t ws_size, hipStream_t stream) {
    static int grid = 0;
    if (grid == 0) {
        if (n_in != 13 || in_sizes[0] != MROWS * DM || out_size != MROWS * DM || ws_size < WS_NEED) { fprintf(stderr, "kernel_launch: unexpected shapes/workspace (%d inputs, ws %zu)\n", n_in, ws_size); grid = -1; return; }
        if (hipFuncSetAttribute((const void*)fwd, hipFuncAttributeMaxDynamicSharedMemorySize, LDS_BYTES) != hipSuccess) { fprintf(stderr, "kernel_launch: hipFuncSetAttribute failed\n"); grid = -1; return; }
        int dev = 0, cus = 0, per_cu = 0;
        hipGetDevice(&dev); hipDeviceGetAttribute(&cus, hipDeviceAttributeMultiprocessorCount, dev);
        hipOccupancyMaxActiveBlocksPerMultiprocessor(&per_cu, (const void*)fwd, NWAVES * 64, LDS_BYTES);
        if (per_cu < 1 || cus < 1) { fprintf(stderr, "kernel_launch: occupancy query says %d blocks/CU on %d CUs\n", per_cu, cus); grid = -1; return; }
        grid = cus;
    }
    if (grid < 0) return;
    if (hipMemsetAsync((char*)d_ws + WS_CTL, 0, CTL_ZERO_BYTES, stream) != hipSuccess) { fprintf(stderr, "kernel_launch: memset failed\n"); return; }
    Args a{};
    a.x = (const float*)d_in[0]; a.norm_mix_g = (const float*)d_in[1]; a.w_in = (const float*)d_in[2]; a.conv_w = (const float*)d_in[3]; a.a_log = (const float*)d_in[4];
    a.dt_bias = (const float*)d_in[5]; a.gdn_norm_g = (const float*)d_in[6]; a.q_norm_g = (const float*)d_in[7]; a.k_norm_g = (const float*)d_in[8]; a.w_out = (const float*)d_in[9];
    a.norm_mlp_g = (const float*)d_in[10]; a.w_up = (const float*)d_in[11]; a.w_down = (const float*)d_in[12];
    a.out = (float*)d_out; a.ws = (unsigned char*)d_ws;
#if MK_ONE_LAUNCH
    a.ph_lo = 0; a.ph_hi = NPHASE;
    void* args[] = {&a};
    hipError_t e = hipLaunchCooperativeKernel((const void*)fwd, dim3(grid), dim3(NWAVES * 64), args, LDS_BYTES, stream);
    if (e != hipSuccess) fprintf(stderr, "cooperative launch failed: %s (grid %d)\n", hipGetErrorString(e), grid);
#else
    for (int p = 0; p < NPHASE; ++p) { a.ph_lo = p; a.ph_hi = p + 1; hipLaunchKernelGGL(fwd, dim3(grid), dim3(NWAVES * 64), LDS_BYTES, stream, a); }
#endif
}
```
